# Optimizing an MI355X kernel written in HIP

```python
import jax, jax.numpy as jnp
from jax import lax
import numpy as np

D_MODEL = 1024
BATCH = 8
SEQ = 2048
DEPTH = 4
DEC_BATCH = 128
DEC_SEQ = 1
PAST_LEN = 16384
PAGE_SIZE = 128

N_META = 16
N_EVEN = (DEPTH + 1) // 2
N_ODD = DEPTH // 2
A_HEADS = 4
A_DK = 128
A_DV = 128
A_W = A_HEADS * A_DK
B_HEADS = 8
B_N = 64
B_W = B_HEADS * B_N
B_DECAY_LORA = 64
B_AAA_LORA = 64
B_GATE_LORA = 128
B_PROJ = 3 * B_W + B_DECAY_LORA + B_AAA_LORA + B_GATE_LORA
EVEN_PROJ = 4 * A_W + B_PROJ
EVEN_MIX = A_W + B_W
RWKV_GN_EPS = 64e-5
C_HEADS = 4
C_DK = 128
C_DV = 256
C_KW = C_HEADS * C_DK
C_VW = C_HEADS * C_DV
C_GATE_LORA = 16
C_GATE_TAU = 16.0
ODD_PROJ = 2 * C_KW + 2 * C_VW + C_GATE_LORA
D_FF = 2816
CHUNK = 32
RMS_EPS = 1e-6

kernel_name = 'hgrn2_rwkv7_gla_macaron_step'


def rmsnorm(x, g):
    xf = x.astype(jnp.float32)
    y = xf * lax.rsqrt(jnp.mean(xf * xf, axis=-1, keepdims=True) + RMS_EPS)
    return (y * g.astype(jnp.float32)).astype(x.dtype)


def half_ffn(x, g, w_gate, w_up, w_down):
    h = rmsnorm(x, g)
    return 0.5 * ((jax.nn.silu(h @ w_gate) * (h @ w_up)) @ w_down)


def split_heads(z, n_heads):
    return z.reshape(z.shape[0], z.shape[1], n_heads, -1)


def hgrn_lower_bounds(lb_param):
    p = jax.nn.softmax(lb_param.astype(jnp.float32), axis=0)
    c = jnp.cumsum(p, axis=0)
    return c - c[0:1]


def gla_chunked(q, k, v, logf, s0, chunk):
    b, t, h, dk = q.shape
    dv = v.shape[-1]
    c = chunk if t % chunk == 0 else t
    n = t // c

    def split(z):
        return jnp.moveaxis(z.reshape(b, n, c, *z.shape[2:]), 1, 0)

    causal = jnp.tril(jnp.ones((c, c), bool))[None, :, :, None, None]

    def step(s, inp):
        qc, kc, vc, lc = (z.astype(jnp.float32) for z in inp)
        cum = jnp.cumsum(lc, axis=1)
        diff = cum[:, :, None] - cum[:, None, :]
        decay = jnp.exp(jnp.where(causal, diff, -jnp.inf))
        scores = jnp.einsum('bthk,bshk,btshk->bhts', qc, kc, decay)
        o_intra = jnp.einsum('bhts,bshv->bthv', scores, vc)
        o_inter = jnp.einsum('bthk,bhkv->bthv', qc * jnp.exp(cum), s)
        last = cum[:, -1]
        k_dec = kc * jnp.exp(last[:, None] - cum)
        s_new = jnp.exp(last)[..., None] * s + jnp.einsum('bshk,bshv->bhkv', k_dec, vc)
        return s_new, o_intra + o_inter

    s_fin, o = lax.scan(step, s0.astype(jnp.float32), (split(q), split(k), split(v), split(logf)))
    o = jnp.moveaxis(o, 0, 1).reshape(b, t, h, dv)
    return o.astype(v.dtype), s_fin


def gla_seq(q, k, v, logf, s0, lead):
    if lead == 0:
        return gla_chunked(q, k, v, logf, s0, CHUNK)
    o1, s1 = gla_chunked(q[:, :lead], k[:, :lead], v[:, :lead], logf[:, :lead], s0, lead)
    o2, s2 = gla_chunked(q[:, lead:], k[:, lead:], v[:, lead:], logf[:, lead:], s1, CHUNK)
    return jnp.concatenate([o1, o2], axis=1), s2


def rwkv7_scan(r, w, k, v, kk, a, s0):
    def step(s, inp):
        rt, wt, kt, vt, kkt, at = inp
        sa = jnp.einsum('bhij,bhj->bhi', s, -kkt)
        s = s * wt[:, :, None, :] + sa[..., None] * (kkt * at)[:, :, None, :] + vt[..., None] * kt[:, :, None, :]
        y = jnp.einsum('bhij,bhj->bhi', s, rt)
        return s, y

    xs = tuple(jnp.moveaxis(z, 1, 0) for z in (r, w, k, v, kk, a))
    s_fin, y = lax.scan(step, s0.astype(jnp.float32), xs)
    return jnp.moveaxis(y, 0, 1), s_fin


def even_mixer(h, lb, s_hgrn, s_rwkv, shift_prev, prm, e, lead):
    f32 = jnp.float32
    bsz, t, _ = h.shape
    proj = (h @ prm['even_w_in'][e]).astype(f32)
    qa, fa, ia, ga, pb = jnp.split(proj, [A_W, 2 * A_W, 3 * A_W, 4 * A_W], axis=-1)
    ka = (1.0 - lb) * jax.nn.sigmoid(-fa)
    logf = jnp.logaddexp(jnp.log(lb), jnp.log1p(-lb) + jax.nn.log_sigmoid(fa))
    oa, s_hgrn_new = gla_seq(split_heads(qa * A_DK ** -0.5, A_HEADS), split_heads(ka, A_HEADS),
                             split_heads(jax.nn.silu(ia), A_HEADS), split_heads(logf, A_HEADS), s_hgrn, lead)
    oa = rmsnorm(oa.reshape(bsz, t, A_W) * jax.nn.sigmoid(ga), prm['hgrn_norm'][e])
    prev = jnp.concatenate([shift_prev[:, None].astype(f32), pb[:, :-1]], axis=1)
    xm = pb + (prev - pb) * prm['rwkv_mu'][e]
    xr, xk, xv, xw, xa, xg = jnp.split(
        xm, [B_W, 2 * B_W, 3 * B_W, 3 * B_W + B_DECAY_LORA, 3 * B_W + B_DECAY_LORA + B_AAA_LORA], axis=-1)
    wv = prm['rwkv_w0'][e] + jnp.tanh(xw) @ prm['rwkv_w2'][e]
    decay = jnp.exp(-jnp.exp(-jax.nn.softplus(-wv) - 0.5))
    a = jax.nn.sigmoid(prm['rwkv_a0'][e] + xa @ prm['rwkv_a2'][e])
    g = jax.nn.sigmoid(xg) @ prm['rwkv_g2'][e]
    kk = split_heads(xk * prm['rwkv_kk'][e], B_HEADS)
    kk = kk / jnp.maximum(jnp.sqrt(jnp.sum(kk * kk, axis=-1, keepdims=True)), 1e-12)
    kmod = xk * (1.0 + (a - 1.0) * prm['rwkv_ka'][e])
    r4, k4, v4 = split_heads(xr, B_HEADS), split_heads(kmod, B_HEADS), split_heads(xv, B_HEADS)
    y, s_rwkv_new = rwkv7_scan(r4, split_heads(decay, B_HEADS), k4, v4, kk, split_heads(a, B_HEADS), s_rwkv)
    mu = jnp.mean(y, axis=-1, keepdims=True)
    var = jnp.mean(jnp.square(y - mu), axis=-1, keepdims=True)
    yn = ((y - mu) * lax.rsqrt(var + RWKV_GN_EPS)).reshape(bsz, t, B_W) * prm['rwkv_ln_w'][e] + prm['rwkv_ln_b'][e]
    bonus = jnp.sum(r4 * k4 * prm['rwkv_rk'][e].reshape(B_HEADS, B_N), axis=-1, keepdims=True) * v4
    ob = (yn + bonus.reshape(bsz, t, B_W)) * g
    mix = jnp.concatenate([oa.astype(f32), ob], axis=-1).astype(h.dtype) @ prm['even_w_out'][e]
    return mix, s_hgrn_new, s_rwkv_new, pb[:, -1]


def odd_mixer(h, s_gla, prm, o, lead):
    f32 = jnp.float32
    bsz, t, _ = h.shape
    proj = (h @ prm['odd_w_in'][o]).astype(f32)
    qc, kc, vc, gd, og = jnp.split(
        proj, [C_KW, 2 * C_KW, 2 * C_KW + C_VW, 2 * C_KW + C_VW + C_GATE_LORA], axis=-1)
    gk = gd @ prm['gla_gate_up'][o] + prm['gla_gate_b'][o]
    logf = jax.nn.log_sigmoid(gk) / C_GATE_TAU
    oc, s_new = gla_seq(split_heads(qc * C_DK ** -0.5, C_HEADS), split_heads(kc, C_HEADS),
                        split_heads(vc, C_HEADS), split_heads(logf, C_HEADS), s_gla, lead)
    oc = rmsnorm(oc, prm['gla_norm'][o]).reshape(bsz, t, C_VW) * jax.nn.silu(og)
    return oc.astype(h.dtype) @ prm['odd_w_out'][o], s_new


def forward(x, st_hgrn, st_rwkv, st_shift, st_gla, prm, lead):
    lbs = hgrn_lower_bounds(prm['hgrn_lb'])
    new_h, new_r, new_s, new_g = [], [], [], []
    for l in range(DEPTH):
        x = x + half_ffn(x, prm['norm_ffn1'][l], prm['ffn1_gate'][l], prm['ffn1_up'][l], prm['ffn1_down'][l]).astype(x.dtype)
        h = rmsnorm(x, prm['norm_mix'][l])
        if l % 2 == 0:
            e = l // 2
            m, sh, sr, ss = even_mixer(h, lbs[e], st_hgrn[e], st_rwkv[e], st_shift[e], prm, e, lead)
            new_h.append(sh)
            new_r.append(sr)
            new_s.append(ss)
        else:
            o = l // 2
            m, sg = odd_mixer(h, st_gla[o], prm, o, lead)
            new_g.append(sg)
        x = x + m.astype(x.dtype)
        x = x + half_ffn(x, prm['norm_ffn2'][l], prm['ffn2_gate'][l], prm['ffn2_up'][l], prm['ffn2_down'][l]).astype(x.dtype)
    y = rmsnorm(x, prm['final_norm'])
    return y, jnp.stack(new_h), jnp.stack(new_r), jnp.stack(new_s), jnp.stack(new_g)


def setup_inputs(seed: int = 0) -> dict:
    key = jax.random.key(seed)
    ks = iter(jax.random.split(key, 64))
    f32 = jnp.float32

    def nrm(shape, scale):
        return jax.random.normal(next(ks), shape, f32) * scale

    def unif(shape, lo, hi):
        return jax.random.uniform(next(ks), shape, f32, lo, hi)

    d = D_MODEL
    return {
        'x_prompt': nrm((BATCH, SEQ, d), 1.0),
        'x_sample': nrm((DEC_BATCH, DEC_SEQ, d), 1.0),
        'state_hgrn': nrm((N_EVEN, DEC_BATCH, A_HEADS, A_DK, A_DV), 0.5),
        'state_rwkv': nrm((N_EVEN, DEC_BATCH, B_HEADS, B_N, B_N), 0.3),
        'state_rwkv_shift': nrm((N_EVEN, DEC_BATCH, B_PROJ), 1.0),
        'state_gla': nrm((N_ODD, DEC_BATCH, C_HEADS, C_DK, C_DV), 1.0),
        'meta_tokens': nrm((N_META, d), 1.0),
        'norm_ffn1': 1.0 + nrm((DEPTH, d), 0.02),
        'ffn1_gate': nrm((DEPTH, d, D_FF), d ** -0.5),
        'ffn1_up': nrm((DEPTH, d, D_FF), d ** -0.5),
        'ffn1_down': nrm((DEPTH, D_FF, d), D_FF ** -0.5),
        'norm_mix': 1.0 + nrm((DEPTH, d), 0.02),
        'even_w_in': nrm((N_EVEN, d, EVEN_PROJ), d ** -0.5),
        'hgrn_lb': nrm((N_EVEN, A_W), 0.1),
        'hgrn_norm': 1.0 + nrm((N_EVEN, A_W), 0.02),
        'rwkv_mu': unif((N_EVEN, B_PROJ), 0.0, 1.0),
        'rwkv_w0': unif((N_EVEN, B_W), -5.0, 0.5),
        'rwkv_w2': nrm((N_EVEN, B_DECAY_LORA, B_W), 0.1),
        'rwkv_a0': nrm((N_EVEN, B_W), 0.1),
        'rwkv_a2': nrm((N_EVEN, B_AAA_LORA, B_W), 0.1),
        'rwkv_g2': nrm((N_EVEN, B_GATE_LORA, B_W), B_GATE_LORA ** -0.5),
        'rwkv_kk': 0.85 + nrm((N_EVEN, B_W), 0.02),
        'rwkv_ka': 1.0 + nrm((N_EVEN, B_W), 0.02),
        'rwkv_rk': nrm((N_EVEN, B_W), 0.1),
        'rwkv_ln_w': 1.0 + nrm((N_EVEN, B_W), 0.02),
        'rwkv_ln_b': nrm((N_EVEN, B_W), 0.02),
        'even_w_out': nrm((N_EVEN, EVEN_MIX, d), EVEN_MIX ** -0.5),
        'odd_w_in': nrm((N_ODD, d, ODD_PROJ), d ** -0.5),
        'gla_gate_up': nrm((N_ODD, C_GATE_LORA, C_KW), C_GATE_LORA ** -0.5),
        'gla_gate_b': nrm((N_ODD, C_KW), 0.1),
        'gla_norm': 1.0 + nrm((N_ODD, C_DV), 0.02),
        'odd_w_out': nrm((N_ODD, C_VW, d), C_VW ** -0.5),
        'norm_ffn2': 1.0 + nrm((DEPTH, d), 0.02),
        'ffn2_gate': nrm((DEPTH, d, D_FF), d ** -0.5),
        'ffn2_up': nrm((DEPTH, d, D_FF), d ** -0.5),
        'ffn2_down': nrm((DEPTH, D_FF, d), D_FF ** -0.5),
        'final_norm': 1.0 + nrm((d,), 0.02),
    }


def reference(x_prompt, x_sample, state_hgrn, state_rwkv, state_rwkv_shift, state_gla, meta_tokens,
              norm_ffn1, ffn1_gate, ffn1_up, ffn1_down, norm_mix, even_w_in, hgrn_lb, hgrn_norm,
              rwkv_mu, rwkv_w0, rwkv_w2, rwkv_a0, rwkv_a2, rwkv_g2, rwkv_kk, rwkv_ka, rwkv_rk,
              rwkv_ln_w, rwkv_ln_b, even_w_out, odd_w_in, gla_gate_up, gla_gate_b, gla_norm, odd_w_out,
              norm_ffn2, ffn2_gate, ffn2_up, ffn2_down, final_norm):
    prm = dict(norm_ffn1=norm_ffn1, ffn1_gate=ffn1_gate, ffn1_up=ffn1_up, ffn1_down=ffn1_down,
               norm_mix=norm_mix, even_w_in=even_w_in, hgrn_lb=hgrn_lb, hgrn_norm=hgrn_norm,
               rwkv_mu=rwkv_mu, rwkv_w0=rwkv_w0, rwkv_w2=rwkv_w2, rwkv_a0=rwkv_a0, rwkv_a2=rwkv_a2,
               rwkv_g2=rwkv_g2, rwkv_kk=rwkv_kk, rwkv_ka=rwkv_ka, rwkv_rk=rwkv_rk,
               rwkv_ln_w=rwkv_ln_w, rwkv_ln_b=rwkv_ln_b, even_w_out=even_w_out, odd_w_in=odd_w_in,
               gla_gate_up=gla_gate_up, gla_gate_b=gla_gate_b, gla_norm=gla_norm, odd_w_out=odd_w_out,
               norm_ffn2=norm_ffn2, ffn2_gate=ffn2_gate, ffn2_up=ffn2_up, ffn2_down=ffn2_down,
               final_norm=final_norm)
    f32 = jnp.float32
    bsz = x_prompt.shape[0]
    meta = jnp.broadcast_to(meta_tokens.astype(x_prompt.dtype)[None], (bsz, N_META, D_MODEL))
    xp = jnp.concatenate([meta, x_prompt], axis=1)
    z_h = jnp.zeros((N_EVEN, bsz, A_HEADS, A_DK, A_DV), f32)
    z_r = jnp.zeros((N_EVEN, bsz, B_HEADS, B_N, B_N), f32)
    z_s = jnp.zeros((N_EVEN, bsz, B_PROJ), f32)
    z_g = jnp.zeros((N_ODD, bsz, C_HEADS, C_DK, C_DV), f32)
    yp, hp, rp, sp, gp = forward(xp, z_h, z_r, z_s, z_g, prm, N_META)
    ys, hs, rs, ss, gs = forward(x_sample, state_hgrn, state_rwkv, state_rwkv_shift, state_gla, prm, 0)
    return (yp[:, N_META:], ys, hp, rp, sp, gp, hs, rs, ss, gs)
```

```cpp
#include <hip/hip_runtime.h>
#include <hip/hip_cooperative_groups.h>
#include <cstdio>
#include <cstdint>
namespace cg = cooperative_groups;

#define LAS __attribute__((address_space(3)))
#define GAS __attribute__((address_space(1)))
typedef unsigned short bf16_t;
typedef short bf16x8 __attribute__((ext_vector_type(8)));
typedef float f32x4 __attribute__((ext_vector_type(4)));
typedef unsigned u32x4 __attribute__((ext_vector_type(4)));
typedef unsigned u32x2 __attribute__((ext_vector_type(2)));
typedef float f32x2_ __attribute__((ext_vector_type(2)));

constexpr int D = 1024, FF = 2816, TP = 2064, NB = 8, NS = 128, MP = NB * TP  , MT = MP + NS  ;
constexpr int EPROJ = 3840, OPROJ = 3328  , OSRC = 3088;
constexpr int NTHREADS = 512, NWAVES = 8;
#define PROBE_MASK 0
constexpr int LDS_BYTES = 131072 + 512;
constexpr int TAB_OFF = 131072;

enum { I_XP = 0, I_XS, I_SH, I_SR, I_SS, I_SG, I_META, I_NF1, I_F1G, I_F1U, I_F1D, I_NMIX, I_EWIN, I_LB, I_HNORM, I_MU, I_W0, I_W2, I_A0, I_A2, I_G2,
       I_KK, I_KA, I_RK, I_LNW, I_LNB, I_EWOUT, I_OWIN, I_GUP, I_GB, I_GNORM, I_OWOUT, I_NF2, I_F2G, I_F2U, I_F2D, I_FNORM, N_IN };

constexpr size_t O_YP = 0, O_YS = 16777216, O_HP = O_YS + 131072, O_RP = O_HP + 1048576, O_SP = O_RP + 524288, O_GP = O_SP + 28672,
                 O_HS = O_GP + 2097152, O_RS = O_HS + 16777216, O_SSH = O_RS + 8388608, O_GS = O_SSH + 458752, O_END = O_GS + 33554432;

constexpr size_t WS_BAR = 0;
constexpr size_t WS_WGU = 16384;
constexpr size_t WS_WD = WS_WGU + (size_t)8 * 5632 * 1024 * 2;
constexpr size_t WS_WINE = WS_WD + (size_t)8 * 1024 * 2816 * 2;
constexpr size_t WS_WINO = WS_WINE + (size_t)2 * EPROJ * 1024 * 2;
constexpr size_t WS_WOUT = WS_WINO + (size_t)2 * OPROJ * 1024 * 2;
constexpr size_t WS_WLORA = WS_WOUT + (size_t)4 * 1024 * 1024 * 2;
constexpr size_t WS_XF = WS_WLORA + (size_t)2 * 1536 * 256 * 2;
constexpr size_t WS_XB = WS_XF + (size_t)MT * 1024 * 4;
constexpr size_t WS_SSQ = WS_XB + (size_t)MT * 1024 * 2;
constexpr size_t WS_PROJ = WS_SSQ + (size_t)MT * 16 * 4;
constexpr size_t WS_LIN = WS_PROJ + (size_t)MT * EPROJ * 2;
constexpr size_t WS_LRAW = WS_LIN + (size_t)MT * 256 * 2;
constexpr size_t WS_ORAW = WS_LRAW + (size_t)MT * 1536 * 2;
constexpr size_t WS_BSUM = WS_ORAW + (size_t)MT * 1024 * 4;
constexpr size_t WS_MIXB = WS_BSUM + (size_t)MT * 8 * 4;
constexpr size_t WS_PART = WS_MIXB + (size_t)MT * 1024 * 2;
constexpr size_t WS_RSTD = WS_PART + (size_t)11 * 256 * 1024 * 4;
constexpr size_t WS_KDT = WS_RSTD + (size_t)MT * 4;
constexpr size_t WS_ELG = WS_KDT + (size_t)8 * 65 * 512 * 32 * 2;
constexpr size_t WS_END = WS_ELG + (size_t)8 * 65 * 512 * 4;

struct Params { const float* in[N_IN]; float* out; unsigned char* ws; int ph_lo, ph_hi, probe_mask, pad_; };
struct Ctx {
    LAS unsigned char* lds; GAS float* out; GAS unsigned char* ws; int tid, bid, G, probe;
    __device__ __forceinline__ const GAS float* in(int i) const {
        const LAS unsigned* t = (const LAS unsigned*)(lds + TAB_OFF) + 2 * i;
        const unsigned lo = __builtin_amdgcn_readfirstlane(t[0]), hi = __builtin_amdgcn_readfirstlane(t[1]);
        return (const GAS float*)(((unsigned long long)hi << 32) | lo);
    }
};

enum { K_P0 = 0, K_GU, K_DN, K_IN, K_LIN, K_LORA, K_SCAN, K_POST, K_OUT, K_FINAL, K_FIX };
constexpr int NPHASES = 40;
__constant__ unsigned char PROG[NPHASES][2] = {
    {K_P0, 0},
    {K_GU, 0}, {K_DN, 0}, {K_IN, 0}, {K_LIN, 0}, {K_LORA, 0}, {K_SCAN, 0}, {K_POST, 0}, {K_OUT, 0}, {K_GU, 1}, {K_DN, 1},
    {K_GU, 2}, {K_DN, 2}, {K_IN, 1}, {K_LIN, 1}, {K_SCAN, 1}, {K_POST, 1}, {K_OUT, 1}, {K_GU, 3}, {K_DN, 3},
    {K_GU, 4}, {K_DN, 4}, {K_IN, 2}, {K_LIN, 2}, {K_LORA, 2}, {K_SCAN, 2}, {K_POST, 2}, {K_OUT, 2}, {K_GU, 5}, {K_DN, 5},
    {K_GU, 6}, {K_DN, 6}, {K_IN, 3}, {K_LIN, 3}, {K_SCAN, 3}, {K_POST, 3}, {K_OUT, 3}, {K_GU, 7}, {K_DN, 7},
    {K_FINAL, 0}};

__device__ __forceinline__ float bf2f(unsigned short b) { return __uint_as_float(((unsigned)b) << 16); }
__device__ __forceinline__ float bflo(unsigned u) { return __uint_as_float(u << 16); }
__device__ __forceinline__ float bfhi(unsigned u) { return __uint_as_float(u & 0xffff0000u); }
__device__ __forceinline__ unsigned pk2(float lo, float hi) { unsigned r; asm volatile("v_cvt_pk_bf16_f32 %0, %1, %2" : "=v"(r) : "v"(lo), "v"(hi)); return r; }
__device__ __forceinline__ unsigned short f2bf_c(float x) { unsigned u = __float_as_uint(x); u += 0x7fffu + ((u >> 16) & 1u); return (unsigned short)(u >> 16); }
__device__ __forceinline__ float sigmoidf_(float x) { return __builtin_amdgcn_rcpf(1.0f + __expf(-x)); }
__device__ __forceinline__ float siluf_(float x) { return x * __builtin_amdgcn_rcpf(1.0f + __expf(-x)); }
__device__ __forceinline__ float wave_sum(float v) {
#pragma unroll
    for (int o = 1; o < 64; o <<= 1) v += __shfl_xor(v, o);
    return v;
}
template <int CTRL> __device__ __forceinline__ float dppf(float v) { return __int_as_float(__builtin_amdgcn_update_dpp(0, __float_as_int(v), CTRL, 0xF, 0xF, true)); }
__device__ __forceinline__ float allred8(float v) { v += dppf<0xB1>(v); v += dppf<0x4E>(v); v += dppf<0x141>(v); return v; }
__device__ __forceinline__ float allred16(float v) { v = allred8(v); v += dppf<0x140>(v); return v; }
#define LDS_WAIT() asm volatile("s_waitcnt lgkmcnt(0)" ::: "memory")
__device__ __forceinline__ float amul(float a, float b) { float r; asm("v_mul_f32 %0, %1, %2" : "=v"(r) : "v"(a), "v"(b)); return r; }
__device__ __forceinline__ float afma(float a, float b, float c) { float r; asm("v_fma_f32 %0, %1, %2, %3" : "=v"(r) : "v"(a), "v"(b), "v"(c)); return r; }

__device__ __forceinline__ float rstd_of(const GAS float* ssq, int row) {
    const GAS f32x4* p = (const GAS f32x4*)(ssq + (size_t)row * 16);
    const f32x4 a = p[0], b = p[1], c = p[2], d = p[3];
    const float s = ((a.x + a.y) + (a.z + a.w)) + ((b.x + b.y) + (b.z + b.w)) + ((c.x + c.y) + (c.z + c.w)) + ((d.x + d.y) + (d.z + d.w));
    return rsqrtf(s * (1.0f / 1024.0f) + 1e-6f);
}

namespace pg8 {
constexpr int BM = 256, BK = 64, HALF = 128, HTB = HALF * BK * 2, NXCD = 8, WGM = 8;
__device__ __forceinline__ int lds_byte(int r, int c) { const int st = (r >> 4) * 2 + (c >> 5), rr = r & 15, cc = c & 31, ob = rr * 64 + cc * 2; return st * 1024 + (ob ^ (((ob >> 9) & 1) << 5)); }
__device__ __forceinline__ void stage_rc(int b, int& R, int& C) { const int st = b / 1024, sb = b % 1024, swz = sb ^ (((sb >> 9) & 1) << 5); R = (st >> 1) * 16 + swz / 64; C = (st & 1) * 32 + (swz % 64) / 2; }
struct Unit { int pm, pn, k0, nt, kc; };
struct Gemm { const GAS bf16_t* A; const GAS bf16_t* Bt; int M, N, K; };
struct StaticOrder {
    int nM, nN, nwg, G, c, ntK, ntail;
    __device__ __forceinline__ void init(int M, int N, int K, int G_, int c_, int tail) { nM = M / BM - (tail ? 1 : 0); nN = N / BM; nwg = nM * nN; G = G_; c = c_; ntK = K / BK; ntail = tail ? nN * (K / 256) : 0; }
    __device__ __forceinline__ bool next(int i, Unit& u) const {
        const long L = (long)i * G + c; if (L >= nwg + ntail) return false;
        const bool tl = L >= nwg; const int j = tl ? (int)L - nwg : 0;
        int wgid = tl ? 0 : (int)L; { const int q = nwg / NXCD, r = nwg % NXCD, xcd = wgid % NXCD, off = wgid / NXCD; wgid = (xcd < r ? xcd * (q + 1) : r * (q + 1) + (xcd - r) * q) + off; }
        const int nig = WGM * nN, gid = wgid / nig, fm = gid * WGM, gsz = (nM - fm) < WGM ? (nM - fm) : WGM;
        const int pm_ = fm + ((wgid % nig) % gsz), pn_ = (wgid % nig) / gsz, kc_ = j / nN;
        u.pm = tl ? nM : pm_; u.pn = tl ? j % nN : pn_; u.k0 = tl ? kc_ * 256 : 0; u.nt = tl ? 4 : ntK; u.kc = tl ? kc_ : -1;
        return true;
    }
};

template <class Epi>
__device__ __forceinline__ void gemm_phase(LAS unsigned char* lds, const Gemm g, const StaticOrder& S, const Epi& E, const int tid) {
    const int wid = __builtin_amdgcn_readfirstlane(tid >> 6), lane = tid & 63, wr = wid >> 2, wc = wid & 3, fr = lane & 15, fq = lane >> 4;
    const int K = g.K;
    unsigned voffA[2];
#pragma unroll
    for (int i = 0; i < 2; ++i) { int R, C; stage_rc(tid * 16 + i * 8192, R, C); voffA[i] = (unsigned)(R * K + C) * 2u; }
    const size_t kstep = (size_t)(BK * 2);
    const size_t hstep = (size_t)HALF * K * 2;
    const size_t tstep = 2 * hstep;
    const unsigned ldsw = (unsigned)wid * 1024u;
    const int aoff = lds_byte(wr * 64 + fr, fq * 8), boff = lds_byte(wc * 32 + fr, fq * 8);
#define PG8_SA(b, h) (((b) * 2 + (h)) * HTB)
#define PG8_SB(b, h) ((4 + (b) * 2 + (h)) * HTB)
#define PG8_STAGE(bufoff, gbase, voff) do { _Pragma("unroll") for (int _i = 0; _i < 2; ++_i) \
        __builtin_amdgcn_global_load_lds((const unsigned*)((const char*)(gbase) + (voff)[_i]), (LAS unsigned*)(lds + (bufoff) + ldsw + _i * 8192), 16, 0, 0); } while (0)
#define PG8_LDA(dst, b, h) do { _Pragma("unroll") for (int m = 0; m < 4; ++m) _Pragma("unroll") for (int k = 0; k < 2; ++k) dst[m][k] = *(const LAS bf16x8*)(lds + PG8_SA(b, h) + aoff + m * 2048 + k * 1024); } while (0)
#define PG8_LDB(dst, b, h) do { _Pragma("unroll") for (int n = 0; n < 2; ++n) _Pragma("unroll") for (int k = 0; k < 2; ++k) dst[n][k] = *(const LAS bf16x8*)(lds + PG8_SB(b, h) + boff + n * 2048 + k * 1024); } while (0)
#define PG8_MMA(ai, bj, At, Bt) do { __builtin_amdgcn_s_setprio(1); _Pragma("unroll") for (int m = 0; m < 4; ++m) _Pragma("unroll") for (int n = 0; n < 2; ++n) _Pragma("unroll") for (int k = 0; k < 2; ++k) \
        acc[ai][bj][m][n] = __builtin_amdgcn_mfma_f32_16x16x32_bf16(Bt[n][k], At[m][k], acc[ai][bj][m][n], 0, 0, 0); __builtin_amdgcn_s_setprio(0); } while (0)
#define PG8_WAIT_V(n) asm volatile("s_waitcnt vmcnt(" #n ")" ::: "memory")
#define PG8_WAIT_L(n) asm volatile("s_waitcnt lgkmcnt(" #n ")" ::: "memory")
#define PG8_BAR __builtin_amdgcn_s_barrier()
#define PG8_SCHED __builtin_amdgcn_sched_barrier(0)
    Unit cur, nxt; int ui = 0;
    if (!S.next(0, cur)) return;
    f32x4 acc[2][2][4][2];
#pragma unroll
    for (int a = 0; a < 2; ++a)
#pragma unroll
        for (int b = 0; b < 2; ++b)
#pragma unroll
            for (int m = 0; m < 4; ++m)
#pragma unroll
                for (int n = 0; n < 2; ++n) acc[a][b][m][n] = (f32x4){0.f, 0.f, 0.f, 0.f};
    bf16x8 At[4][2], B0[2][2], B1[2][2];
    const char* cA = (const char*)g.A + (size_t)cur.pm * tstep + (size_t)cur.k0 * 2; const char* cB = (const char*)g.Bt + (size_t)cur.pn * tstep + (size_t)cur.k0 * 2;
    PG8_STAGE(PG8_SB(0, 0), cB, voffA); PG8_STAGE(PG8_SA(0, 0), cA, voffA); PG8_STAGE(PG8_SB(0, 1), cB + hstep, voffA); PG8_STAGE(PG8_SA(0, 1), cA + hstep, voffA);
    if (wr == 1) PG8_BAR;
    PG8_WAIT_V(4); PG8_BAR;
    PG8_STAGE(PG8_SB(1, 0), cB + kstep, voffA); PG8_STAGE(PG8_SA(1, 0), cA + kstep, voffA); PG8_STAGE(PG8_SB(1, 1), cB + hstep + kstep, voffA);
    PG8_WAIT_V(6); PG8_BAR;
    for (;;) {
        const bool has_next = S.next(ui + 1, nxt);
        const char* nA = has_next ? (const char*)g.A + (size_t)nxt.pm * tstep + (size_t)nxt.k0 * 2 : cA; const char* nB = has_next ? (const char*)g.Bt + (size_t)nxt.pn * tstep + (size_t)nxt.k0 * 2 : cB;
        const int nt = cur.nt;
        for (int t = 0; t < nt; t += 2) {
            const bool last = (t == nt - 2);
            const char* a1 = cA + (size_t)(t + 1) * kstep;
            const char* a2 = last ? nA : cA + (size_t)(t + 2) * kstep; const char* b2 = last ? nB : cB + (size_t)(t + 2) * kstep;
            const char* a3 = a2 + kstep; const char* b3 = b2 + kstep;
            PG8_LDB(B0, 0, 0); PG8_SCHED; PG8_LDA(At, 0, 0); PG8_STAGE(PG8_SA(1, 1), a1 + hstep, voffA);
            PG8_WAIT_L(8); PG8_BAR; PG8_WAIT_L(0); PG8_MMA(0, 0, At, B0); PG8_BAR; PG8_SCHED;
            PG8_LDB(B1, 0, 1); PG8_STAGE(PG8_SB(0, 0), b2, voffA);
            PG8_BAR; PG8_WAIT_L(0); PG8_MMA(0, 1, At, B1); PG8_BAR;
            PG8_LDA(At, 0, 1); PG8_STAGE(PG8_SA(0, 0), a2, voffA);
            PG8_BAR; PG8_WAIT_L(0); PG8_MMA(1, 0, At, B0); PG8_BAR; PG8_SCHED;
            PG8_STAGE(PG8_SB(0, 1), b2 + hstep, voffA);
            PG8_WAIT_V(6); PG8_BAR; PG8_MMA(1, 1, At, B1); PG8_BAR;
            PG8_LDB(B0, 1, 0); PG8_SCHED; PG8_LDA(At, 1, 0); PG8_STAGE(PG8_SA(0, 1), a2 + hstep, voffA);
            PG8_WAIT_L(8); PG8_BAR; PG8_WAIT_L(0); PG8_MMA(0, 0, At, B0); PG8_BAR; PG8_SCHED;
            PG8_LDB(B1, 1, 1); PG8_STAGE(PG8_SB(1, 0), b3, voffA);
            PG8_BAR; PG8_WAIT_L(0); PG8_MMA(0, 1, At, B1); PG8_BAR;
            PG8_LDA(At, 1, 1); PG8_STAGE(PG8_SA(1, 0), a3, voffA);
            PG8_BAR; PG8_WAIT_L(0); PG8_MMA(1, 0, At, B0); PG8_BAR; PG8_SCHED;
            PG8_STAGE(PG8_SB(1, 1), b3 + hstep, voffA);
            PG8_WAIT_V(6); PG8_BAR; PG8_MMA(1, 1, At, B1); PG8_BAR;
        }
        E(acc, cur, wr, wc, fr, fq);
        if (!has_next) break;
#pragma unroll
        for (int a = 0; a < 2; ++a)
#pragma unroll
            for (int b = 0; b < 2; ++b)
#pragma unroll
                for (int m = 0; m < 4; ++m)
#pragma unroll
                    for (int n = 0; n < 2; ++n) acc[a][b][m][n] = (f32x4){0.f, 0.f, 0.f, 0.f};
        cur = nxt; cA = nA; cB = nB; ++ui;
    }
    PG8_WAIT_V(0);
    if (wr == 0) PG8_BAR;
    PG8_BAR;
#undef PG8_SA
#undef PG8_SB
#undef PG8_STAGE
#undef PG8_LDA
#undef PG8_LDB
#undef PG8_MMA
#undef PG8_WAIT_V
#undef PG8_WAIT_L
#undef PG8_BAR
#undef PG8_SCHED
}
}
using pg8::Unit;

struct Epi {
    int mode, ldo; float scale; GAS unsigned char* ws;
    __device__ __forceinline__ void operator()(const f32x4 (&acc)[2][2][4][2], const Unit& u, int wr, int wc, int fr, int fq) const {
        const int row0 = u.pm * 256 + wr * 64 + fr, col0 = u.pn * 256 + wc * 32 + 4 * fq;
        const GAS float* ssq_in = (const GAS float*)(ws + WS_SSQ); GAS float* ssq_out = (GAS float*)(ws + WS_SSQ); GAS float* xf = (GAS float*)(ws + WS_XF); GAS bf16_t* xb = (GAS bf16_t*)(ws + WS_XB);
        GAS float* part = (GAS float*)(ws + WS_PART); GAS bf16_t* O = (GAS bf16_t*)(ws + (mode == 3 ? WS_LRAW : WS_PROJ));
        if (u.kc >= 0) {
#pragma unroll
            for (int ai = 0; ai < 2; ++ai)
#pragma unroll
                for (int m = 0; m < 4; ++m) {
                    GAS float* rp = part + ((size_t)u.kc * 256 + (wr * 64 + fr + ai * 128 + m * 16)) * 1024 + col0;
#pragma unroll
                    for (int bj = 0; bj < 2; ++bj)
#pragma unroll
                        for (int n = 0; n < 2; ++n) *(GAS f32x4*)(rp + bj * 128 + n * 16) = acc[ai][bj][m][n];
                }
        } else if (mode == 0) {
#pragma unroll
            for (int ai = 0; ai < 2; ++ai)
#pragma unroll
                for (int m = 0; m < 4; ++m) {
                    const int row = row0 + ai * 128 + m * 16; const float rs = rstd_of(ssq_in, row);
#pragma unroll
                    for (int bj = 0; bj < 2; ++bj) {
                        const int hid = (u.pn * 256 + bj * 128 + wc * 32) / 2 + 4 * fq;
                        const f32x4 gg = acc[ai][bj][m][0] * rs, uu = acc[ai][bj][m][1] * rs;
                        u32x2 w; w.x = pk2(siluf_(gg.x) * uu.x, siluf_(gg.y) * uu.y); w.y = pk2(siluf_(gg.z) * uu.z, siluf_(gg.w) * uu.w);
                        *(GAS u32x2*)(O + (size_t)row * FF + hid) = w;
                    }
                }
        } else if (mode == 1) {
#pragma unroll
            for (int ai = 0; ai < 2; ++ai)
#pragma unroll
                for (int m = 0; m < 4; ++m) {
                    const int row = row0 + ai * 128 + m * 16; float ss = 0.f;
#pragma unroll
                    for (int bj = 0; bj < 2; ++bj)
#pragma unroll
                        for (int n = 0; n < 2; ++n) {
                            const int c = col0 + bj * 128 + n * 16;
                            GAS u32x2* xp = (GAS u32x2*)(xb + (size_t)row * D + c);
                            const u32x2 xo = *xp; f32x4 x = {bflo(xo.x), bfhi(xo.x), bflo(xo.y), bfhi(xo.y)}; x = x + acc[ai][bj][m][n] * scale;
                            u32x2 w; w.x = pk2(x.x, x.y); w.y = pk2(x.z, x.w); *xp = w;
                            ss += (x.x * x.x + x.y * x.y) + (x.z * x.z + x.w * x.w);
                        }
                    ss += __shfl_xor(ss, 16); ss += __shfl_xor(ss, 32);
                    if (fq == 0) ssq_out[(size_t)row * 16 + u.pn * 4 + wc] = ss;
                }
        } else {
#pragma unroll
            for (int ai = 0; ai < 2; ++ai)
#pragma unroll
                for (int m = 0; m < 4; ++m) {
                    const int row = row0 + ai * 128 + m * 16; const float rs = mode == 2 ? rstd_of(ssq_in, row) : 1.0f;
#pragma unroll
                    for (int bj = 0; bj < 2; ++bj)
#pragma unroll
                        for (int n = 0; n < 2; ++n) {
                            const int c = col0 + bj * 128 + n * 16; const f32x4 v = acc[ai][bj][m][n] * rs;
                            u32x2 w; w.x = pk2(v.x, v.y); w.y = pk2(v.z, v.w); *(GAS u32x2*)(O + (size_t)row * ldo + c) = w;
                        }
                }
        }
    }
};

__device__ __forceinline__ int map_col(int n, int kind) {
    if (kind == 1) return ((n >> 4) << 5) + (n & 15);
    if (kind == 2) return ((n >> 4) << 5) + 16 + (n & 15);
    if (kind == 3) return n < 2048 ? n : (n < 2064 ? 3072 + (n - 2048) : n - 16);
    return n;
}
struct TItem { const GAS float* W; const GAS float* gsc; GAS bf16_t* WT; int K, Nsrc, kind, k0, n0; };
__device__ __forceinline__ void titem_load(const TItem& t, f32x4 (&v)[8], int lane) {
    const int nq = t.n0 + (lane & 7) * 4;
#pragma unroll
    for (int i = 0; i < 8; ++i) { const int kk = 8 * i + (lane >> 3); v[i] = (nq < t.Nsrc) ? *(const GAS f32x4*)(t.W + (size_t)(t.k0 + kk) * t.Nsrc + nq) : (f32x4){0.f, 0.f, 0.f, 0.f}; }
}
__device__ __forceinline__ void titem_store(const TItem& t, const f32x4 (&v)[8], LAS float* scr, int lane) {
#pragma unroll
    for (int i = 0; i < 8; ++i) {
        const int kk = 8 * i + (lane >> 3); const float g = t.gsc ? t.gsc[t.k0 + kk] : 1.0f;
        LAS float* d = scr + kk * 33 + (lane & 7) * 4;
        d[0] = v[i].x * g; d[1] = v[i].y * g; d[2] = v[i].z * g; d[3] = v[i].w * g;
    }
    LDS_WAIT();
    const int c = lane & 7;
#pragma unroll
    for (int j = 0; j < 4; ++j) {
        const int nl = (lane >> 3) + 8 * j, n = t.n0 + nl;
        if (n < t.Nsrc) {
            const LAS float* s = scr + (8 * c) * 33 + nl;
            u32x4 o; o.x = pk2(s[0 * 33], s[1 * 33]); o.y = pk2(s[2 * 33], s[3 * 33]); o.z = pk2(s[4 * 33], s[5 * 33]); o.w = pk2(s[6 * 33], s[7 * 33]);
            *(GAS u32x4*)(t.WT + (size_t)map_col(n, t.kind) * t.K + t.k0 + 8 * c) = o;
        }
    }
    LDS_WAIT();
}
__device__ __forceinline__ TItem titem_decode(const Ctx& p, int it) {
    GAS unsigned char* ws = p.ws;
    constexpr int IT_G = 176, N_G = 8 * IT_G, IT_E = 240, N_E = 2 * IT_E, IT_O = 200, N_O = 2 * IT_O, IT_W = 64;
    TItem t; int r = it, nblk;
    if (r < 2 * N_G) {
        const int up = r >= N_G; if (up) r -= N_G;
        const int mat = r / IT_G, l = mat >> 1, f = mat & 1; r %= IT_G;
        t.W = p.in(f ? (up ? I_F2U : I_F2G) : (up ? I_F1U : I_F1G)) + (size_t)l * D * FF; t.gsc = p.in(f ? I_NF2 : I_NF1) + l * D;
        t.WT = (GAS bf16_t*)(ws + WS_WGU) + (size_t)mat * 5632 * 1024; t.K = D; t.Nsrc = FF; t.kind = up ? 2 : 1;
    } else if ((r -= 2 * N_G) < N_G) {
        const int mat = r / IT_G, l = mat >> 1, f = mat & 1; r %= IT_G;
        t.W = p.in(f ? I_F2D : I_F1D) + (size_t)l * FF * D; t.gsc = nullptr; t.WT = (GAS bf16_t*)(ws + WS_WD) + (size_t)mat * 1024 * FF; t.K = FF; t.Nsrc = D; t.kind = 0;
    } else if ((r -= N_G) < N_E) {
        const int mat = r / IT_E; r %= IT_E;
        t.W = p.in(I_EWIN) + (size_t)mat * D * EPROJ; t.gsc = p.in(I_NMIX) + (2 * mat) * D; t.WT = (GAS bf16_t*)(ws + WS_WINE) + (size_t)mat * EPROJ * 1024; t.K = D; t.Nsrc = EPROJ; t.kind = 0;
    } else if ((r -= N_E) < N_O) {
        const int mat = r / IT_O; r %= IT_O;
        t.W = p.in(I_OWIN) + (size_t)mat * D * OSRC; t.gsc = p.in(I_NMIX) + (2 * mat + 1) * D; t.WT = (GAS bf16_t*)(ws + WS_WINO) + (size_t)mat * OPROJ * 1024; t.K = D; t.Nsrc = OSRC; t.kind = 3;
    } else {
        r -= N_O; const int mat = r / IT_W; r %= IT_W;
        t.W = (mat & 1) ? p.in(I_OWOUT) + (size_t)(mat >> 1) * D * D : p.in(I_EWOUT) + (size_t)(mat >> 1) * D * D; t.gsc = nullptr;
        t.WT = (GAS bf16_t*)(ws + WS_WOUT) + (size_t)mat * D * D; t.K = D; t.Nsrc = D; t.kind = 0;
    }
    nblk = (t.Nsrc + 127) / 128; t.k0 = 128 * (r / nblk); t.n0 = 128 * (r % nblk);
    return t;
}

__device__ __forceinline__ void phase_p0(const Ctx& p, LAS unsigned char* lds) {
    const int tid = p.tid, lane = tid & 63, wave = tid >> 6;
    const int gw = p.bid * NWAVES + wave, NGW = p.G * NWAVES;
    GAS unsigned char* ws = p.ws;
    GAS bf16_t* WINO = (GAS bf16_t*)(ws + WS_WINO); GAS bf16_t* WLORA = (GAS bf16_t*)(ws + WS_WLORA);
    constexpr int NITEMS = 3 * 8 * 1408 + 2 * 1920 + 2 * 1552 + 4 * 512;
    {
        constexpr int NTILES = 3 * 8 * 176 + 2 * 240 + 2 * 200 + 4 * 64;
        LAS float* tile = (LAS float*)lds;
        const int q = tid & 31, r0 = tid >> 5;
        for (int tix = p.bid; tix < NTILES; tix += p.G) {
            const TItem t = titem_decode(p, tix);
            const int nq = t.n0 + 4 * q;
            f32x4 v[8]; float g8[8];
#pragma unroll
            for (int i = 0; i < 8; ++i) { const int kk = r0 + 16 * i; v[i] = (nq < t.Nsrc) ? *(const GAS f32x4*)(t.W + (size_t)(t.k0 + kk) * t.Nsrc + nq) : (f32x4){0.f, 0.f, 0.f, 0.f}; g8[i] = t.gsc ? t.gsc[t.k0 + kk] : 1.0f; }
            __syncthreads();
#pragma unroll
            for (int i = 0; i < 8; ++i) { LAS float* d = tile + (r0 + 16 * i) * 129 + 4 * q; d[0] = v[i].x * g8[i]; d[1] = v[i].y * g8[i]; d[2] = v[i].z * g8[i]; d[3] = v[i].w * g8[i]; }
            __syncthreads();
#pragma unroll
            for (int j = 0; j < 4; ++j) {
                const int id = tid + NTHREADS * j, nl = id >> 4, c16 = id & 15, n = t.n0 + nl;
                if (n < t.Nsrc) {
                    const LAS float* sp = tile + (8 * c16) * 129 + nl;
                    u32x4 o; o.x = pk2(sp[0 * 129], sp[1 * 129]); o.y = pk2(sp[2 * 129], sp[3 * 129]); o.z = pk2(sp[4 * 129], sp[5 * 129]); o.w = pk2(sp[6 * 129], sp[7 * 129]);
                    *(GAS u32x4*)(t.WT + (size_t)map_col(n, t.kind) * t.K + t.k0 + 8 * c16) = o;
                }
            }
        }
        __syncthreads();
    }
    const size_t gt = (size_t)p.bid * NTHREADS + tid, GT = (size_t)p.G * NTHREADS;
    for (size_t i = gt; i < (size_t)2 * 240 * 1024 / 2; i += GT) {
        const size_t mat = i / (240 * 512), r = i % (240 * 512);
        ((GAS unsigned*)(WINO + (size_t)mat * OPROJ * 1024 + (size_t)OSRC * 1024))[r] = 0u;
    }
    for (size_t i = gt; i < (size_t)2 * 1536 * 256; i += GT) {
        const int e = (int)(i / (1536 * 256)), n = (int)((i / 256) % 1536), k = (int)(i % 256), region = n >> 9, ch = n & 511;
        float v = 0.f;
        if (region == 0) { if (k < 64) v = p.in(I_W2)[((size_t)e * 64 + k) * 512 + ch]; }
        else if (region == 1) { if (k >= 64 && k < 128) v = p.in(I_A2)[((size_t)e * 64 + (k - 64)) * 512 + ch]; }
        else { if (k >= 128) v = p.in(I_G2)[((size_t)e * 128 + (k - 128)) * 512 + ch]; }
        WLORA[i] = (bf16_t)(pk2(v, 0.f) & 0xffffu);
    }
    GAS float* xf = (GAS float*)(ws + WS_XF); GAS bf16_t* xb = (GAS bf16_t*)(ws + WS_XB); GAS float* ssq = (GAS float*)(ws + WS_SSQ);
    for (int m = gw; m < MT; m += NGW) {
        const GAS float* src;
        if (m < MP) { const int b = m / TP, t = m % TP; src = t < 16 ? p.in(I_META) + (size_t)t * D : p.in(I_XP) + ((size_t)b * 2048 + (t - 16)) * D; }
        else src = p.in(I_XS) + (size_t)(m - MP) * D;
        float ss = 0.f;
#pragma unroll
        for (int j = 0; j < 4; ++j) {
            const int c = 4 * lane + 256 * j; const f32x4 x = *(const GAS f32x4*)(src + c);
            u32x2 w; w.x = pk2(x.x, x.y); w.y = pk2(x.z, x.w); *(GAS u32x2*)(xb + (size_t)m * D + c) = w;
            ss += (x.x * x.x + x.y * x.y) + (x.z * x.z + x.w * x.w);
        }
        ss = wave_sum(ss);
        if (lane < 16) ssq[(size_t)m * 16 + lane] = lane == 0 ? ss : 0.f;
        if (lane == 0) ((GAS float*)(ws + WS_RSTD))[m] = rsqrtf(ss * (1.0f / 1024.0f) + 1e-6f);
    }
}

__device__ __forceinline__ float lbval(const Ctx& p, int e, int ch) { return e == 0 ? 0.f : __builtin_amdgcn_rcpf(1.0f + __expf(p.in(I_LB)[ch] - p.in(I_LB)[512 + ch])); }

__device__ __forceinline__ void phase_fprep(const Ctx& p, int odd, int idx) {
    GAS unsigned char* ws = p.ws;
    const GAS bf16_t* proj = (const GAS bf16_t*)(ws + WS_PROJ);
    GAS bf16_t* QDg = (GAS bf16_t*)(ws + WS_MIXB); GAS bf16_t* KDg = QDg + (size_t)MT * 512; GAS bf16_t* KDTg = (GAS bf16_t*)(ws + WS_KDT); GAS float* ELg = (GAS float*)(ws + WS_ELG);
    const int LDP = odd ? OPROJ : EPROJ;
    constexpr float SC = 0.08838834764831845f;
    const int tid = p.tid, lane = tid & 63, wv = tid >> 6, cg = lane & 15, tq = lane >> 4, c4 = (wv * 16 + cg) * 4;
    f32x4 gu[16]; f32x4 gbv = {0.f, 0.f, 0.f, 0.f}; float lb[4] = {0.f, 0.f, 0.f, 0.f};
    if (odd) {
#pragma unroll
        for (int r = 0; r < 16; ++r) gu[r] = *(const GAS f32x4*)(p.in(I_GUP) + ((size_t)idx * 16 + r) * 512 + c4);
        gbv = *(const GAS f32x4*)(p.in(I_GB) + (size_t)idx * 512 + c4);
    } else {
#pragma unroll
        for (int r = 0; r < 16; ++r) gu[r] = (f32x4){0.f, 0.f, 0.f, 0.f};
#pragma unroll
        for (int i = 0; i < 4; ++i) lb[i] = lbval(p, idx, c4 + i);
    }
    for (int pair = p.bid; pair < 8 * 65; pair += p.G) {
        const int b = pair / 65, ch = pair % 65, tok0 = ch * 32 + tq * 8;
        const size_t m0 = (size_t)b * TP + tok0;
        u32x2 qv[8], kv[8];
#pragma unroll
        for (int j = 0; j < 8; ++j) { const GAS bf16_t* row = proj + (m0 + j) * LDP; qv[j] = *(const GAS u32x2*)(row + c4); kv[j] = *(const GAS u32x2*)(row + 512 + c4); }
        f32x4 lf[8];
        if (odd) {
            u32x4 g0[8], g1[8];
#pragma unroll
            for (int j = 0; j < 8; ++j) { const GAS bf16_t* row = proj + (m0 + j) * LDP; g0[j] = *(const GAS u32x4*)(row + 3072); g1[j] = *(const GAS u32x4*)(row + 3080); }
#pragma unroll
            for (int j = 0; j < 8; ++j) {
                const float gd[16] = {bflo(g0[j].x), bfhi(g0[j].x), bflo(g0[j].y), bfhi(g0[j].y), bflo(g0[j].z), bfhi(g0[j].z), bflo(g0[j].w), bfhi(g0[j].w),
                                      bflo(g1[j].x), bfhi(g1[j].x), bflo(g1[j].y), bfhi(g1[j].y), bflo(g1[j].z), bfhi(g1[j].z), bflo(g1[j].w), bfhi(g1[j].w)};
                f32x4 gk = gbv;
#pragma unroll
                for (int r = 0; r < 16; ++r) gk = gk + gu[r] * gd[r];
                lf[j].x = (fminf(gk.x, 0.f) - __logf(1.0f + __expf(-fabsf(gk.x)))) * 0.0625f; lf[j].y = (fminf(gk.y, 0.f) - __logf(1.0f + __expf(-fabsf(gk.y)))) * 0.0625f;
                lf[j].z = (fminf(gk.z, 0.f) - __logf(1.0f + __expf(-fabsf(gk.z)))) * 0.0625f; lf[j].w = (fminf(gk.w, 0.f) - __logf(1.0f + __expf(-fabsf(gk.w)))) * 0.0625f;
            }
        } else {
#pragma unroll
            for (int j = 0; j < 8; ++j) {
                const float fa[4] = {bflo(kv[j].x), bfhi(kv[j].x), bflo(kv[j].y), bfhi(kv[j].y)}; float l4[4];
#pragma unroll
                for (int i = 0; i < 4; ++i) l4[i] = __logf(1.0f - (1.0f - lb[i]) * __builtin_amdgcn_rcpf(1.0f + __expf(fa[i])));
                lf[j] = (f32x4){l4[0], l4[1], l4[2], l4[3]};
            }
        }
        f32x4 kk[8];
#pragma unroll
        for (int j = 0; j < 8; ++j) {
            const bool ok = tok0 + j < TP;
            if (odd) kk[j] = (f32x4){bflo(kv[j].x), bfhi(kv[j].x), bflo(kv[j].y), bfhi(kv[j].y)};
            else kk[j] = (f32x4){1.0f - __expf(lf[j].x), 1.0f - __expf(lf[j].y), 1.0f - __expf(lf[j].z), 1.0f - __expf(lf[j].w)};
            if (!ok) { lf[j] = (f32x4){0.f, 0.f, 0.f, 0.f}; kk[j] = lf[j]; qv[j] = (u32x2){0u, 0u}; }
            if (j) lf[j] = lf[j] + lf[j - 1];
        }
        f32x4 pre = {0.f, 0.f, 0.f, 0.f};
        {
            const float tot[4] = {lf[7].x, lf[7].y, lf[7].z, lf[7].w}; float pr4[4];
#pragma unroll
            for (int i = 0; i < 4; ++i) {
                const float p0 = __int_as_float(__builtin_amdgcn_ds_bpermute(cg << 2, __float_as_int(tot[i]))), p1 = __int_as_float(__builtin_amdgcn_ds_bpermute((cg + 16) << 2, __float_as_int(tot[i]))),
                            p2 = __int_as_float(__builtin_amdgcn_ds_bpermute((cg + 32) << 2, __float_as_int(tot[i])));
                pr4[i] = (tq > 0 ? p0 : 0.f) + (tq > 1 ? p1 : 0.f) + (tq > 2 ? p2 : 0.f);
            }
            pre = (f32x4){pr4[0], pr4[1], pr4[2], pr4[3]};
        }
        u32x4 kt[4];
        unsigned ktw[4][4];
#pragma unroll
        for (int j = 0; j < 8; j += 2) {
            f32x4 kd2[2];
#pragma unroll
            for (int jj = 0; jj < 2; ++jj) {
                const f32x4 cu4 = lf[j + jj] + pre; const float cu[4] = {fmaxf(cu4.x, -85.0f), fmaxf(cu4.y, -85.0f), fmaxf(cu4.z, -85.0f), fmaxf(cu4.w, -85.0f)};
                const float q4[4] = {bflo(qv[j + jj].x), bfhi(qv[j + jj].x), bflo(qv[j + jj].y), bfhi(qv[j + jj].y)}; const float k4[4] = {kk[j + jj].x, kk[j + jj].y, kk[j + jj].z, kk[j + jj].w};
                float qd[4], kd[4];
#pragma unroll
                for (int i = 0; i < 4; ++i) { qd[i] = q4[i] * SC * __expf(cu[i]); kd[i] = k4[i] * __expf(-cu[i]); }
                kd2[jj] = (f32x4){kd[0], kd[1], kd[2], kd[3]};
                if (tok0 + j + jj < TP) {
                    *(GAS u32x2*)(QDg + (m0 + j + jj) * 512 + c4) = (u32x2){pk2(qd[0], qd[1]), pk2(qd[2], qd[3])};
                    *(GAS u32x2*)(KDg + (m0 + j + jj) * 512 + c4) = (u32x2){pk2(kd[0], kd[1]), pk2(kd[2], kd[3])};
                }
            }
            ktw[0][j >> 1] = pk2(kd2[0].x, kd2[1].x); ktw[1][j >> 1] = pk2(kd2[0].y, kd2[1].y); ktw[2][j >> 1] = pk2(kd2[0].z, kd2[1].z); ktw[3][j >> 1] = pk2(kd2[0].w, kd2[1].w);
        }
#pragma unroll
        for (int i = 0; i < 4; ++i) { kt[i] = (u32x4){ktw[i][0], ktw[i][1], ktw[i][2], ktw[i][3]};
            *(GAS u32x4*)(KDTg + (((size_t)b * 65 + ch) * 512 + c4 + i) * 32 + tq * 8) = kt[i]; }
        if (tq == 3) {
            const f32x4 ce = lf[7] + pre;
            *(GAS f32x4*)(ELg + ((size_t)b * 65 + ch) * 512 + c4) = (f32x4){__expf(fmaxf(ce.x, -85.0f)), __expf(fmaxf(ce.y, -85.0f)), __expf(fmaxf(ce.z, -85.0f)), __expf(fmaxf(ce.w, -85.0f))};
        }
    }
}

__device__ __forceinline__ void phase_lin(const Ctx& p, int e) {
    GAS unsigned char* ws = p.ws;
    const GAS bf16_t* proj = (const GAS bf16_t*)(ws + WS_PROJ); GAS bf16_t* lin = (GAS bf16_t*)(ws + WS_LIN);
    const GAS float* mu = p.in(I_MU) + (size_t)e * 1792; const GAS float* sst = p.in(I_SS) + (size_t)e * NS * 1792;
    const size_t gt = (size_t)p.bid * NTHREADS + p.tid, GT = (size_t)p.G * NTHREADS;
    for (size_t i = gt; i < (size_t)MT * 32; i += GT) {
        const int m = (int)(i >> 5), j8 = (int)(i & 31) * 8;
        const u32x4 cu = *(const GAS u32x4*)(proj + (size_t)m * EPROJ + 3584 + j8);
        float cur[8] = {bflo(cu.x), bfhi(cu.x), bflo(cu.y), bfhi(cu.y), bflo(cu.z), bfhi(cu.z), bflo(cu.w), bfhi(cu.w)};
        float prv[8];
        if (m >= MP) { const GAS float* s = sst + (size_t)(m - MP) * 1792 + 1536 + j8; const f32x4 a = *(const GAS f32x4*)s, b = *(const GAS f32x4*)(s + 4);
            prv[0] = a.x; prv[1] = a.y; prv[2] = a.z; prv[3] = a.w; prv[4] = b.x; prv[5] = b.y; prv[6] = b.z; prv[7] = b.w; }
        else if ((m % TP) == 0) {
#pragma unroll
            for (int j = 0; j < 8; ++j) prv[j] = 0.f; }
        else { const u32x4 pu = *(const GAS u32x4*)(proj + (size_t)(m - 1) * EPROJ + 3584 + j8);
            prv[0] = bflo(pu.x); prv[1] = bfhi(pu.x); prv[2] = bflo(pu.y); prv[3] = bfhi(pu.y); prv[4] = bflo(pu.z); prv[5] = bfhi(pu.z); prv[6] = bflo(pu.w); prv[7] = bfhi(pu.w); }
        const f32x4 m0 = *(const GAS f32x4*)(mu + 1536 + j8), m1 = *(const GAS f32x4*)(mu + 1536 + j8 + 4);
        const float mm[8] = {m0.x, m0.y, m0.z, m0.w, m1.x, m1.y, m1.z, m1.w};
        float o[8];
#pragma unroll
        for (int j = 0; j < 8; ++j) { const float x = cur[j] + (prv[j] - cur[j]) * mm[j]; o[j] = j8 < 64 ? 1.0f - 2.0f * __builtin_amdgcn_rcpf(1.0f + __expf(2.0f * x)) : (j8 < 128 ? x : sigmoidf_(x)); }
        u32x4 w; w.x = pk2(o[0], o[1]); w.y = pk2(o[2], o[3]); w.z = pk2(o[4], o[5]); w.w = pk2(o[6], o[7]);
        *(GAS u32x4*)(lin + (size_t)m * 256 + j8) = w;
    }
    for (size_t i = gt; i < (size_t)(NB + NS) * 1792; i += GT) {
        const int s = (int)(i / 1792), c = (int)(i % 1792);
        if (s < NB) p.out[O_SP + ((size_t)e * NB + s) * 1792 + c] = bf2f(proj[((size_t)s * TP + TP - 1) * EPROJ + 2048 + c]);
        else p.out[O_SSH + ((size_t)e * NS + (s - NB)) * 1792 + c] = bf2f(proj[((size_t)MP + (s - NB)) * EPROJ + 2048 + c]);
    }
}

constexpr int TC = 32, NCH = (TP + TC - 1) / TC;

template <bool GLA>
__device__ __forceinline__ void glalike_sample(const Ctx& p, int idx  , int i, int h, LAS unsigned char* lds) {
    constexpr int DV = GLA ? 256 : 128, LDP = GLA ? OPROJ : EPROJ, KR = GLA ? 8 : 16, RPT = 128 / KR, VT = DV / 4;
    const int tid = p.tid, m = MP + i;
    GAS unsigned char* ws = p.ws;
    const GAS bf16_t* pr = (const GAS bf16_t*)(ws + WS_PROJ) + (size_t)m * LDP; GAS bf16_t* oraw = (GAS bf16_t*)(ws + WS_ORAW);
    LAS float* sq = (LAS float*)lds; LAS float* sk = sq + 128; LAS float* sf = sk + 128; LAS float* sv = sf + 128; LAS float* red = sv + 256;
    __syncthreads();
    if (tid < 128) {
        const int ch = h * 128 + tid;
        if (!GLA) {
            const float qa = bf2f(pr[ch]), fa = bf2f(pr[512 + ch]); const float lb = lbval(p, idx, ch);
            const float kk = (1.0f - lb) / (1.0f + __expf(fa));
            sq[tid] = qa * 0.08838834764831845f; sk[tid] = kk; sf[tid] = 1.0f - kk;
        } else {
            float gk = p.in(I_GB)[(size_t)idx * 512 + ch];
#pragma unroll
            for (int r = 0; r < 16; ++r) gk += bf2f(pr[3072 + r]) * p.in(I_GUP)[((size_t)idx * 16 + r) * 512 + ch];
            const float ls = fminf(gk, 0.f) - __logf(1.0f + __expf(-fabsf(gk)));
            sq[tid] = bf2f(pr[ch]) * 0.08838834764831845f; sk[tid] = bf2f(pr[512 + ch]); sf[tid] = __expf(ls * 0.0625f);
        }
    }
    if (tid >= 128 && tid < 128 + DV) {
        const int c = tid - 128;
        if (!GLA) sv[c] = siluf_(bf2f(pr[1024 + h * 128 + c])); else sv[c] = bf2f(pr[1024 + h * 256 + c]);
    }
    __syncthreads();
    const int v4 = (tid % VT) * 4, kr = tid / VT;
    const size_t soff = ((((size_t)idx * NS + i) * 4 + h) * 128) * DV;
    const GAS float* Sin = p.in(GLA ? I_SG : I_SH) + soff; GAS float* Sout = p.out + (GLA ? O_GS : O_HS) + soff;
    const f32x4 vv = *(const LAS f32x4*)(sv + v4); f32x4 o = {0.f, 0.f, 0.f, 0.f};
#pragma unroll 4
    for (int jj = 0; jj < RPT; ++jj) {
        const int k = kr * RPT + jj;
        f32x4 s = *(const GAS f32x4*)(Sin + (size_t)k * DV + v4);
        s = s * sf[k] + vv * sk[k];
        *(GAS f32x4*)(Sout + (size_t)k * DV + v4) = s;
        o = o + s * sq[k];
    }
    *(LAS f32x4*)(red + kr * DV + v4) = o;
    __syncthreads();
    if (tid < DV) { float a = 0.f;
#pragma unroll
        for (int r = 0; r < KR; ++r) a += red[r * DV + tid];
        oraw[(size_t)m * 1024 + h * DV + tid] = f2bf_c(a); }
}

__device__ __forceinline__ void rwkv_sample(const Ctx& p, int e, int i, int h, LAS unsigned char* lds) {
    const int tid = p.tid, m = MP + i;
    GAS unsigned char* ws = p.ws;
    const GAS bf16_t* pb = (const GAS bf16_t*)(ws + WS_PROJ) + (size_t)m * EPROJ + 2048; GAS bf16_t* oraw = (GAS bf16_t*)(ws + WS_ORAW);
    const GAS bf16_t* lraw = (const GAS bf16_t*)(ws + WS_LRAW); GAS float* bsum = (GAS float*)(ws + WS_BSUM);
    LAS float* sr = (LAS float*)lds; LAS float* sw = sr + 64; LAS float* sk = sw + 64; LAS float* sn = sk + 64; LAS float* sa_ = sn + 64; LAS float* sv = sa_ + 64;
    __syncthreads();
    if (tid < 64) {
        const int c = h * 64 + tid;
        const GAS float* prev = p.in(I_SS) + ((size_t)e * NS + i) * 1792; const GAS float* mu = p.in(I_MU) + (size_t)e * 1792;
        const float xr = bf2f(pb[c]), xk = bf2f(pb[512 + c]), xv = bf2f(pb[1024 + c]);
        const float r = xr + (prev[c] - xr) * mu[c], k_ = xk + (prev[512 + c] - xk) * mu[512 + c], v = xv + (prev[1024 + c] - xv) * mu[1024 + c];
        const float a = sigmoidf_(p.in(I_A0)[e * 512 + c] + bf2f(lraw[(size_t)m * 1536 + 512 + c]));
        const float w = __expf(-0.60653066f * sigmoidf_(p.in(I_W0)[e * 512 + c] + bf2f(lraw[(size_t)m * 1536 + c])));
        const float kkw = k_ * p.in(I_KK)[e * 512 + c];
        const float nrm = fmaxf(sqrtf(wave_sum(kkw * kkw)), 1e-12f), kk = kkw / nrm;
        const float kmod = k_ * (1.0f + (a - 1.0f) * p.in(I_KA)[e * 512 + c]);
        const float bs = wave_sum(r * kmod * p.in(I_RK)[e * 512 + c]);
        if (tid == 0) bsum[(size_t)m * 8 + h] = bs;
        sr[tid] = r; sw[tid] = w; sk[tid] = kmod; sn[tid] = -kk; sa_[tid] = kk * a; sv[tid] = v;
    }
    __syncthreads();
    const int row = tid >> 3, l = tid & 7;
    const size_t soff = ((((size_t)e * NS + i) * 8 + h) * 64 + row) * 64 + 8 * l;
    const GAS float* Sin = p.in(I_SR) + soff; GAS float* Sout = p.out + O_RS + soff;
    f32x4 s0 = *(const GAS f32x4*)Sin, s1 = *(const GAS f32x4*)(Sin + 4);
    const f32x4 n0 = *(const LAS f32x4*)(sn + 8 * l), n1 = *(const LAS f32x4*)(sn + 8 * l + 4);
    float sa = (s0.x * n0.x + s0.y * n0.y) + (s0.z * n0.z + s0.w * n0.w) + (s1.x * n1.x + s1.y * n1.y) + (s1.z * n1.z + s1.w * n1.w);
    sa = allred8(sa);
    const f32x4 w0 = *(const LAS f32x4*)(sw + 8 * l), w1 = *(const LAS f32x4*)(sw + 8 * l + 4), a0 = *(const LAS f32x4*)(sa_ + 8 * l), a1 = *(const LAS f32x4*)(sa_ + 8 * l + 4);
    const f32x4 k0 = *(const LAS f32x4*)(sk + 8 * l), k1 = *(const LAS f32x4*)(sk + 8 * l + 4), r0 = *(const LAS f32x4*)(sr + 8 * l), r1 = *(const LAS f32x4*)(sr + 8 * l + 4);
    const float v = sv[row];
    s0 = s0 * w0 + a0 * sa + k0 * v; s1 = s1 * w1 + a1 * sa + k1 * v;
    float y = (s0.x * r0.x + s0.y * r0.y) + (s0.z * r0.z + s0.w * r0.w) + (s1.x * r1.x + s1.y * r1.y) + (s1.z * r1.z + s1.w * r1.w);
    y = allred8(y);
    if (l == 0) oraw[(size_t)m * 1024 + 512 + h * 64 + row] = f2bf_c(y);
    *(GAS f32x4*)Sout = s0; *(GAS f32x4*)(Sout + 4) = s1;
}

__device__ __forceinline__ void rwkv_prompt_scan(const Ctx& p, int e, int bh, int hf, LAS unsigned char* lds) {
    const int tid = p.tid, lane = tid & 63, wave = tid >> 6, b = bh >> 3, h = bh & 7;
    GAS unsigned char* ws = p.ws;
    const GAS bf16_t* proj = (const GAS bf16_t*)(ws + WS_PROJ); GAS bf16_t* oraw = (GAS bf16_t*)(ws + WS_ORAW);
    const GAS bf16_t* lraw = (const GAS bf16_t*)(ws + WS_LRAW); GAS float* bsum = (GAS float*)(ws + WS_BSUM);
    LAS float* st = (LAS float*)lds;
    __syncthreads();
    if (wave >= 4) {
        const int ts = tid - 256, s_st = ts >> 3, j8 = (ts & 7) * 8, c0 = h * 64 + j8;
        const GAS float* mu = p.in(I_MU) + (size_t)e * 1792;
        float mu_r[8], mu_k[8], mu_v[8], w0p[8], a0p[8], kkp[8], kap[8], rkp[8];
#pragma unroll
        for (int j = 0; j < 8; ++j) { mu_r[j] = mu[c0 + j]; mu_k[j] = mu[512 + c0 + j]; mu_v[j] = mu[1024 + c0 + j]; w0p[j] = p.in(I_W0)[e * 512 + c0 + j]; a0p[j] = p.in(I_A0)[e * 512 + c0 + j];
            kkp[j] = p.in(I_KK)[e * 512 + c0 + j]; kap[j] = p.in(I_KA)[e * 512 + c0 + j]; rkp[j] = p.in(I_RK)[e * 512 + c0 + j]; }
        for (int c = 0; c < NCH; ++c) {
            {
                const int t = c * TC + s_st; const bool ok = t < TP; const size_t m = (size_t)b * TP + (ok ? t : 0);
                const GAS bf16_t* q = proj + m * EPROJ + 2048 + c0;
                const u32x4 cr = *(const GAS u32x4*)q, ck = *(const GAS u32x4*)(q + 512), cv = *(const GAS u32x4*)(q + 1024);
                u32x4 pr_ = {0u, 0u, 0u, 0u}, pk_ = pr_, pv_ = pr_;
                if (ok && t > 0) { pr_ = *(const GAS u32x4*)(q - EPROJ); pk_ = *(const GAS u32x4*)(q - EPROJ + 512); pv_ = *(const GAS u32x4*)(q - EPROJ + 1024); }
                const u32x4 av = *(const GAS u32x4*)(lraw + m * 1536 + 512 + c0), wv = *(const GAS u32x4*)(lraw + m * 1536 + c0);
                const float xr0[8] = {bflo(cr.x), bfhi(cr.x), bflo(cr.y), bfhi(cr.y), bflo(cr.z), bfhi(cr.z), bflo(cr.w), bfhi(cr.w)};
                const float xk0[8] = {bflo(ck.x), bfhi(ck.x), bflo(ck.y), bfhi(ck.y), bflo(ck.z), bfhi(ck.z), bflo(ck.w), bfhi(ck.w)};
                const float xv0[8] = {bflo(cv.x), bfhi(cv.x), bflo(cv.y), bfhi(cv.y), bflo(cv.z), bfhi(cv.z), bflo(cv.w), bfhi(cv.w)};
                const float qr[8] = {bflo(pr_.x), bfhi(pr_.x), bflo(pr_.y), bfhi(pr_.y), bflo(pr_.z), bfhi(pr_.z), bflo(pr_.w), bfhi(pr_.w)};
                const float qk[8] = {bflo(pk_.x), bfhi(pk_.x), bflo(pk_.y), bfhi(pk_.y), bflo(pk_.z), bfhi(pk_.z), bflo(pk_.w), bfhi(pk_.w)};
                const float qv[8] = {bflo(pv_.x), bfhi(pv_.x), bflo(pv_.y), bfhi(pv_.y), bflo(pv_.z), bfhi(pv_.z), bflo(pv_.w), bfhi(pv_.w)};
                const float ar[8] = {bflo(av.x), bfhi(av.x), bflo(av.y), bfhi(av.y), bflo(av.z), bfhi(av.z), bflo(av.w), bfhi(av.w)};
                const float wr_[8] = {bflo(wv.x), bfhi(wv.x), bflo(wv.y), bfhi(wv.y), bflo(wv.z), bfhi(wv.z), bflo(wv.w), bfhi(wv.w)};
                float xr[8], xk[8], xv[8], a[8], wd[8], kkw[8], kmod[8]; float ss = 0.f, bs = 0.f;
#pragma unroll
                for (int j = 0; j < 8; ++j) {
                    xr[j] = xr0[j] + (qr[j] - xr0[j]) * mu_r[j]; xk[j] = xk0[j] + (qk[j] - xk0[j]) * mu_k[j]; xv[j] = xv0[j] + (qv[j] - xv0[j]) * mu_v[j];
                    a[j] = sigmoidf_(ar[j] + a0p[j]); wd[j] = __expf(-0.60653066f * sigmoidf_(wr_[j] + w0p[j]));
                    kkw[j] = xk[j] * kkp[j]; ss += kkw[j] * kkw[j];
                    kmod[j] = xk[j] * ((a[j] - 1.0f) * kap[j] + 1.0f); bs += xr[j] * kmod[j] * rkp[j];
                }
                ss = allred8(ss); bs = allred8(bs);
                const float inv = rsqrtf(fmaxf(ss, 1e-24f));
                if (ok) {
                    if (hf == 0 && (ts & 7) == 0) bsum[m * 8 + h] = bs;
                    LAS float* sp = st + (c & 1) * (TC * 384) + s_st * 384 + j8;
                    *(LAS f32x4*)(sp) = (f32x4){xr[0], xr[1], xr[2], xr[3]}; *(LAS f32x4*)(sp + 4) = (f32x4){xr[4], xr[5], xr[6], xr[7]};
                    *(LAS f32x4*)(sp + 64) = (f32x4){wd[0], wd[1], wd[2], wd[3]}; *(LAS f32x4*)(sp + 68) = (f32x4){wd[4], wd[5], wd[6], wd[7]};
                    *(LAS f32x4*)(sp + 128) = (f32x4){kmod[0], kmod[1], kmod[2], kmod[3]}; *(LAS f32x4*)(sp + 132) = (f32x4){kmod[4], kmod[5], kmod[6], kmod[7]};
                    *(LAS f32x4*)(sp + 192) = (f32x4){-kkw[0] * inv, -kkw[1] * inv, -kkw[2] * inv, -kkw[3] * inv}; *(LAS f32x4*)(sp + 196) = (f32x4){-kkw[4] * inv, -kkw[5] * inv, -kkw[6] * inv, -kkw[7] * inv};
                    *(LAS f32x4*)(sp + 256) = (f32x4){kkw[0] * inv * a[0], kkw[1] * inv * a[1], kkw[2] * inv * a[2], kkw[3] * inv * a[3]};
                    *(LAS f32x4*)(sp + 260) = (f32x4){kkw[4] * inv * a[4], kkw[5] * inv * a[5], kkw[6] * inv * a[6], kkw[7] * inv * a[7]};
                    *(LAS f32x4*)(sp + 320) = (f32x4){xv[0], xv[1], xv[2], xv[3]}; *(LAS f32x4*)(sp + 324) = (f32x4){xv[4], xv[5], xv[6], xv[7]};
                }
            }
            __syncthreads();
        }
        __syncthreads();
    } else {
        __builtin_amdgcn_s_setprio(2);
        const int rowl = wave * 8 + (lane >> 3), row = hf * 32 + rowl, l = lane & 7;
        f32x2_ S[4];
#pragma unroll
        for (int j = 0; j < 4; ++j) S[j] = (f32x2_){0.f, 0.f};
        __syncthreads();
        for (int c = 0; c < NCH; ++c) {
            const int nsteps = (TP - c * TC) < TC ? (TP - c * TC) : TC;
            GAS bf16_t* yp = oraw + ((size_t)b * TP + (size_t)c * TC + l) * 1024 + 512 + h * 64 + row;
            const LAS float* sp = st + (c & 1) * (TC * 384);
#define RW_LD(X, ptr) const f32x4 X##r0 = *(const LAS f32x4*)((ptr) + 8 * l), X##r1 = *(const LAS f32x4*)((ptr) + 8 * l + 4), X##w0 = *(const LAS f32x4*)((ptr) + 64 + 8 * l), X##w1 = *(const LAS f32x4*)((ptr) + 68 + 8 * l), \
                X##k0 = *(const LAS f32x4*)((ptr) + 128 + 8 * l), X##k1 = *(const LAS f32x4*)((ptr) + 132 + 8 * l), X##n0 = *(const LAS f32x4*)((ptr) + 192 + 8 * l), X##n1 = *(const LAS f32x4*)((ptr) + 196 + 8 * l), \
                X##a0 = *(const LAS f32x4*)((ptr) + 256 + 8 * l), X##a1 = *(const LAS f32x4*)((ptr) + 260 + 8 * l); const float X##v = (ptr)[320 + row]
#define RW_LDV(X, ptr) f32x4 X##r0 = *(const LAS f32x4*)((ptr) + 8 * l), X##r1 = *(const LAS f32x4*)((ptr) + 8 * l + 4), X##w0 = *(const LAS f32x4*)((ptr) + 64 + 8 * l), X##w1 = *(const LAS f32x4*)((ptr) + 68 + 8 * l), \
                X##k0 = *(const LAS f32x4*)((ptr) + 128 + 8 * l), X##k1 = *(const LAS f32x4*)((ptr) + 132 + 8 * l), X##n0 = *(const LAS f32x4*)((ptr) + 192 + 8 * l), X##n1 = *(const LAS f32x4*)((ptr) + 196 + 8 * l), \
                X##a0 = *(const LAS f32x4*)((ptr) + 256 + 8 * l), X##a1 = *(const LAS f32x4*)((ptr) + 260 + 8 * l); float X##v = (ptr)[320 + row]
#define RW_LDA(X, ptr) do { X##r0 = *(const LAS f32x4*)((ptr) + 8 * l); X##r1 = *(const LAS f32x4*)((ptr) + 8 * l + 4); X##w0 = *(const LAS f32x4*)((ptr) + 64 + 8 * l); X##w1 = *(const LAS f32x4*)((ptr) + 68 + 8 * l); \
                X##k0 = *(const LAS f32x4*)((ptr) + 128 + 8 * l); X##k1 = *(const LAS f32x4*)((ptr) + 132 + 8 * l); X##n0 = *(const LAS f32x4*)((ptr) + 192 + 8 * l); X##n1 = *(const LAS f32x4*)((ptr) + 196 + 8 * l); \
                X##a0 = *(const LAS f32x4*)((ptr) + 256 + 8 * l); X##a1 = *(const LAS f32x4*)((ptr) + 260 + 8 * l); X##v = (ptr)[320 + row]; } while (0)
#define RW_STEP(X, ssv) do { \
                const f32x2_ nn[4] = {X##n0.xy, X##n0.zw, X##n1.xy, X##n1.zw}, ww[4] = {X##w0.xy, X##w0.zw, X##w1.xy, X##w1.zw}, aa[4] = {X##a0.xy, X##a0.zw, X##a1.xy, X##a1.zw}; \
                const f32x2_ kq[4] = {X##k0.xy, X##k0.zw, X##k1.xy, X##k1.zw}, rr[4] = {X##r0.xy, X##r0.zw, X##r1.xy, X##r1.zw}; \
                const f32x2_ sp2 = (S[0] * nn[0] + S[1] * nn[1]) + (S[2] * nn[2] + S[3] * nn[3]); \
                float sa = sp2.x + sp2.y; sa = allred8(sa); \
                _Pragma("unroll") for (int j = 0; j < 4; ++j) S[j] = S[j] * ww[j] + (aa[j] * sa + kq[j] * X##v); \
                const f32x2_ yp2 = (S[0] * rr[0] + S[1] * rr[1]) + (S[2] * rr[2] + S[3] * rr[3]); \
                float y = yp2.x + yp2.y; y = allred8(y); ycap = (l == (ssv)) ? y : ycap; } while (0)
            RW_LDV(A0_, sp);
            for (int s0 = 0; s0 < nsteps; s0 += 8) {
                float ycap = 0.f;
#define SB_ __builtin_amdgcn_sched_barrier(0);
                { RW_LD(B_, sp + 384); SB_ RW_STEP(A0_, 0); SB_ RW_LD(A_, sp + 768); SB_ RW_STEP(B_, 1); SB_
                  RW_LD(B2_, sp + 1152); SB_ RW_STEP(A_, 2); SB_ RW_LD(A2_, sp + 1536); SB_ RW_STEP(B2_, 3); SB_
                  RW_LD(B3_, sp + 1920); SB_ RW_STEP(A2_, 4); SB_ RW_LD(A3_, sp + 2304); SB_ RW_STEP(B3_, 5); SB_
                  RW_LD(B4_, sp + 2688); SB_ RW_STEP(A3_, 6); SB_ RW_LDA(A0_, sp + 3072); SB_ RW_STEP(B4_, 7); SB_ }
#undef SB_
                sp += 8 * 384;
                yp[(size_t)s0 * 1024] = f2bf_c(ycap);
            }
#undef RW_LD
#undef RW_LDV
#undef RW_LDA
#undef RW_STEP
            __syncthreads();
        }
        __builtin_amdgcn_s_setprio(0);
        GAS float* So = p.out + O_RP + ((((size_t)e * NB + b) * 8 + h) * 64 + row) * 64 + 8 * l;
        *(GAS f32x4*)So = (f32x4){S[0].x, S[0].y, S[1].x, S[1].y}; *(GAS f32x4*)(So + 4) = (f32x4){S[2].x, S[2].y, S[3].x, S[3].y};
    }
}

__device__ __forceinline__ unsigned pkc(float lo, float hi) { return (unsigned)f2bf_c(lo) | ((unsigned)f2bf_c(hi) << 16); }
template <bool GLA>
__device__ __forceinline__ void gla_mfma_scan(const Ctx& p, int o, int bh, int part, LAS unsigned char* lds) {
    constexpr int DV = GLA ? 256 : 128, LDP = GLA ? OPROJ : EPROJ, QS = 136  , TS = 40  ;
    constexpr int OFF_QD = 0, OFF_KD = 32 * QS * 2, OFF_KDT = 2 * 32 * QS * 2, OFF_VT = OFF_KDT + 128 * TS * 2, OFF_EL = OFF_VT + 32 * TS * 2, STG = OFF_EL + 512;
    constexpr int OFF_SB = 2 * STG, SBB = 8192;
    constexpr float SC = 0.08838834764831845f;
    const int tid = p.tid, lane = tid & 63, w = tid >> 6, b = bh >> 2, h = bh & 3, colbase = part * 32;
    GAS unsigned char* ws = p.ws;
    const GAS bf16_t* proj = (const GAS bf16_t*)(ws + WS_PROJ); GAS bf16_t* oraw = (GAS bf16_t*)(ws + WS_ORAW);
    const int kk = lane & 15, tq = lane >> 4, k = 16 * w + kk;
    const int vv = tid & 31, sg = tid >> 5;
    const int r16 = lane & 15, quad = lane >> 4;
    f32x4 S0 = {0.f, 0.f, 0.f, 0.f}, S1 = {0.f, 0.f, 0.f, 0.f};
    u32x4 Aq, Ak, At, Bq, Bk, Bt; unsigned Av0, Av1, Bv0, Bv1; float Ael, Bel;
    const GAS bf16_t* QDg = (const GAS bf16_t*)(ws + WS_MIXB); const GAS bf16_t* KDg = QDg + (size_t)MT * 512; const GAS bf16_t* KDTg = (const GAS bf16_t*)(ws + WS_KDT); const GAS float* ELg = (const GAS float*)(ws + WS_ELG);
    const int tr = tid >> 4, c8 = (tid & 15) * 8, kq = tid >> 2, ps = tid & 3;
#define GM_LOAD(X, cc) do { const size_t r0_ = (size_t)b * TP + (size_t)(cc) * 32;   \
        X##q = *(const GAS u32x4*)(QDg + (r0_ + tr) * 512 + h * 128 + c8); X##k = *(const GAS u32x4*)(KDg + (r0_ + tr) * 512 + h * 128 + c8); \
        X##t = *(const GAS u32x4*)(KDTg + ((((size_t)b * 65 + (cc)) * 512 + h * 128 + kq) * 32 + ps * 8)); \
        const GAS bf16_t* pv_ = proj + (r0_ + 2 * sg) * LDP + 1024 + h * DV + colbase + vv; X##v0 = (unsigned)pv_[0]; X##v1 = (unsigned)pv_[LDP]; \
        X##el = ELg[((size_t)b * 65 + (cc)) * 512 + h * 128 + (tid & 127)]; } while (0)
#define GM_STAGE(X, cc) do { LAS unsigned char* sb_ = lds + ((cc) & 1) * STG; const u32x4 z_ = {0u, 0u, 0u, 0u}; \
        const bool okr_ = (cc) * 32 + tr < TP, okt_ = (cc) * 32 + ps * 8 < TP; \
        *(LAS u32x4*)(sb_ + OFF_QD + (tr * QS + c8) * 2) = okr_ ? X##q : z_; *(LAS u32x4*)(sb_ + OFF_KD + (tr * QS + c8) * 2) = okr_ ? X##k : z_; \
        *(LAS u32x4*)(sb_ + OFF_KDT + (kq * TS + ps * 8) * 2) = okt_ ? X##t : z_; \
        const unsigned va_ = ((cc) * 32 + 2 * sg < TP) ? X##v0 : 0u, vb_ = ((cc) * 32 + 2 * sg + 1 < TP) ? X##v1 : 0u; \
        *(LAS unsigned*)(sb_ + OFF_VT + (vv * TS + 2 * sg) * 2) = GLA ? (va_ | (vb_ << 16)) : pk2(siluf_(bflo(va_)), siluf_(bflo(vb_))); \
        if (tid < 128) *(LAS float*)(sb_ + OFF_EL + tid * 4) = X##el; } while (0)
#define MFMA16(a, b, c) __builtin_amdgcn_mfma_f32_16x16x32_bf16((a), (b), (c), 0, 0, 0)
    auto chunk = [&](const int c) {
        LAS unsigned char* sb = lds + (c & 1) * STG; LAS unsigned char* sbS = lds + OFF_SB + (c & 1) * SBB;
        if (w < 4) {
            const int tt = w >> 1, vt = w & 1;
            f32x4 sc0 = {0.f, 0.f, 0.f, 0.f}, sc1 = {0.f, 0.f, 0.f, 0.f};
#pragma unroll
            for (int ks = 0; ks < 4; ++ks) {
                const bf16x8 bq = *(const LAS bf16x8*)(sb + OFF_QD + ((tt * 16 + r16) * QS + ks * 32 + quad * 8) * 2);
                const bf16x8 a0 = *(const LAS bf16x8*)(sb + OFF_KD + ((r16) * QS + ks * 32 + quad * 8) * 2);
                sc0 = MFMA16(a0, bq, sc0);
                if (tt == 1) { const bf16x8 a1 = *(const LAS bf16x8*)(sb + OFF_KD + ((16 + r16) * QS + ks * 32 + quad * 8) * 2); sc1 = MFMA16(a1, bq, sc1); }
            }
            const int s0 = quad * 4;
            f32x4 dg = tt ? sc1 : sc0;
            dg.x = (s0 + 0 <= r16) ? dg.x : 0.f; dg.y = (s0 + 1 <= r16) ? dg.y : 0.f; dg.z = (s0 + 2 <= r16) ? dg.z : 0.f; dg.w = (s0 + 3 <= r16) ? dg.w : 0.f;
            const f32x4 lo = tt ? sc0 : dg, hi = tt ? dg : (f32x4){0.f, 0.f, 0.f, 0.f};
            const u32x4 au = {pkc(lo.x, lo.y), pkc(lo.z, lo.w), pkc(hi.x, hi.y), pkc(hi.z, hi.w)};
            const u32x2 v0 = *(const LAS u32x2*)(sb + OFF_VT + ((vt * 16 + r16) * TS + quad * 4) * 2), v1 = *(const LAS u32x2*)(sb + OFF_VT + ((vt * 16 + r16) * TS + 16 + quad * 4) * 2);
            f32x4 oacc = MFMA16(__builtin_bit_cast(bf16x8, au), __builtin_bit_cast(bf16x8, ((u32x4){v0.x, v0.y, v1.x, v1.y})), ((f32x4){0.f, 0.f, 0.f, 0.f}));
#pragma unroll
            for (int ks = 0; ks < 4; ++ks) {
                const u32x2 q0 = *(const LAS u32x2*)(sb + OFF_QD + ((tt * 16 + r16) * QS + ks * 32 + quad * 4) * 2), q1 = *(const LAS u32x2*)(sb + OFF_QD + ((tt * 16 + r16) * QS + ks * 32 + 16 + quad * 4) * 2);
                const u32x2 t0 = *(const LAS u32x2*)(sbS + ((vt * 8 + 2 * ks) * 64 + lane) * 8), t1 = *(const LAS u32x2*)(sbS + ((vt * 8 + 2 * ks + 1) * 64 + lane) * 8);
                oacc = MFMA16(__builtin_bit_cast(bf16x8, ((u32x4){q0.x, q0.y, q1.x, q1.y})), __builtin_bit_cast(bf16x8, ((u32x4){t0.x, t0.y, t1.x, t1.y})), oacc);
            }
            const float ov[4] = {oacc.x, oacc.y, oacc.z, oacc.w};
#pragma unroll
            for (int j = 0; j < 4; ++j) { const int tok = c * 32 + tt * 16 + quad * 4 + j; if (tok < TP) oraw[((size_t)b * TP + tok) * 1024 + h * DV + colbase + vt * 16 + r16] = f2bf_c(ov[j]); }
        }
        {
            const bf16x8 ak = *(const LAS bf16x8*)(sb + OFF_KDT + ((16 * w + r16) * TS + quad * 8) * 2);
            const bf16x8 b0 = *(const LAS bf16x8*)(sb + OFF_VT + ((r16) * TS + quad * 8) * 2), b1 = *(const LAS bf16x8*)(sb + OFF_VT + ((16 + r16) * TS + quad * 8) * 2);
            S0 = MFMA16(ak, b0, S0); S1 = MFMA16(ak, b1, S1);
            const f32x4 el = *(const LAS f32x4*)(sb + OFF_EL + (16 * w + quad * 4) * 4);
            S0 = S0 * el; S1 = S1 * el;
        }
    };
    auto publish = [&](const int c) {
        LAS unsigned char* sbS = lds + OFF_SB + (c & 1) * SBB;
        *(LAS u32x2*)(sbS + ((0 * 8 + w) * 64 + lane) * 8) = (u32x2){pkc(S0.x, S0.y), pkc(S0.z, S0.w)};
        *(LAS u32x2*)(sbS + ((1 * 8 + w) * 64 + lane) * 8) = (u32x2){pkc(S1.x, S1.y), pkc(S1.z, S1.w)};
    };
    __syncthreads();
    GM_LOAD(A, 0); GM_STAGE(A, 0); GM_LOAD(B, 1);
    for (int c = 0; c < NCH; c += 2) {
        publish(c);
        __syncthreads();
        if (c + 2 < NCH) GM_LOAD(A, c + 2);
        chunk(c);
        if (c + 1 < NCH) {
            GM_STAGE(B, c + 1);
            publish(c + 1);
            __syncthreads();
            if (c + 3 < NCH) GM_LOAD(B, c + 3);
            chunk(c + 1);
            if (c + 2 < NCH) GM_STAGE(A, c + 2);
        }
    }
#undef GM_LOAD
#undef GM_STAGE
#undef MFMA16
    GAS float* So = p.out + (GLA ? O_GP : O_HP) + ((((size_t)o * NB + b) * 4 + h) * 128 + 16 * w + quad * 4) * DV + colbase + r16;
    So[0 * DV] = S0.x; So[1 * DV] = S0.y; So[2 * DV] = S0.z; So[3 * DV] = S0.w;
    So[0 * DV + 16] = S1.x; So[1 * DV + 16] = S1.y; So[2 * DV + 16] = S1.z; So[3 * DV + 16] = S1.w;
}

__device__ __forceinline__ void phase_scan_even(const Ctx& p, int e, LAS unsigned char* lds) {
    const int G = p.G;
    const int sfirst = G > 128 ? 128 : 0, sstride = G - sfirst;
    for (int r = 0; r < (((p.probe >> 11) & 1) ? 2 : 1); ++r)
    for (int task = p.bid - sfirst; task >= 0 && task < 512 + 1024; task += sstride) {
        if (task < 512) glalike_sample<false>(p, e, task >> 2, task & 3, lds);
        else rwkv_sample(p, e, (task - 512) >> 3, (task - 512) & 7, lds);
    }
    for (int task = p.bid; task < 256; task += G) {
        if (task < 128) rwkv_prompt_scan(p, e, task >> 1, task & 1, lds);
        else gla_mfma_scan<false>(p, e, (task - 128) >> 2, (task - 128) & 3, lds);
    }
}
__device__ __forceinline__ void phase_scan_odd(const Ctx& p, int o, LAS unsigned char* lds) {
    const int G = p.G;
    for (int r = 0; r < (((p.probe >> 11) & 1) ? 2 : 1); ++r)
    for (int task = p.bid; task < 512; task += G) glalike_sample<true>(p, o, task >> 2, task & 3, lds);
    for (int task = p.bid; task < 256; task += G) gla_mfma_scan<true>(p, o, task >> 3, task & 7, lds);
}

__device__ __forceinline__ void phase_post_even(const Ctx& p, int e) {
    const int tid = p.tid, lane = tid & 63, wave = tid >> 6;
    GAS unsigned char* ws = p.ws;
    const GAS bf16_t* proj = (const GAS bf16_t*)(ws + WS_PROJ); const GAS bf16_t* oraw = (const GAS bf16_t*)(ws + WS_ORAW); const GAS bf16_t* lraw = (const GAS bf16_t*)(ws + WS_LRAW);
    const GAS float* bsum = (const GAS float*)(ws + WS_BSUM); GAS bf16_t* mixb = (GAS bf16_t*)(ws + WS_MIXB);
    const int c = lane * 8;
    const GAS float* hn = p.in(I_HNORM) + e * 512 + c; const GAS float* lw = p.in(I_LNW) + e * 512 + c; const GAS float* lbi = p.in(I_LNB) + e * 512 + c;
    const GAS float* mu = p.in(I_MU) + (size_t)e * 1792 + 1024 + c;
    for (int m = p.bid * NWAVES + wave; m < MT; m += p.G * NWAVES) {
        {
            const u32x4 ou = *(const GAS u32x4*)(oraw + (size_t)m * 1024 + c);
            const f32x4 o0 = {bflo(ou.x), bfhi(ou.x), bflo(ou.y), bfhi(ou.y)}, o1 = {bflo(ou.z), bfhi(ou.z), bflo(ou.w), bfhi(ou.w)};
            const u32x4 gu = *(const GAS u32x4*)(proj + (size_t)m * EPROJ + 1536 + c);
            float z[8] = {o0.x, o0.y, o0.z, o0.w, o1.x, o1.y, o1.z, o1.w};
            const float ga[8] = {bflo(gu.x), bfhi(gu.x), bflo(gu.y), bfhi(gu.y), bflo(gu.z), bfhi(gu.z), bflo(gu.w), bfhi(gu.w)};
            float ss = 0.f;
#pragma unroll
            for (int j = 0; j < 8; ++j) { z[j] *= sigmoidf_(ga[j]); ss += z[j] * z[j]; }
            ss = wave_sum(ss); const float rs = rsqrtf(ss * (1.0f / 512.0f) + 1e-6f);
            u32x4 w; w.x = pk2(z[0] * rs * hn[0], z[1] * rs * hn[1]); w.y = pk2(z[2] * rs * hn[2], z[3] * rs * hn[3]);
            w.z = pk2(z[4] * rs * hn[4], z[5] * rs * hn[5]); w.w = pk2(z[6] * rs * hn[6], z[7] * rs * hn[7]);
            *(GAS u32x4*)(mixb + (size_t)m * 1024 + c) = w;
        }
        {
            const u32x4 yu = *(const GAS u32x4*)(oraw + (size_t)m * 1024 + 512 + c);
            const f32x4 y0 = {bflo(yu.x), bfhi(yu.x), bflo(yu.y), bfhi(yu.y)}, y1 = {bflo(yu.z), bfhi(yu.z), bflo(yu.w), bfhi(yu.w)};
            float y[8] = {y0.x, y0.y, y0.z, y0.w, y1.x, y1.y, y1.z, y1.w};
            float s1 = 0.f;
#pragma unroll
            for (int j = 0; j < 8; ++j) s1 += y[j];
            s1 = allred8(s1); const float mean = s1 * (1.0f / 64.0f);
            float s2 = 0.f;
#pragma unroll
            for (int j = 0; j < 8; ++j) { y[j] -= mean; s2 += y[j] * y[j]; }
            s2 = allred8(s2); const float rs = rsqrtf(s2 * (1.0f / 64.0f) + 64e-5f);
            const u32x4 cu = *(const GAS u32x4*)(proj + (size_t)m * EPROJ + 2048 + 1024 + c);
            const float cur[8] = {bflo(cu.x), bfhi(cu.x), bflo(cu.y), bfhi(cu.y), bflo(cu.z), bfhi(cu.z), bflo(cu.w), bfhi(cu.w)};
            float prv[8];
            if (m >= MP) { const GAS float* s = p.in(I_SS) + ((size_t)e * NS + (m - MP)) * 1792 + 1024 + c; const f32x4 a = *(const GAS f32x4*)s, b = *(const GAS f32x4*)(s + 4);
                prv[0] = a.x; prv[1] = a.y; prv[2] = a.z; prv[3] = a.w; prv[4] = b.x; prv[5] = b.y; prv[6] = b.z; prv[7] = b.w; }
            else if ((m % TP) == 0) {
#pragma unroll
                for (int j = 0; j < 8; ++j) prv[j] = 0.f; }
            else { const u32x4 pu = *(const GAS u32x4*)(proj + (size_t)(m - 1) * EPROJ + 2048 + 1024 + c);
                prv[0] = bflo(pu.x); prv[1] = bfhi(pu.x); prv[2] = bflo(pu.y); prv[3] = bfhi(pu.y); prv[4] = bflo(pu.z); prv[5] = bfhi(pu.z); prv[6] = bflo(pu.w); prv[7] = bfhi(pu.w); }
            const float bonus = bsum[(size_t)m * 8 + (lane >> 3)];
            const u32x4 gg = *(const GAS u32x4*)(lraw + (size_t)m * 1536 + 1024 + c);
            const float g[8] = {bflo(gg.x), bfhi(gg.x), bflo(gg.y), bfhi(gg.y), bflo(gg.z), bfhi(gg.z), bflo(gg.w), bfhi(gg.w)};
            float ob[8];
#pragma unroll
            for (int j = 0; j < 8; ++j) { const float v = cur[j] + (prv[j] - cur[j]) * mu[j]; ob[j] = (y[j] * rs * lw[j] + lbi[j] + bonus * v) * g[j]; }
            u32x4 w; w.x = pk2(ob[0], ob[1]); w.y = pk2(ob[2], ob[3]); w.z = pk2(ob[4], ob[5]); w.w = pk2(ob[6], ob[7]);
            *(GAS u32x4*)(mixb + (size_t)m * 1024 + 512 + c) = w;
        }
    }
}
__device__ __forceinline__ void phase_post_odd(const Ctx& p, int o) {
    const int tid = p.tid, lane = tid & 63, wave = tid >> 6;
    GAS unsigned char* ws = p.ws;
    const GAS bf16_t* proj = (const GAS bf16_t*)(ws + WS_PROJ); const GAS bf16_t* oraw = (const GAS bf16_t*)(ws + WS_ORAW); GAS bf16_t* mixb = (GAS bf16_t*)(ws + WS_MIXB);
    const f32x4 gn = *(const GAS f32x4*)(p.in(I_GNORM) + o * 256 + 4 * lane);
    for (int m = p.bid * NWAVES + wave; m < MT; m += p.G * NWAVES) {
#pragma unroll
        for (int h = 0; h < 4; ++h) {
            const int c = h * 256 + 4 * lane;
            const u32x2 vu = *(const GAS u32x2*)(oraw + (size_t)m * 1024 + c);
            const f32x4 v = {bflo(vu.x), bfhi(vu.x), bflo(vu.y), bfhi(vu.y)};
            float ss = (v.x * v.x + v.y * v.y) + (v.z * v.z + v.w * v.w); ss = wave_sum(ss);
            const float rs = rsqrtf(ss * (1.0f / 256.0f) + 1e-6f);
            const u32x2 gu = *(const GAS u32x2*)(proj + (size_t)m * OPROJ + 2048 + c);
            u32x2 w; w.x = pk2(v.x * rs * gn.x * siluf_(bflo(gu.x)), v.y * rs * gn.y * siluf_(bfhi(gu.x)));
            w.y = pk2(v.z * rs * gn.z * siluf_(bflo(gu.y)), v.w * rs * gn.w * siluf_(bfhi(gu.y)));
            *(GAS u32x2*)(mixb + (size_t)m * 1024 + c) = w;
        }
    }
}
__device__ __forceinline__ void phase_fix(const Ctx& p, int arg_, int rep_) {
    int sel = arg_ * 2 + (rep_ ? 1 : 0); asm volatile("" : "+s"(sel));
    const int nk = (sel & 2) ? 4 : 11; const float scale = (sel & 1) ? 0.f : ((sel & 2) ? 1.0f : 0.5f);
    const int tid = p.tid, lane = tid & 63, wave = tid >> 6;
    GAS float* xf = (GAS float*)(p.ws + WS_XF); GAS bf16_t* xb = (GAS bf16_t*)(p.ws + WS_XB); GAS float* ssq = (GAS float*)(p.ws + WS_SSQ);
    const GAS float* part = (const GAS float*)(p.ws + WS_PART);
    for (int r = p.bid * NWAVES + wave; r < 256; r += p.G * NWAVES) {
        const int m = MT - 256 + r; float ss = 0.f;
#pragma unroll
        for (int j = 0; j < 4; ++j) {
            const int c = 4 * lane + 256 * j;
            f32x4 a = {0.f, 0.f, 0.f, 0.f};
            for (int k = 0; k < nk; ++k) a = a + *(const GAS f32x4*)(part + ((size_t)k * 256 + r) * 1024 + c);
            f32x4 x = *(const GAS f32x4*)(xf + (size_t)m * D + c); x = x + a * scale;
            *(GAS f32x4*)(xf + (size_t)m * D + c) = x;
            u32x2 w; w.x = pk2(x.x, x.y); w.y = pk2(x.z, x.w); *(GAS u32x2*)(xb + (size_t)m * D + c) = w;
            ss += (x.x * x.x + x.y * x.y) + (x.z * x.z + x.w * x.w);
        }
        ss = wave_sum(ss);
        if (lane < 16) ssq[(size_t)m * 16 + lane] = lane == 0 ? ss : 0.f;
        if (lane == 0) ((GAS float*)(p.ws + WS_RSTD))[m] = rsqrtf(ss * (1.0f / 1024.0f) + 1e-6f);
    }
    for (int m = p.bid * NTHREADS + tid; m < MT - 256; m += p.G * NTHREADS) ((GAS float*)(p.ws + WS_RSTD))[m] = rstd_of(ssq, m);
}
__device__ __forceinline__ void phase_final(const Ctx& p) {
    const int tid = p.tid, lane = tid & 63, wave = tid >> 6;
    const GAS bf16_t* xb = (const GAS bf16_t*)(p.ws + WS_XB); const GAS float* ssq = (const GAS float*)(p.ws + WS_SSQ);
    for (int m = p.bid * NWAVES + wave; m < MT; m += p.G * NWAVES) {
        GAS float* dst;
        if (m < MP) { const int b = m / TP, t = m % TP; if (t < 16) continue; dst = p.out + O_YP + ((size_t)b * 2048 + (t - 16)) * D; }
        else dst = p.out + O_YS + (size_t)(m - MP) * D;
        const float rs = rstd_of(ssq, m);
#pragma unroll
        for (int j = 0; j < 4; ++j) {
            const int c = 4 * lane + 256 * j; const u32x2 xo = *(const GAS u32x2*)(xb + (size_t)m * D + c); const f32x4 x = {bflo(xo.x), bfhi(xo.x), bflo(xo.y), bfhi(xo.y)}, g = *(const GAS f32x4*)(p.in(I_FNORM) + c);
            *(GAS f32x4*)(dst + c) = x * rs * g;
        }
    }
}

#define XB_TMO      128
#define XB_XCNT(j)  (256  + 64 * (j))
#define XB_XSUB(j)  (1280 + 64 * (j))
#define XB_XGEN(j)  (2304 + 64 * (j))
#define XB_TOP      3328
#define XB_TOPGEN   3392
#define XCD_BAR_WORDS 3456
#define XB_SPIN_CAP (1u << 22)
__device__ __forceinline__ unsigned xb_ld(unsigned* p)              { return __hip_atomic_load(p, __ATOMIC_RELAXED, __HIP_MEMORY_SCOPE_AGENT); }
__device__ __forceinline__ unsigned xb_add(unsigned* p, unsigned v) { return __hip_atomic_fetch_add(p, v, __ATOMIC_RELAXED, __HIP_MEMORY_SCOPE_AGENT); }
__device__ __forceinline__ unsigned xb_xcc_id() { return (unsigned)__builtin_amdgcn_s_getreg((3 << 11) | 20) & 0xFu; }
#define XB_SPIN(cond, bar) do { unsigned _sp = 0; while (cond) { __builtin_amdgcn_s_sleep(1); \
    if ((++_sp & 255u) == 0u) { if (xb_ld(&(bar)[XB_TMO])) break; if (_sp > XB_SPIN_CAP) { atomicAdd(&(bar)[XB_TMO], 1u); break; } } } } while (0)
struct XcdBarrier { unsigned* bar; unsigned x; volatile LAS unsigned* st; };
__device__ __forceinline__ void xcd_barrier_complete(unsigned* bar, unsigned x, unsigned G, unsigned& nloc, unsigned& nx) {
    unsigned sum, cnt, mine, sp = 0u;
    for (;;) {
        sum = 0u; cnt = 0u; mine = 0u;
#pragma unroll
        for (unsigned j = 0; j < 16; ++j) { const unsigned c = xb_ld(&bar[XB_XCNT(j)]); sum += c; cnt += (c > 0u) ? 1u : 0u; mine = (j == x) ? c : mine; }
        if (sum == G) break;
        __builtin_amdgcn_s_sleep(1);
        if ((++sp & 255u) == 0u) { if (xb_ld(&bar[XB_TMO])) break; if (sp > XB_SPIN_CAP) { atomicAdd(&bar[XB_TMO], 1u); break; } }
    }
    nloc = mine > 0u ? mine : 1u; nx = cnt > 0u ? cnt : 1u;
}
__device__ __forceinline__ void xcd_barrier(const XcdBarrier& b, int tid, unsigned G) {
    asm volatile("s_waitcnt vmcnt(0)" ::: "memory");
    __syncthreads();
    if (tid == 0) {
        unsigned* bar = b.bar;
        __builtin_amdgcn_s_waitcnt(0);
        unsigned nloc = b.st[0], nx = b.st[1];
        if (nloc == 0u) { xcd_barrier_complete(bar, b.x, G, nloc, nx); b.st[0] = nloc; b.st[1] = nx; }
        const unsigned old = xb_add(&bar[XB_XSUB(b.x)], 1u);
        const unsigned gen = old / nloc;
        if (old + 1u == (gen + 1u) * nloc) {
            __builtin_amdgcn_fence(__ATOMIC_RELEASE, "agent");
            asm volatile("s_waitcnt vmcnt(0)" ::: "memory");
            const unsigned og = xb_add(&bar[XB_TOP], 1u);
            const unsigned tg = og / nx;
            if (og + 1u == (tg + 1u) * nx) xb_add(&bar[XB_TOPGEN], 1u);
            else XB_SPIN(xb_ld(&bar[XB_TOPGEN]) == tg, bar);
            __builtin_amdgcn_fence(__ATOMIC_ACQUIRE, "agent");
            xb_add(&bar[XB_XGEN(b.x)], 1u);
            asm volatile("s_waitcnt vmcnt(0)" ::: "memory");
        } else {
            XB_SPIN(xb_ld(&bar[XB_XGEN(b.x)]) == gen, bar);
            __builtin_amdgcn_fence(__ATOMIC_ACQUIRE, "agent");
            asm volatile("s_waitcnt vmcnt(0)" ::: "memory");
        }
    }
    __syncthreads();
}

#define TAILCNT(ph, pn) (3520 + (ph) * 4 + (pn))
__device__ __forceinline__ void tail_fixup(const Ctx& p, int ph, int nk, float scale) {
    const int tid = p.tid, lane = tid & 63, wave = tid >> 6, nmain = 64 * 4, ntail = 4 * nk;
    unsigned* bar = (unsigned*)(unsigned char*)(p.ws + WS_BAR);
    GAS float* xf = (GAS float*)(p.ws + WS_XF); GAS bf16_t* xb = (GAS bf16_t*)(p.ws + WS_XB); GAS float* ssq = (GAS float*)(p.ws + WS_SSQ);
    const GAS float* part = (const GAS float*)(p.ws + WS_PART);
    for (int L = p.bid; L < nmain + ntail; L += p.G) {
        if (L < nmain) continue;
        const int j = L - nmain, pn = j % 4, kc = j / 4;
        asm volatile("s_waitcnt vmcnt(0)" ::: "memory");
        __syncthreads();
        if (tid == 0) {
            __builtin_amdgcn_fence(__ATOMIC_RELEASE, "agent");
            asm volatile("s_waitcnt vmcnt(0)" ::: "memory");
            (void)xb_add(&bar[TAILCNT(ph, pn)], 1u);
            XB_SPIN(xb_ld(&bar[TAILCNT(ph, pn)]) < (unsigned)nk, bar);
            __builtin_amdgcn_fence(__ATOMIC_ACQUIRE, "agent");
            asm volatile("s_waitcnt vmcnt(0)" ::: "memory");
        }
        __syncthreads();
        const int r_lo = (kc * 256) / nk, r_hi = ((kc + 1) * 256) / nk, c4 = pn * 256 + 4 * lane;
        for (int r = r_lo + wave; r < r_hi; r += NWAVES) {
            const int m = MT - 256 + r;
            f32x4 sl[11];
#pragma unroll
            for (int k = 0; k < 11; ++k) sl[k] = (k < nk) ? *(const GAS f32x4*)(part + ((size_t)k * 256 + r) * 1024 + c4) : (f32x4){0.f, 0.f, 0.f, 0.f};
            f32x4 a = sl[0];
#pragma unroll
            for (int k = 1; k < 11; ++k) a = a + sl[k];
            const u32x2 xo = *(const GAS u32x2*)(xb + (size_t)m * D + c4); f32x4 x = {bflo(xo.x), bfhi(xo.x), bflo(xo.y), bfhi(xo.y)}; x = x + a * scale;
            u32x2 w; w.x = pk2(x.x, x.y); w.y = pk2(x.z, x.w); *(GAS u32x2*)(xb + (size_t)m * D + c4) = w;
            float ss = (x.x * x.x + x.y * x.y) + (x.z * x.z + x.w * x.w); ss = wave_sum(ss);
            if (lane < 4) ssq[(size_t)m * 16 + pn * 4 + lane] = lane == 0 ? ss : 0.f;
        }
    }
}

__global__ void __launch_bounds__(NTHREADS, 2) mega_fwd(Params pp) {
    extern __shared__ __attribute__((aligned(16))) unsigned char shm[];
    LAS unsigned char* lds = (LAS unsigned char*)shm;
    cg::grid_group grid = cg::this_grid();
    if (threadIdx.x < N_IN) {
        const unsigned long long v = (unsigned long long)pp.in[threadIdx.x];
        LAS unsigned* t = (LAS unsigned*)(lds + TAB_OFF) + 2 * threadIdx.x; t[0] = (unsigned)v; t[1] = (unsigned)(v >> 32);
    }
    #define MK_GBAR() XcdBarrier gbar; gbar.bar = (unsigned*)(pp.ws + WS_BAR); gbar.x = xb_xcc_id(); gbar.st = (volatile LAS unsigned*)(lds + TAB_OFF + 320)
    if (threadIdx.x == 0) { MK_GBAR(); gbar.st[0] = 0u; gbar.st[1] = 0u; (void)xb_add(&gbar.bar[XB_XCNT(gbar.x)], 1u); }
    __syncthreads();
    const int wave_s = __builtin_amdgcn_readfirstlane((int)(threadIdx.x >> 6));
    for (int ph = pp.ph_lo; ph < pp.ph_hi; ++ph) {
        const int kind = PROG[ph][0], arg = PROG[ph][1];
        const int nrep = (((pp.probe_mask >> kind) & 1) || (kind == K_SCAN && (arg & 1) && ((pp.probe_mask >> 12) & 1))) ? 2 : 1;
        for (int rep = 0; rep < nrep; ++rep) {
        int lane_l; asm volatile("v_mbcnt_lo_u32_b32 %0, -1, 0\n\tv_mbcnt_hi_u32_b32 %0, -1, %0" : "=v"(lane_l));
        int tid = wave_s * 64 + lane_l, bid = blockIdx.x; unsigned char* ws_ = pp.ws; float* outp_ = pp.out; LAS unsigned char* ldsl = lds;
        asm volatile("" : "+v"(tid)); asm volatile("" : "+s"(bid)); asm volatile("" : "+s"(ws_)); asm volatile("" : "+s"(outp_)); asm volatile("" : "+s"(ldsl));
        GAS unsigned char* ws = (GAS unsigned char*)ws_; GAS float* outp = (GAS float*)outp_;
        Ctx p; p.lds = ldsl; p.out = outp; p.ws = ws; p.tid = tid; p.bid = bid; p.G = gridDim.x; p.probe = pp.probe_mask;
        if (rep) { MK_GBAR(); xcd_barrier(gbar, tid, (unsigned)gridDim.x); }
        GAS bf16_t* xb = (GAS bf16_t*)(ws + WS_XB); GAS float* xf = (GAS float*)(ws + WS_XF); GAS float* ssq = (GAS float*)(ws + WS_SSQ);
        GAS bf16_t* projb = (GAS bf16_t*)(ws + WS_PROJ);
        if (kind == K_P0) phase_p0(p, ldsl);
        else if (kind == K_GU || kind == K_DN || kind == K_OUT || kind == K_IN || kind == K_LORA) {
            pg8::Gemm g; Epi E; E.ws = ws; E.scale = 1.0f; E.ldo = 0;
            if (kind == K_GU) { g = pg8::Gemm{xb, (const GAS bf16_t*)(ws + WS_WGU) + (size_t)arg * 5632 * 1024, MT, 5632, 1024}; E.mode = 0; }
            else if (kind == K_DN) { g = pg8::Gemm{projb, (const GAS bf16_t*)(ws + WS_WD) + (size_t)arg * 1024 * FF, MT, 1024, FF}; E.mode = 1; E.scale = rep ? 0.f : 0.5f; }
            else if (kind == K_OUT) { g = pg8::Gemm{(const GAS bf16_t*)(ws + WS_MIXB), (const GAS bf16_t*)(ws + WS_WOUT) + (size_t)arg * D * D, MT, 1024, 1024}; E.mode = 1; E.scale = rep ? 0.f : 1.0f; }
            else if (kind == K_IN) { const int odd = arg & 1, idx = arg >> 1;
                g = pg8::Gemm{xb, odd ? (const GAS bf16_t*)(ws + WS_WINO) + (size_t)idx * OPROJ * 1024 : (const GAS bf16_t*)(ws + WS_WINE) + (size_t)idx * EPROJ * 1024, MT, odd ? OPROJ : EPROJ, 1024};
                E.mode = 2; E.ldo = odd ? OPROJ : EPROJ; }
            else { g = pg8::Gemm{(const GAS bf16_t*)(ws + WS_LIN), (const GAS bf16_t*)(ws + WS_WLORA) + (size_t)(arg >> 1) * 1536 * 256, MT, 1536, 256}; E.mode = 3; E.ldo = 1536; }
            pg8::StaticOrder S; S.init(g.M, g.N, g.K, p.G, bid, E.mode == 1);
            pg8::gemm_phase(ldsl, g, S, E, tid);
            if (E.mode == 1) tail_fixup(p, ph, g.K / 256, E.scale);
        } else if (kind == K_LIN) { phase_fprep(p, arg & 1, arg >> 1); if (!(arg & 1)) phase_lin(p, arg >> 1); }
        else if (kind == K_SCAN) { if (arg & 1) phase_scan_odd(p, arg >> 1, ldsl); else phase_scan_even(p, arg >> 1, ldsl); }
        else if (kind == K_FIX) phase_fix(p, arg, rep);
        else if (kind == K_POST) { if (arg & 1) phase_post_odd(p, arg >> 1); else phase_post_even(p, arg >> 1); }
        else phase_final(p);
        }
        if (ph + 1 < pp.ph_hi) { if (pp.ph_lo < 0) grid.sync();   else { MK_GBAR(); int lane_b; asm volatile("v_mbcnt_lo_u32_b32 %0, -1, 0\n\tv_mbcnt_hi_u32_b32 %0, -1, %0" : "=v"(lane_b)); xcd_barrier(gbar, wave_s * 64 + lane_b, (unsigned)gridDim.x); } }
    }
}

extern "C" void kernel_launch(void* const* d_in, const int* in_sizes, int n_in, void* d_out, int out_size, void* d_ws, size_t ws_size, hipStream_t stream) {
    static int grid_blocks = 0;
    if (grid_blocks == 0) {
        if (n_in != N_IN || (size_t)out_size != O_END || ws_size < WS_END) {
            fprintf(stderr, "kernel_launch: unexpected shapes: n_in %d out %d ws %zu (need %zu)\n", n_in, out_size, ws_size, (size_t)WS_END);
            grid_blocks = -1; return;
        }
        int dev = 0, cus = 0, per_cu = 0;
        hipGetDevice(&dev);
        hipDeviceGetAttribute(&cus, hipDeviceAttributeMultiprocessorCount, dev);
        if (hipFuncSetAttribute((const void*)mega_fwd, hipFuncAttributeMaxDynamicSharedMemorySize, LDS_BYTES) != hipSuccess) fprintf(stderr, "kernel_launch: hipFuncSetAttribute failed\n");
        hipOccupancyMaxActiveBlocksPerMultiprocessor(&per_cu, (const void*)mega_fwd, NTHREADS, LDS_BYTES);
        (void)hipGetLastError();
        if (per_cu < 1) fprintf(stderr, "kernel_launch: occupancy query reports %d blocks per CU\n", per_cu);
        grid_blocks = cus > 0 ? cus : 256;
    }
    if (grid_blocks < 0) return;
    if (hipMemsetAsync((char*)d_ws + WS_BAR, 0, 16384, stream) != hipSuccess) { fprintf(stderr, "kernel_launch: memset failed\n"); return; }
    Params p{};
    for (int i = 0; i < N_IN; ++i) p.in[i] = (const float*)d_in[i];
    p.out = (float*)d_out; p.ws = (unsigned char*)d_ws; p.ph_lo = 0; p.ph_hi = NPHASES; p.probe_mask = PROBE_MASK;
    void* args[] = {&p};
    hipError_t e = hipLaunchCooperativeKernel((const void*)mega_fwd, dim3(grid_blocks), dim3(NTHREADS), args, LDS_BYTES, stream);
    if (e != hipSuccess) fprintf(stderr, "cooperative launch failed: %s (grid %d)\n", hipGetErrorString(e), grid_blocks);
}
```

```cpp
#include <hip/hip_runtime.h>
#include <hip/hip_cooperative_groups.h>
#include <cstdio>
#include <cstdint>
namespace cg = cooperative_groups;

#define LAS __attribute__((address_space(3)))
#define GAS __attribute__((address_space(1)))
typedef unsigned short bf16_t;
typedef short bf16x8 __attribute__((ext_vector_type(8)));
typedef float f32x4 __attribute__((ext_vector_type(4)));
typedef unsigned u32x4 __attribute__((ext_vector_type(4)));
typedef unsigned u32x2 __attribute__((ext_vector_type(2)));
typedef float f32x2_ __attribute__((ext_vector_type(2)));

constexpr int D = 1024, FF = 2816, TP = 2064, NB = 8, NS = 128, MP = NB * TP  , MT = MP + NS  ;
constexpr int EPROJ = 3840, OPROJ = 3328  , OSRC = 3088;
constexpr int NTHREADS = 512, NWAVES = 8;
#define PROBE_MASK 0
constexpr int LDS_BYTES = 131072 + 512;
constexpr int TAB_OFF = 131072;

enum { I_XP = 0, I_XS, I_SH, I_SR, I_SS, I_SG, I_META, I_NF1, I_F1G, I_F1U, I_F1D, I_NMIX, I_EWIN, I_LB, I_HNORM, I_MU, I_W0, I_W2, I_A0, I_A2, I_G2,
       I_KK, I_KA, I_RK, I_LNW, I_LNB, I_EWOUT, I_OWIN, I_GUP, I_GB, I_GNORM, I_OWOUT, I_NF2, I_F2G, I_F2U, I_F2D, I_FNORM, N_IN };

constexpr size_t O_YP = 0, O_YS = 16777216, O_HP = O_YS + 131072, O_RP = O_HP + 1048576, O_SP = O_RP + 524288, O_GP = O_SP + 28672,
                 O_HS = O_GP + 2097152, O_RS = O_HS + 16777216, O_SSH = O_RS + 8388608, O_GS = O_SSH + 458752, O_END = O_GS + 33554432;

constexpr size_t WS_BAR = 0;
constexpr size_t WS_WGU = 16384;
constexpr size_t WS_WD = WS_WGU + (size_t)8 * 5632 * 1024 * 2;
constexpr size_t WS_WINE = WS_WD + (size_t)8 * 1024 * 2816 * 2;
constexpr size_t WS_WINO = WS_WINE + (size_t)2 * EPROJ * 1024 * 2;
constexpr size_t WS_WOUT = WS_WINO + (size_t)2 * OPROJ * 1024 * 2;
constexpr size_t WS_WLORA = WS_WOUT + (size_t)4 * 1024 * 1024 * 2;
constexpr size_t WS_XF = WS_WLORA + (size_t)2 * 1536 * 256 * 2;
constexpr size_t WS_XB = WS_XF + (size_t)MT * 1024 * 4;
constexpr size_t WS_SSQ = WS_XB + (size_t)MT * 1024 * 2;
constexpr size_t WS_PROJ = WS_SSQ + (size_t)MT * 16 * 4;
constexpr size_t WS_LIN = WS_PROJ + (size_t)MT * EPROJ * 2;
constexpr size_t WS_LRAW = WS_LIN + (size_t)MT * 256 * 2;
constexpr size_t WS_ORAW = WS_LRAW + (size_t)MT * 1536 * 2;
constexpr size_t WS_BSUM = WS_ORAW + (size_t)MT * 1024 * 4;
constexpr size_t WS_MIXB = WS_BSUM + (size_t)MT * 8 * 4;
constexpr size_t WS_PART = WS_MIXB + (size_t)MT * 1024 * 2;
constexpr size_t WS_RSTD = WS_PART + (size_t)11 * 256 * 1024 * 4;
constexpr size_t WS_KDT = WS_RSTD + (size_t)MT * 4;
constexpr size_t WS_ELG = WS_KDT + (size_t)8 * 65 * 512 * 32 * 2;
constexpr size_t WS_END = WS_ELG + (size_t)8 * 65 * 512 * 4;

struct Params { const float* in[N_IN]; float* out; unsigned char* ws; int ph_lo, ph_hi, probe_mask, pad_; };
struct Ctx {
    LAS unsigned char* lds; GAS float* out; GAS unsigned char* ws; int tid, bid, G, probe;
    __device__ __forceinline__ const GAS float* in(int i) const {
        const LAS unsigned* t = (const LAS unsigned*)(lds + TAB_OFF) + 2 * i;
        const unsigned lo = __builtin_amdgcn_readfirstlane(t[0]), hi = __builtin_amdgcn_readfirstlane(t[1]);
        return (const GAS float*)(((unsigned long long)hi << 32) | lo);
    }
};

enum { K_P0 = 0, K_GU, K_DN, K_IN, K_LIN, K_LORA, K_SCAN, K_POST, K_OUT, K_FINAL, K_FIX };
constexpr int NPHASES = 40;
__constant__ unsigned char PROG[NPHASES][2] = {
    {K_P0, 0},
    {K_GU, 0}, {K_DN, 0}, {K_IN, 0}, {K_LIN, 0}, {K_LORA, 0}, {K_SCAN, 0}, {K_POST, 0}, {K_OUT, 0}, {K_GU, 1}, {K_DN, 1},
    {K_GU, 2}, {K_DN, 2}, {K_IN, 1}, {K_LIN, 1}, {K_SCAN, 1}, {K_POST, 1}, {K_OUT, 1}, {K_GU, 3}, {K_DN, 3},
    {K_GU, 4}, {K_DN, 4}, {K_IN, 2}, {K_LIN, 2}, {K_LORA, 2}, {K_SCAN, 2}, {K_POST, 2}, {K_OUT, 2}, {K_GU, 5}, {K_DN, 5},
    {K_GU, 6}, {K_DN, 6}, {K_IN, 3}, {K_LIN, 3}, {K_SCAN, 3}, {K_POST, 3}, {K_OUT, 3}, {K_GU, 7}, {K_DN, 7},
    {K_FINAL, 0}};

__device__ __forceinline__ float bf2f(unsigned short b) { return __uint_as_float(((unsigned)b) << 16); }
__device__ __forceinline__ float bflo(unsigned u) { return __uint_as_float(u << 16); }
__device__ __forceinline__ float bfhi(unsigned u) { return __uint_as_float(u & 0xffff0000u); }
__device__ __forceinline__ unsigned pk2(float lo, float hi) { unsigned r; asm volatile("v_cvt_pk_bf16_f32 %0, %1, %2" : "=v"(r) : "v"(lo), "v"(hi)); return r; }
__device__ __forceinline__ float sigmoidf_(float x) { return __builtin_amdgcn_rcpf(1.0f + __expf(-x)); }
__device__ __forceinline__ float siluf_(float x) { return x * __builtin_amdgcn_rcpf(1.0f + __expf(-x)); }
__device__ __forceinline__ float wave_sum(float v) {
#pragma unroll
    for (int o = 1; o < 64; o <<= 1) v += __shfl_xor(v, o);
    return v;
}
template <int CTRL> __device__ __forceinline__ float dppf(float v) { return __int_as_float(__builtin_amdgcn_update_dpp(0, __float_as_int(v), CTRL, 0xF, 0xF, true)); }
__device__ __forceinline__ float allred8(float v) { v += dppf<0xB1>(v); v += dppf<0x4E>(v); v += dppf<0x141>(v); return v; }
__device__ __forceinline__ float allred16(float v) { v = allred8(v); v += dppf<0x140>(v); return v; }
#define LDS_WAIT() asm volatile("s_waitcnt lgkmcnt(0)" ::: "memory")
__device__ __forceinline__ float amul(float a, float b) { float r; asm("v_mul_f32 %0, %1, %2" : "=v"(r) : "v"(a), "v"(b)); return r; }
__device__ __forceinline__ float afma(float a, float b, float c) { float r; asm("v_fma_f32 %0, %1, %2, %3" : "=v"(r) : "v"(a), "v"(b), "v"(c)); return r; }

__device__ __forceinline__ float rstd_of(const GAS float* ssq, int row) {
    const GAS f32x4* p = (const GAS f32x4*)(ssq + (size_t)row * 16);
    const f32x4 a = p[0], b = p[1], c = p[2], d = p[3];
    const float s = ((a.x + a.y) + (a.z + a.w)) + ((b.x + b.y) + (b.z + b.w)) + ((c.x + c.y) + (c.z + c.w)) + ((d.x + d.y) + (d.z + d.w));
    return rsqrtf(s * (1.0f / 1024.0f) + 1e-6f);
}

namespace pg8 {
constexpr int BM = 256, BK = 64, HALF = 128, HTB = HALF * BK * 2, NXCD = 8, WGM = 8;
__device__ __forceinline__ int lds_byte(int r, int c) { const int st = (r >> 4) * 2 + (c >> 5), rr = r & 15, cc = c & 31, ob = rr * 64 + cc * 2; return st * 1024 + (ob ^ (((ob >> 9) & 1) << 5)); }
__device__ __forceinline__ void stage_rc(int b, int& R, int& C) { const int st = b / 1024, sb = b % 1024, swz = sb ^ (((sb >> 9) & 1) << 5); R = (st >> 1) * 16 + swz / 64; C = (st & 1) * 32 + (swz % 64) / 2; }
struct Unit { int pm, pn, k0, nt, kc; };
struct Gemm { const GAS bf16_t* A; const GAS bf16_t* Bt; int M, N, K; };
struct StaticOrder {
    int nM, nN, nwg, G, c, ntK, ntail;
    __device__ __forceinline__ void init(int M, int N, int K, int G_, int c_, int tail) { nM = M / BM - (tail ? 1 : 0); nN = N / BM; nwg = nM * nN; G = G_; c = c_; ntK = K / BK; ntail = tail ? nN * (K / 256) : 0; }
    __device__ __forceinline__ bool next(int i, Unit& u) const {
        const long L = (long)i * G + c; if (L >= nwg + ntail) return false;
        const bool tl = L >= nwg; const int j = tl ? (int)L - nwg : 0;
        int wgid = tl ? 0 : (int)L; { const int q = nwg / NXCD, r = nwg % NXCD, xcd = wgid % NXCD, off = wgid / NXCD; wgid = (xcd < r ? xcd * (q + 1) : r * (q + 1) + (xcd - r) * q) + off; }
        const int nig = WGM * nN, gid = wgid / nig, fm = gid * WGM, gsz = (nM - fm) < WGM ? (nM - fm) : WGM;
        const int pm_ = fm + ((wgid % nig) % gsz), pn_ = (wgid % nig) / gsz, kc_ = j / nN;
        u.pm = tl ? nM : pm_; u.pn = tl ? j % nN : pn_; u.k0 = tl ? kc_ * 256 : 0; u.nt = tl ? 4 : ntK; u.kc = tl ? kc_ : -1;
        return true;
    }
};

template <class Epi>
__device__ __forceinline__ void gemm_phase(LAS unsigned char* lds, const Gemm g, const StaticOrder& S, const Epi& E, const int tid) {
    const int wid = __builtin_amdgcn_readfirstlane(tid >> 6), lane = tid & 63, wr = wid >> 2, wc = wid & 3, fr = lane & 15, fq = lane >> 4;
    const int K = g.K;
    unsigned voffA[2];
#pragma unroll
    for (int i = 0; i < 2; ++i) { int R, C; stage_rc(tid * 16 + i * 8192, R, C); voffA[i] = (unsigned)(R * K + C) * 2u; }
    const size_t kstep = (size_t)(BK * 2);
    const size_t hstep = (size_t)HALF * K * 2;
    const size_t tstep = 2 * hstep;
    const unsigned ldsw = (unsigned)wid * 1024u;
    const int aoff = lds_byte(wr * 64 + fr, fq * 8), boff = lds_byte(wc * 32 + fr, fq * 8);
#define PG8_SA(b, h) (((b) * 2 + (h)) * HTB)
#define PG8_SB(b, h) ((4 + (b) * 2 + (h)) * HTB)
#define PG8_STAGE(bufoff, gbase, voff) do { _Pragma("unroll") for (int _i = 0; _i < 2; ++_i) \
        __builtin_amdgcn_global_load_lds((const unsigned*)((const char*)(gbase) + (voff)[_i]), (LAS unsigned*)(lds + (bufoff) + ldsw + _i * 8192), 16, 0, 0); } while (0)
#define PG8_LDA(dst, b, h) do { _Pragma("unroll") for (int m = 0; m < 4; ++m) _Pragma("unroll") for (int k = 0; k < 2; ++k) dst[m][k] = *(const LAS bf16x8*)(lds + PG8_SA(b, h) + aoff + m * 2048 + k * 1024); } while (0)
#define PG8_LDB(dst, b, h) do { _Pragma("unroll") for (int n = 0; n < 2; ++n) _Pragma("unroll") for (int k = 0; k < 2; ++k) dst[n][k] = *(const LAS bf16x8*)(lds + PG8_SB(b, h) + boff + n * 2048 + k * 1024); } while (0)
#define PG8_MMA(ai, bj, At, Bt) do { __builtin_amdgcn_s_setprio(1); _Pragma("unroll") for (int m = 0; m < 4; ++m) _Pragma("unroll") for (int n = 0; n < 2; ++n) _Pragma("unroll") for (int k = 0; k < 2; ++k) \
        acc[ai][bj][m][n] = __builtin_amdgcn_mfma_f32_16x16x32_bf16(Bt[n][k], At[m][k], acc[ai][bj][m][n], 0, 0, 0); __builtin_amdgcn_s_setprio(0); } while (0)
#define PG8_WAIT_V(n) asm volatile("s_waitcnt vmcnt(" #n ")" ::: "memory")
#define PG8_WAIT_L(n) asm volatile("s_waitcnt lgkmcnt(" #n ")" ::: "memory")
#define PG8_BAR __builtin_amdgcn_s_barrier()
#define PG8_SCHED __builtin_amdgcn_sched_barrier(0)
    Unit cur, nxt; int ui = 0;
    if (!S.next(0, cur)) return;
    f32x4 acc[2][2][4][2];
#pragma unroll
    for (int a = 0; a < 2; ++a)
#pragma unroll
        for (int b = 0; b < 2; ++b)
#pragma unroll
            for (int m = 0; m < 4; ++m)
#pragma unroll
                for (int n = 0; n < 2; ++n) acc[a][b][m][n] = (f32x4){0.f, 0.f, 0.f, 0.f};
    bf16x8 At[4][2], B0[2][2], B1[2][2];
    const char* cA = (const char*)g.A + (size_t)cur.pm * tstep + (size_t)cur.k0 * 2; const char* cB = (const char*)g.Bt + (size_t)cur.pn * tstep + (size_t)cur.k0 * 2;
    PG8_STAGE(PG8_SB(0, 0), cB, voffA); PG8_STAGE(PG8_SA(0, 0), cA, voffA); PG8_STAGE(PG8_SB(0, 1), cB + hstep, voffA); PG8_STAGE(PG8_SA(0, 1), cA + hstep, voffA);
    if (wr == 1) PG8_BAR;
    PG8_WAIT_V(4); PG8_BAR;
    PG8_STAGE(PG8_SB(1, 0), cB + kstep, voffA); PG8_STAGE(PG8_SA(1, 0), cA + kstep, voffA); PG8_STAGE(PG8_SB(1, 1), cB + hstep + kstep, voffA);
    PG8_WAIT_V(6); PG8_BAR;
    for (;;) {
        const bool has_next = S.next(ui + 1, nxt);
        const char* nA = has_next ? (const char*)g.A + (size_t)nxt.pm * tstep + (size_t)nxt.k0 * 2 : cA; const char* nB = has_next ? (const char*)g.Bt + (size_t)nxt.pn * tstep + (size_t)nxt.k0 * 2 : cB;
        const int nt = cur.nt;
        for (int t = 0; t < nt; t += 2) {
            const bool last = (t == nt - 2);
            const char* a1 = cA + (size_t)(t + 1) * kstep;
            const char* a2 = last ? nA : cA + (size_t)(t + 2) * kstep; const char* b2 = last ? nB : cB + (size_t)(t + 2) * kstep;
            const char* a3 = a2 + kstep; const char* b3 = b2 + kstep;
            PG8_LDB(B0, 0, 0); PG8_SCHED; PG8_LDA(At, 0, 0); PG8_STAGE(PG8_SA(1, 1), a1 + hstep, voffA);
            PG8_WAIT_L(8); PG8_BAR; PG8_WAIT_L(0); PG8_MMA(0, 0, At, B0); PG8_BAR; PG8_SCHED;
            PG8_LDB(B1, 0, 1); PG8_STAGE(PG8_SB(0, 0), b2, voffA);
            PG8_BAR; PG8_WAIT_L(0); PG8_MMA(0, 1, At, B1); PG8_BAR;
            PG8_LDA(At, 0, 1); PG8_STAGE(PG8_SA(0, 0), a2, voffA);
            PG8_BAR; PG8_WAIT_L(0); PG8_MMA(1, 0, At, B0); PG8_BAR; PG8_SCHED;
            PG8_STAGE(PG8_SB(0, 1), b2 + hstep, voffA);
            PG8_WAIT_V(6); PG8_BAR; PG8_MMA(1, 1, At, B1); PG8_BAR;
            PG8_LDB(B0, 1, 0); PG8_SCHED; PG8_LDA(At, 1, 0); PG8_STAGE(PG8_SA(0, 1), a2 + hstep, voffA);
            PG8_WAIT_L(8); PG8_BAR; PG8_WAIT_L(0); PG8_MMA(0, 0, At, B0); PG8_BAR; PG8_SCHED;
            PG8_LDB(B1, 1, 1); PG8_STAGE(PG8_SB(1, 0), b3, voffA);
            PG8_BAR; PG8_WAIT_L(0); PG8_MMA(0, 1, At, B1); PG8_BAR;
            PG8_LDA(At, 1, 1); PG8_STAGE(PG8_SA(1, 0), a3, voffA);
            PG8_BAR; PG8_WAIT_L(0); PG8_MMA(1, 0, At, B0); PG8_BAR; PG8_SCHED;
            PG8_STAGE(PG8_SB(1, 1), b3 + hstep, voffA);
            PG8_WAIT_V(6); PG8_BAR; PG8_MMA(1, 1, At, B1); PG8_BAR;
        }
        E(acc, cur, wr, wc, fr, fq);
        if (!has_next) break;
#pragma unroll
        for (int a = 0; a < 2; ++a)
#pragma unroll
            for (int b = 0; b < 2; ++b)
#pragma unroll
                for (int m = 0; m < 4; ++m)
#pragma unroll
                    for (int n = 0; n < 2; ++n) acc[a][b][m][n] = (f32x4){0.f, 0.f, 0.f, 0.f};
        cur = nxt; cA = nA; cB = nB; ++ui;
    }
    PG8_WAIT_V(0);
    if (wr == 0) PG8_BAR;
    PG8_BAR;
#undef PG8_SA
#undef PG8_SB
#undef PG8_STAGE
#undef PG8_LDA
#undef PG8_LDB
#undef PG8_MMA
#undef PG8_WAIT_V
#undef PG8_WAIT_L
#undef PG8_BAR
#undef PG8_SCHED
}
}
using pg8::Unit;

struct Epi {
    int mode, ldo; float scale; GAS unsigned char* ws;
    __device__ __forceinline__ void operator()(const f32x4 (&acc)[2][2][4][2], const Unit& u, int wr, int wc, int fr, int fq) const {
        const int row0 = u.pm * 256 + wr * 64 + fr, col0 = u.pn * 256 + wc * 32 + 4 * fq;
        const GAS float* ssq_in = (const GAS float*)(ws + WS_SSQ); GAS float* ssq_out = (GAS float*)(ws + WS_SSQ); GAS float* xf = (GAS float*)(ws + WS_XF); GAS bf16_t* xb = (GAS bf16_t*)(ws + WS_XB);
        GAS float* part = (GAS float*)(ws + WS_PART); GAS bf16_t* O = (GAS bf16_t*)(ws + (mode == 3 ? WS_LRAW : WS_PROJ));
        if (u.kc >= 0) {
#pragma unroll
            for (int ai = 0; ai < 2; ++ai)
#pragma unroll
                for (int m = 0; m < 4; ++m) {
                    GAS float* rp = part + ((size_t)u.kc * 256 + (wr * 64 + fr + ai * 128 + m * 16)) * 1024 + col0;
#pragma unroll
                    for (int bj = 0; bj < 2; ++bj)
#pragma unroll
                        for (int n = 0; n < 2; ++n) *(GAS f32x4*)(rp + bj * 128 + n * 16) = acc[ai][bj][m][n];
                }
        } else if (mode == 0) {
#pragma unroll
            for (int ai = 0; ai < 2; ++ai)
#pragma unroll
                for (int m = 0; m < 4; ++m) {
                    const int row = row0 + ai * 128 + m * 16; const float rs = rstd_of(ssq_in, row);
#pragma unroll
                    for (int bj = 0; bj < 2; ++bj) {
                        const int hid = (u.pn * 256 + bj * 128 + wc * 32) / 2 + 4 * fq;
                        const f32x4 gg = acc[ai][bj][m][0] * rs, uu = acc[ai][bj][m][1] * rs;
                        u32x2 w; w.x = pk2(siluf_(gg.x) * uu.x, siluf_(gg.y) * uu.y); w.y = pk2(siluf_(gg.z) * uu.z, siluf_(gg.w) * uu.w);
                        *(GAS u32x2*)(O + (size_t)row * FF + hid) = w;
                    }
                }
        } else if (mode == 1) {
#pragma unroll
            for (int ai = 0; ai < 2; ++ai)
#pragma unroll
                for (int m = 0; m < 4; ++m) {
                    const int row = row0 + ai * 128 + m * 16; float ss = 0.f;
#pragma unroll
                    for (int bj = 0; bj < 2; ++bj)
#pragma unroll
                        for (int n = 0; n < 2; ++n) {
                            const int c = col0 + bj * 128 + n * 16;
                            GAS u32x2* xp = (GAS u32x2*)(xb + (size_t)row * D + c);
                            const u32x2 xo = *xp; f32x4 x = {bflo(xo.x), bfhi(xo.x), bflo(xo.y), bfhi(xo.y)}; x = x + acc[ai][bj][m][n] * scale;
                            u32x2 w; w.x = pk2(x.x, x.y); w.y = pk2(x.z, x.w); *xp = w;
                            ss += (x.x * x.x + x.y * x.y) + (x.z * x.z + x.w * x.w);
                        }
                    ss += __shfl_xor(ss, 16); ss += __shfl_xor(ss, 32);
                    if (fq == 0) ssq_out[(size_t)row * 16 + u.pn * 4 + wc] = ss;
                }
        } else {
#pragma unroll
            for (int ai = 0; ai < 2; ++ai)
#pragma unroll
                for (int m = 0; m < 4; ++m) {
                    const int row = row0 + ai * 128 + m * 16; const float rs = mode == 2 ? rstd_of(ssq_in, row) : 1.0f;
#pragma unroll
                    for (int bj = 0; bj < 2; ++bj)
#pragma unroll
                        for (int n = 0; n < 2; ++n) {
                            const int c = col0 + bj * 128 + n * 16; const f32x4 v = acc[ai][bj][m][n] * rs;
                            u32x2 w; w.x = pk2(v.x, v.y); w.y = pk2(v.z, v.w); *(GAS u32x2*)(O + (size_t)row * ldo + c) = w;
                        }
                }
        }
    }
};

__device__ __forceinline__ int map_col(int n, int kind) {
    if (kind == 1) return ((n >> 4) << 5) + (n & 15);
    if (kind == 2) return ((n >> 4) << 5) + 16 + (n & 15);
    if (kind == 3) return n < 2048 ? n : (n < 2064 ? 3072 + (n - 2048) : n - 16);
    return n;
}
struct TItem { const GAS float* W; const GAS float* gsc; GAS bf16_t* WT; int K, Nsrc, kind, k0, n0; };
__device__ __forceinline__ void titem_load(const TItem& t, f32x4 (&v)[8], int lane) {
    const int nq = t.n0 + (lane & 7) * 4;
#pragma unroll
    for (int i = 0; i < 8; ++i) { const int kk = 8 * i + (lane >> 3); v[i] = (nq < t.Nsrc) ? *(const GAS f32x4*)(t.W + (size_t)(t.k0 + kk) * t.Nsrc + nq) : (f32x4){0.f, 0.f, 0.f, 0.f}; }
}
__device__ __forceinline__ void titem_store(const TItem& t, const f32x4 (&v)[8], LAS float* scr, int lane) {
#pragma unroll
    for (int i = 0; i < 8; ++i) {
        const int kk = 8 * i + (lane >> 3); const float g = t.gsc ? t.gsc[t.k0 + kk] : 1.0f;
        LAS float* d = scr + kk * 33 + (lane & 7) * 4;
        d[0] = v[i].x * g; d[1] = v[i].y * g; d[2] = v[i].z * g; d[3] = v[i].w * g;
    }
    LDS_WAIT();
    const int c = lane & 7;
#pragma unroll
    for (int j = 0; j < 4; ++j) {
        const int nl = (lane >> 3) + 8 * j, n = t.n0 + nl;
        if (n < t.Nsrc) {
            const LAS float* s = scr + (8 * c) * 33 + nl;
            u32x4 o; o.x = pk2(s[0 * 33], s[1 * 33]); o.y = pk2(s[2 * 33], s[3 * 33]); o.z = pk2(s[4 * 33], s[5 * 33]); o.w = pk2(s[6 * 33], s[7 * 33]);
            *(GAS u32x4*)(t.WT + (size_t)map_col(n, t.kind) * t.K + t.k0 + 8 * c) = o;
        }
    }
    LDS_WAIT();
}
__device__ __forceinline__ TItem titem_decode(const Ctx& p, int it) {
    GAS unsigned char* ws = p.ws;
    constexpr int IT_G = 176, N_G = 8 * IT_G, IT_E = 240, N_E = 2 * IT_E, IT_O = 200, N_O = 2 * IT_O, IT_W = 64;
    TItem t; int r = it, nblk;
    if (r < 2 * N_G) {
        const int up = r >= N_G; if (up) r -= N_G;
        const int mat = r / IT_G, l = mat >> 1, f = mat & 1; r %= IT_G;
        t.W = p.in(f ? (up ? I_F2U : I_F2G) : (up ? I_F1U : I_F1G)) + (size_t)l * D * FF; t.gsc = p.in(f ? I_NF2 : I_NF1) + l * D;
        t.WT = (GAS bf16_t*)(ws + WS_WGU) + (size_t)mat * 5632 * 1024; t.K = D; t.Nsrc = FF; t.kind = up ? 2 : 1;
    } else if ((r -= 2 * N_G) < N_G) {
        const int mat = r / IT_G, l = mat >> 1, f = mat & 1; r %= IT_G;
        t.W = p.in(f ? I_F2D : I_F1D) + (size_t)l * FF * D; t.gsc = nullptr; t.WT = (GAS bf16_t*)(ws + WS_WD) + (size_t)mat * 1024 * FF; t.K = FF; t.Nsrc = D; t.kind = 0;
    } else if ((r -= N_G) < N_E) {
        const int mat = r / IT_E; r %= IT_E;
        t.W = p.in(I_EWIN) + (size_t)mat * D * EPROJ; t.gsc = p.in(I_NMIX) + (2 * mat) * D; t.WT = (GAS bf16_t*)(ws + WS_WINE) + (size_t)mat * EPROJ * 1024; t.K = D; t.Nsrc = EPROJ; t.kind = 0;
    } else if ((r -= N_E) < N_O) {
        const int mat = r / IT_O; r %= IT_O;
        t.W = p.in(I_OWIN) + (size_t)mat * D * OSRC; t.gsc = p.in(I_NMIX) + (2 * mat + 1) * D; t.WT = (GAS bf16_t*)(ws + WS_WINO) + (size_t)mat * OPROJ * 1024; t.K = D; t.Nsrc = OSRC; t.kind = 3;
    } else {
        r -= N_O; const int mat = r / IT_W; r %= IT_W;
        t.W = (mat & 1) ? p.in(I_OWOUT) + (size_t)(mat >> 1) * D * D : p.in(I_EWOUT) + (size_t)(mat >> 1) * D * D; t.gsc = nullptr;
        t.WT = (GAS bf16_t*)(ws + WS_WOUT) + (size_t)mat * D * D; t.K = D; t.Nsrc = D; t.kind = 0;
    }
    nblk = (t.Nsrc + 127) / 128; t.k0 = 128 * (r / nblk); t.n0 = 128 * (r % nblk);
    return t;
}

__device__ __forceinline__ void phase_p0(const Ctx& p, LAS unsigned char* lds) {
    const int tid = p.tid, lane = tid & 63, wave = tid >> 6;
    const int gw = p.bid * NWAVES + wave, NGW = p.G * NWAVES;
    GAS unsigned char* ws = p.ws;
    GAS bf16_t* WINO = (GAS bf16_t*)(ws + WS_WINO); GAS bf16_t* WLORA = (GAS bf16_t*)(ws + WS_WLORA);
    constexpr int NITEMS = 3 * 8 * 1408 + 2 * 1920 + 2 * 1552 + 4 * 512;
    {
        constexpr int NTILES = 3 * 8 * 176 + 2 * 240 + 2 * 200 + 4 * 64;
        LAS float* tile = (LAS float*)lds;
        const int q = tid & 31, r0 = tid >> 5;
        for (int tix = p.bid; tix < NTILES; tix += p.G) {
            const TItem t = titem_decode(p, tix);
            const int nq = t.n0 + 4 * q;
            f32x4 v[8]; float g8[8];
#pragma unroll
            for (int i = 0; i < 8; ++i) { const int kk = r0 + 16 * i; v[i] = (nq < t.Nsrc) ? __builtin_nontemporal_load((const GAS f32x4*)(t.W + (size_t)(t.k0 + kk) * t.Nsrc + nq)) : (f32x4){0.f, 0.f, 0.f, 0.f}; g8[i] = t.gsc ? t.gsc[t.k0 + kk] : 1.0f; }
            __syncthreads();
#pragma unroll
            for (int i = 0; i < 8; ++i) { LAS float* d = tile + (r0 + 16 * i) * 129 + 4 * q; d[0] = v[i].x * g8[i]; d[1] = v[i].y * g8[i]; d[2] = v[i].z * g8[i]; d[3] = v[i].w * g8[i]; }
            __syncthreads();
#pragma unroll
            for (int j = 0; j < 4; ++j) {
                const int id = tid + NTHREADS * j, nl = id >> 4, c16 = id & 15, n = t.n0 + nl;
                if (n < t.Nsrc) {
                    const LAS float* sp = tile + (8 * c16) * 129 + nl;
                    u32x4 o; o.x = pk2(sp[0 * 129], sp[1 * 129]); o.y = pk2(sp[2 * 129], sp[3 * 129]); o.z = pk2(sp[4 * 129], sp[5 * 129]); o.w = pk2(sp[6 * 129], sp[7 * 129]);
                    *(GAS u32x4*)(t.WT + (size_t)map_col(n, t.kind) * t.K + t.k0 + 8 * c16) = o;
                }
            }
        }
        __syncthreads();
    }
    const size_t gt = (size_t)p.bid * NTHREADS + tid, GT = (size_t)p.G * NTHREADS;
    for (size_t i = gt; i < (size_t)2 * 240 * 1024 / 2; i += GT) {
        const size_t mat = i / (240 * 512), r = i % (240 * 512);
        ((GAS unsigned*)(WINO + (size_t)mat * OPROJ * 1024 + (size_t)OSRC * 1024))[r] = 0u;
    }
    for (size_t i = gt; i < (size_t)2 * 1536 * 256; i += GT) {
        const int e = (int)(i / (1536 * 256)), n = (int)((i / 256) % 1536), k = (int)(i % 256), region = n >> 9, ch = n & 511;
        float v = 0.f;
        if (region == 0) { if (k < 64) v = p.in(I_W2)[((size_t)e * 64 + k) * 512 + ch]; }
        else if (region == 1) { if (k >= 64 && k < 128) v = p.in(I_A2)[((size_t)e * 64 + (k - 64)) * 512 + ch]; }
        else { if (k >= 128) v = p.in(I_G2)[((size_t)e * 128 + (k - 128)) * 512 + ch]; }
        WLORA[i] = (bf16_t)(pk2(v, 0.f) & 0xffffu);
    }
    GAS float* xf = (GAS float*)(ws + WS_XF); GAS bf16_t* xb = (GAS bf16_t*)(ws + WS_XB); GAS float* ssq = (GAS float*)(ws + WS_SSQ);
    for (int m = gw; m < MT; m += NGW) {
        const GAS float* src;
        if (m < MP) { const int b = m / TP, t = m % TP; src = t < 16 ? p.in(I_META) + (size_t)t * D : p.in(I_XP) + ((size_t)b * 2048 + (t - 16)) * D; }
        else src = p.in(I_XS) + (size_t)(m - MP) * D;
        float ss = 0.f;
#pragma unroll
        for (int j = 0; j < 4; ++j) {
            const int c = 4 * lane + 256 * j; const f32x4 x = *(const GAS f32x4*)(src + c);
            u32x2 w; w.x = pk2(x.x, x.y); w.y = pk2(x.z, x.w); *(GAS u32x2*)(xb + (size_t)m * D + c) = w;
            ss += (x.x * x.x + x.y * x.y) + (x.z * x.z + x.w * x.w);
        }
        ss = wave_sum(ss);
        if (lane < 16) ssq[(size_t)m * 16 + lane] = lane == 0 ? ss : 0.f;
        if (lane == 0) ((GAS float*)(ws + WS_RSTD))[m] = rsqrtf(ss * (1.0f / 1024.0f) + 1e-6f);
    }
}

__device__ __forceinline__ float lbval(const Ctx& p, int e, int ch) { return e == 0 ? 0.f : __builtin_amdgcn_rcpf(1.0f + __expf(p.in(I_LB)[ch] - p.in(I_LB)[512 + ch])); }

__device__ __forceinline__ void phase_fprep(const Ctx& p, int odd, int idx) {
    GAS unsigned char* ws = p.ws;
    const GAS bf16_t* proj = (const GAS bf16_t*)(ws + WS_PROJ);
    GAS bf16_t* QDg = (GAS bf16_t*)(ws + WS_MIXB); GAS bf16_t* KDg = QDg + (size_t)MT * 512; GAS bf16_t* KDTg = (GAS bf16_t*)(ws + WS_KDT); GAS float* ELg = (GAS float*)(ws + WS_ELG);
    const int LDP = odd ? OPROJ : EPROJ;
    constexpr float SC = 0.08838834764831845f;
    const int tid = p.tid, lane = tid & 63, wv = tid >> 6, cg = lane & 15, tq = lane >> 4, c4 = (wv * 16 + cg) * 4;
    f32x4 gu[16]; f32x4 gbv = {0.f, 0.f, 0.f, 0.f}; float lb[4] = {0.f, 0.f, 0.f, 0.f};
    if (odd) {
#pragma unroll
        for (int r = 0; r < 16; ++r) gu[r] = *(const GAS f32x4*)(p.in(I_GUP) + ((size_t)idx * 16 + r) * 512 + c4);
        gbv = *(const GAS f32x4*)(p.in(I_GB) + (size_t)idx * 512 + c4);
    } else {
#pragma unroll
        for (int r = 0; r < 16; ++r) gu[r] = (f32x4){0.f, 0.f, 0.f, 0.f};
#pragma unroll
        for (int i = 0; i < 4; ++i) lb[i] = lbval(p, idx, c4 + i);
    }
    for (int pair = p.bid; pair < 8 * 65; pair += p.G) {
        const int b = pair / 65, ch = pair % 65, tok0 = ch * 32 + tq * 8;
        const size_t m0 = (size_t)b * TP + tok0;
        u32x2 qv[8], kv[8];
#pragma unroll
        for (int j = 0; j < 8; ++j) { const GAS bf16_t* row = proj + (m0 + j) * LDP; qv[j] = *(const GAS u32x2*)(row + c4); kv[j] = *(const GAS u32x2*)(row + 512 + c4); }
        f32x4 lf[8];
        if (odd) {
            u32x4 g0[8], g1[8];
#pragma unroll
            for (int j = 0; j < 8; ++j) { const GAS bf16_t* row = proj + (m0 + j) * LDP; g0[j] = *(const GAS u32x4*)(row + 3072); g1[j] = *(const GAS u32x4*)(row + 3080); }
#pragma unroll
            for (int j = 0; j < 8; ++j) {
                const float gd[16] = {bflo(g0[j].x), bfhi(g0[j].x), bflo(g0[j].y), bfhi(g0[j].y), bflo(g0[j].z), bfhi(g0[j].z), bflo(g0[j].w), bfhi(g0[j].w),
                                      bflo(g1[j].x), bfhi(g1[j].x), bflo(g1[j].y), bfhi(g1[j].y), bflo(g1[j].z), bfhi(g1[j].z), bflo(g1[j].w), bfhi(g1[j].w)};
                f32x4 gk = gbv;
#pragma unroll
                for (int r = 0; r < 16; ++r) gk = gk + gu[r] * gd[r];
                lf[j].x = (fminf(gk.x, 0.f) - __logf(1.0f + __expf(-fabsf(gk.x)))) * 0.0625f; lf[j].y = (fminf(gk.y, 0.f) - __logf(1.0f + __expf(-fabsf(gk.y)))) * 0.0625f;
                lf[j].z = (fminf(gk.z, 0.f) - __logf(1.0f + __expf(-fabsf(gk.z)))) * 0.0625f; lf[j].w = (fminf(gk.w, 0.f) - __logf(1.0f + __expf(-fabsf(gk.w)))) * 0.0625f;
            }
        } else {
#pragma unroll
            for (int j = 0; j < 8; ++j) {
                const float fa[4] = {bflo(kv[j].x), bfhi(kv[j].x), bflo(kv[j].y), bfhi(kv[j].y)}; float l4[4];
#pragma unroll
                for (int i = 0; i < 4; ++i) l4[i] = __logf(1.0f - (1.0f - lb[i]) * __builtin_amdgcn_rcpf(1.0f + __expf(fa[i])));
                lf[j] = (f32x4){l4[0], l4[1], l4[2], l4[3]};
            }
        }
        f32x4 kk[8];
#pragma unroll
        for (int j = 0; j < 8; ++j) {
            const bool ok = tok0 + j < TP;
            if (odd) kk[j] = (f32x4){bflo(kv[j].x), bfhi(kv[j].x), bflo(kv[j].y), bfhi(kv[j].y)};
            else kk[j] = (f32x4){1.0f - __expf(lf[j].x), 1.0f - __expf(lf[j].y), 1.0f - __expf(lf[j].z), 1.0f - __expf(lf[j].w)};
            if (!ok) { lf[j] = (f32x4){0.f, 0.f, 0.f, 0.f}; kk[j] = lf[j]; qv[j] = (u32x2){0u, 0u}; }
            if (j) lf[j] = lf[j] + lf[j - 1];
        }
        f32x4 pre = {0.f, 0.f, 0.f, 0.f};
        {
            const float tot[4] = {lf[7].x, lf[7].y, lf[7].z, lf[7].w}; float pr4[4];
#pragma unroll
            for (int i = 0; i < 4; ++i) {
                const float p0 = __int_as_float(__builtin_amdgcn_ds_bpermute(cg << 2, __float_as_int(tot[i]))), p1 = __int_as_float(__builtin_amdgcn_ds_bpermute((cg + 16) << 2, __float_as_int(tot[i]))),
                            p2 = __int_as_float(__builtin_amdgcn_ds_bpermute((cg + 32) << 2, __float_as_int(tot[i])));
                pr4[i] = (tq > 0 ? p0 : 0.f) + (tq > 1 ? p1 : 0.f) + (tq > 2 ? p2 : 0.f);
            }
            pre = (f32x4){pr4[0], pr4[1], pr4[2], pr4[3]};
        }
        u32x4 kt[4];
        unsigned ktw[4][4];
#pragma unroll
        for (int j = 0; j < 8; j += 2) {
            f32x4 kd2[2];
#pragma unroll
            for (int jj = 0; jj < 2; ++jj) {
                const f32x4 cu4 = lf[j + jj] + pre; const float cu[4] = {fmaxf(cu4.x, -85.0f), fmaxf(cu4.y, -85.0f), fmaxf(cu4.z, -85.0f), fmaxf(cu4.w, -85.0f)};
                const float q4[4] = {bflo(qv[j + jj].x), bfhi(qv[j + jj].x), bflo(qv[j + jj].y), bfhi(qv[j + jj].y)}; const float k4[4] = {kk[j + jj].x, kk[j + jj].y, kk[j + jj].z, kk[j + jj].w};
                float qd[4], kd[4];
#pragma unroll
                for (int i = 0; i < 4; ++i) { qd[i] = q4[i] * SC * __expf(cu[i]); kd[i] = k4[i] * __expf(-cu[i]); }
                kd2[jj] = (f32x4){kd[0], kd[1], kd[2], kd[3]};
                if (tok0 + j + jj < TP) {
                    *(GAS u32x2*)(QDg + (m0 + j + jj) * 512 + c4) = (u32x2){pk2(qd[0], qd[1]), pk2(qd[2], qd[3])};
                    *(GAS u32x2*)(KDg + (m0 + j + jj) * 512 + c4) = (u32x2){pk2(kd[0], kd[1]), pk2(kd[2], kd[3])};
                }
            }
            ktw[0][j >> 1] = pk2(kd2[0].x, kd2[1].x); ktw[1][j >> 1] = pk2(kd2[0].y, kd2[1].y); ktw[2][j >> 1] = pk2(kd2[0].z, kd2[1].z); ktw[3][j >> 1] = pk2(kd2[0].w, kd2[1].w);
        }
#pragma unroll
        for (int i = 0; i < 4; ++i) { kt[i] = (u32x4){ktw[i][0], ktw[i][1], ktw[i][2], ktw[i][3]};
            *(GAS u32x4*)(KDTg + (((size_t)b * 65 + ch) * 512 + c4 + i) * 32 + tq * 8) = kt[i]; }
        if (tq == 3) {
            const f32x4 ce = lf[7] + pre;
            *(GAS f32x4*)(ELg + ((size_t)b * 65 + ch) * 512 + c4) = (f32x4){__expf(fmaxf(ce.x, -85.0f)), __expf(fmaxf(ce.y, -85.0f)), __expf(fmaxf(ce.z, -85.0f)), __expf(fmaxf(ce.w, -85.0f))};
        }
    }
}

__device__ __forceinline__ void phase_lin(const Ctx& p, int e) {
    GAS unsigned char* ws = p.ws;
    const GAS bf16_t* proj = (const GAS bf16_t*)(ws + WS_PROJ); GAS bf16_t* lin = (GAS bf16_t*)(ws + WS_LIN);
    const GAS float* mu = p.in(I_MU) + (size_t)e * 1792; const GAS float* sst = p.in(I_SS) + (size_t)e * NS * 1792;
    const size_t gt = (size_t)p.bid * NTHREADS + p.tid, GT = (size_t)p.G * NTHREADS;
    for (size_t i = gt; i < (size_t)MT * 32; i += GT) {
        const int m = (int)(i >> 5), j8 = (int)(i & 31) * 8;
        const u32x4 cu = *(const GAS u32x4*)(proj + (size_t)m * EPROJ + 3584 + j8);
        float cur[8] = {bflo(cu.x), bfhi(cu.x), bflo(cu.y), bfhi(cu.y), bflo(cu.z), bfhi(cu.z), bflo(cu.w), bfhi(cu.w)};
        float prv[8];
        if (m >= MP) { const GAS float* s = sst + (size_t)(m - MP) * 1792 + 1536 + j8; const f32x4 a = *(const GAS f32x4*)s, b = *(const GAS f32x4*)(s + 4);
            prv[0] = a.x; prv[1] = a.y; prv[2] = a.z; prv[3] = a.w; prv[4] = b.x; prv[5] = b.y; prv[6] = b.z; prv[7] = b.w; }
        else if ((m % TP) == 0) {
#pragma unroll
            for (int j = 0; j < 8; ++j) prv[j] = 0.f; }
        else { const u32x4 pu = *(const GAS u32x4*)(proj + (size_t)(m - 1) * EPROJ + 3584 + j8);
            prv[0] = bflo(pu.x); prv[1] = bfhi(pu.x); prv[2] = bflo(pu.y); prv[3] = bfhi(pu.y); prv[4] = bflo(pu.z); prv[5] = bfhi(pu.z); prv[6] = bflo(pu.w); prv[7] = bfhi(pu.w); }
        const f32x4 m0 = *(const GAS f32x4*)(mu + 1536 + j8), m1 = *(const GAS f32x4*)(mu + 1536 + j8 + 4);
        const float mm[8] = {m0.x, m0.y, m0.z, m0.w, m1.x, m1.y, m1.z, m1.w};
        float o[8];
#pragma unroll
        for (int j = 0; j < 8; ++j) { const float x = cur[j] + (prv[j] - cur[j]) * mm[j]; o[j] = j8 < 64 ? 1.0f - 2.0f * __builtin_amdgcn_rcpf(1.0f + __expf(2.0f * x)) : (j8 < 128 ? x : sigmoidf_(x)); }
        u32x4 w; w.x = pk2(o[0], o[1]); w.y = pk2(o[2], o[3]); w.z = pk2(o[4], o[5]); w.w = pk2(o[6], o[7]);
        *(GAS u32x4*)(lin + (size_t)m * 256 + j8) = w;
    }
    for (size_t i = gt; i < (size_t)(NB + NS) * 1792; i += GT) {
        const int s = (int)(i / 1792), c = (int)(i % 1792);
        if (s < NB) p.out[O_SP + ((size_t)e * NB + s) * 1792 + c] = bf2f(proj[((size_t)s * TP + TP - 1) * EPROJ + 2048 + c]);
        else p.out[O_SSH + ((size_t)e * NS + (s - NB)) * 1792 + c] = bf2f(proj[((size_t)MP + (s - NB)) * EPROJ + 2048 + c]);
    }
}

constexpr int TC = 32, NCH = (TP + TC - 1) / TC;

template <bool GLA>
__device__ __forceinline__ void glalike_sample(const Ctx& p, int idx  , int i, int h, LAS unsigned char* lds) {
    constexpr int DV = GLA ? 256 : 128, LDP = GLA ? OPROJ : EPROJ, KR = GLA ? 8 : 16, RPT = 128 / KR, VT = DV / 4;
    const int tid = p.tid, m = MP + i;
    GAS unsigned char* ws = p.ws;
    const GAS bf16_t* pr = (const GAS bf16_t*)(ws + WS_PROJ) + (size_t)m * LDP; GAS float* oraw = (GAS float*)(ws + WS_ORAW);
    LAS float* sq = (LAS float*)lds; LAS float* sk = sq + 128; LAS float* sf = sk + 128; LAS float* sv = sf + 128; LAS float* red = sv + 256;
    __syncthreads();
    if (tid < 128) {
        const int ch = h * 128 + tid;
        if (!GLA) {
            const float qa = bf2f(pr[ch]), fa = bf2f(pr[512 + ch]); const float lb = lbval(p, idx, ch);
            const float kk = (1.0f - lb) / (1.0f + __expf(fa));
            sq[tid] = qa * 0.08838834764831845f; sk[tid] = kk; sf[tid] = 1.0f - kk;
        } else {
            float gk = p.in(I_GB)[(size_t)idx * 512 + ch];
#pragma unroll
            for (int r = 0; r < 16; ++r) gk += bf2f(pr[3072 + r]) * p.in(I_GUP)[((size_t)idx * 16 + r) * 512 + ch];
            const float ls = fminf(gk, 0.f) - __logf(1.0f + __expf(-fabsf(gk)));
            sq[tid] = bf2f(pr[ch]) * 0.08838834764831845f; sk[tid] = bf2f(pr[512 + ch]); sf[tid] = __expf(ls * 0.0625f);
        }
    }
    if (tid >= 128 && tid < 128 + DV) {
        const int c = tid - 128;
        if (!GLA) sv[c] = siluf_(bf2f(pr[1024 + h * 128 + c])); else sv[c] = bf2f(pr[1024 + h * 256 + c]);
    }
    __syncthreads();
    const int v4 = (tid % VT) * 4, kr = tid / VT;
    const size_t soff = ((((size_t)idx * NS + i) * 4 + h) * 128) * DV;
    const GAS float* Sin = p.in(GLA ? I_SG : I_SH) + soff; GAS float* Sout = p.out + (GLA ? O_GS : O_HS) + soff;
    const f32x4 vv = *(const LAS f32x4*)(sv + v4); f32x4 o = {0.f, 0.f, 0.f, 0.f};
#pragma unroll 4
    for (int jj = 0; jj < RPT; ++jj) {
        const int k = kr * RPT + jj;
        f32x4 s = __builtin_nontemporal_load((const GAS f32x4*)(Sin + (size_t)k * DV + v4));
        s = s * sf[k] + vv * sk[k];
        __builtin_nontemporal_store(s, (GAS f32x4*)(Sout + (size_t)k * DV + v4));
        o = o + s * sq[k];
    }
    *(LAS f32x4*)(red + kr * DV + v4) = o;
    __syncthreads();
    if (tid < DV) { float a = 0.f;
#pragma unroll
        for (int r = 0; r < KR; ++r) a += red[r * DV + tid];
        oraw[(size_t)m * 1024 + h * DV + tid] = a; }
}

__device__ __forceinline__ void rwkv_sample(const Ctx& p, int e, int i, int h, LAS unsigned char* lds) {
    const int tid = p.tid, m = MP + i;
    GAS unsigned char* ws = p.ws;
    const GAS bf16_t* pb = (const GAS bf16_t*)(ws + WS_PROJ) + (size_t)m * EPROJ + 2048; GAS float* oraw = (GAS float*)(ws + WS_ORAW);
    const GAS bf16_t* lraw = (const GAS bf16_t*)(ws + WS_LRAW); GAS float* bsum = (GAS float*)(ws + WS_BSUM);
    LAS float* sr = (LAS float*)lds; LAS float* sw = sr + 64; LAS float* sk = sw + 64; LAS float* sn = sk + 64; LAS float* sa_ = sn + 64; LAS float* sv = sa_ + 64;
    __syncthreads();
    if (tid < 64) {
        const int c = h * 64 + tid;
        const GAS float* prev = p.in(I_SS) + ((size_t)e * NS + i) * 1792; const GAS float* mu = p.in(I_MU) + (size_t)e * 1792;
        const float xr = bf2f(pb[c]), xk = bf2f(pb[512 + c]), xv = bf2f(pb[1024 + c]);
        const float r = xr + (prev[c] - xr) * mu[c], k_ = xk + (prev[512 + c] - xk) * mu[512 + c], v = xv + (prev[1024 + c] - xv) * mu[1024 + c];
        const float a = sigmoidf_(p.in(I_A0)[e * 512 + c] + bf2f(lraw[(size_t)m * 1536 + 512 + c]));
        const float w = __expf(-0.60653066f * sigmoidf_(p.in(I_W0)[e * 512 + c] + bf2f(lraw[(size_t)m * 1536 + c])));
        const float kkw = k_ * p.in(I_KK)[e * 512 + c];
        const float nrm = fmaxf(sqrtf(wave_sum(kkw * kkw)), 1e-12f), kk = kkw / nrm;
        const float kmod = k_ * (1.0f + (a - 1.0f) * p.in(I_KA)[e * 512 + c]);
        const float bs = wave_sum(r * kmod * p.in(I_RK)[e * 512 + c]);
        if (tid == 0) bsum[(size_t)m * 8 + h] = bs;
        sr[tid] = r; sw[tid] = w; sk[tid] = kmod; sn[tid] = -kk; sa_[tid] = kk * a; sv[tid] = v;
    }
    __syncthreads();
    const int row = tid >> 3, l = tid & 7;
    const size_t soff = ((((size_t)e * NS + i) * 8 + h) * 64 + row) * 64 + 8 * l;
    const GAS float* Sin = p.in(I_SR) + soff; GAS float* Sout = p.out + O_RS + soff;
    f32x4 s0 = __builtin_nontemporal_load((const GAS f32x4*)Sin), s1 = __builtin_nontemporal_load((const GAS f32x4*)(Sin + 4));
    const f32x4 n0 = *(const LAS f32x4*)(sn + 8 * l), n1 = *(const LAS f32x4*)(sn + 8 * l + 4);
    float sa = (s0.x * n0.x + s0.y * n0.y) + (s0.z * n0.z + s0.w * n0.w) + (s1.x * n1.x + s1.y * n1.y) + (s1.z * n1.z + s1.w * n1.w);
    sa = allred8(sa);
    const f32x4 w0 = *(const LAS f32x4*)(sw + 8 * l), w1 = *(const LAS f32x4*)(sw + 8 * l + 4), a0 = *(const LAS f32x4*)(sa_ + 8 * l), a1 = *(const LAS f32x4*)(sa_ + 8 * l + 4);
    const f32x4 k0 = *(const LAS f32x4*)(sk + 8 * l), k1 = *(const LAS f32x4*)(sk + 8 * l + 4), r0 = *(const LAS f32x4*)(sr + 8 * l), r1 = *(const LAS f32x4*)(sr + 8 * l + 4);
    const float v = sv[row];
    s0 = s0 * w0 + a0 * sa + k0 * v; s1 = s1 * w1 + a1 * sa + k1 * v;
    float y = (s0.x * r0.x + s0.y * r0.y) + (s0.z * r0.z + s0.w * r0.w) + (s1.x * r1.x + s1.y * r1.y) + (s1.z * r1.z + s1.w * r1.w);
    y = allred8(y);
    if (l == 0) oraw[(size_t)m * 1024 + 512 + h * 64 + row] = y;
    __builtin_nontemporal_store(s0, (GAS f32x4*)Sout); __builtin_nontemporal_store(s1, (GAS f32x4*)(Sout + 4));
}

__device__ __forceinline__ void rwkv_prompt_scan(const Ctx& p, int e, int bh, int hf, LAS unsigned char* lds) {
    const int tid = p.tid, lane = tid & 63, wave = tid >> 6, b = bh >> 3, h = bh & 7;
    GAS unsigned char* ws = p.ws;
    const GAS bf16_t* proj = (const GAS bf16_t*)(ws + WS_PROJ); GAS float* oraw = (GAS float*)(ws + WS_ORAW);
    const GAS bf16_t* lraw = (const GAS bf16_t*)(ws + WS_LRAW); GAS float* bsum = (GAS float*)(ws + WS_BSUM);
    LAS float* st = (LAS float*)lds;
    __syncthreads();
    if (wave >= 4) {
        const int ts = tid - 256, s_st = ts >> 3, j8 = (ts & 7) * 8, c0 = h * 64 + j8;
        const GAS float* mu = p.in(I_MU) + (size_t)e * 1792;
        float mu_r[8], mu_k[8], mu_v[8], w0p[8], a0p[8], kkp[8], kap[8], rkp[8];
#pragma unroll
        for (int j = 0; j < 8; ++j) { mu_r[j] = mu[c0 + j]; mu_k[j] = mu[512 + c0 + j]; mu_v[j] = mu[1024 + c0 + j]; w0p[j] = p.in(I_W0)[e * 512 + c0 + j]; a0p[j] = p.in(I_A0)[e * 512 + c0 + j];
            kkp[j] = p.in(I_KK)[e * 512 + c0 + j]; kap[j] = p.in(I_KA)[e * 512 + c0 + j]; rkp[j] = p.in(I_RK)[e * 512 + c0 + j]; }
        for (int c = 0; c < NCH; ++c) {
            {
                const int t = c * TC + s_st; const bool ok = t < TP; const size_t m = (size_t)b * TP + (ok ? t : 0);
                const GAS bf16_t* q = proj + m * EPROJ + 2048 + c0;
                const u32x4 cr = *(const GAS u32x4*)q, ck = *(const GAS u32x4*)(q + 512), cv = *(const GAS u32x4*)(q + 1024);
                u32x4 pr_ = {0u, 0u, 0u, 0u}, pk_ = pr_, pv_ = pr_;
                if (ok && t > 0) { pr_ = *(const GAS u32x4*)(q - EPROJ); pk_ = *(const GAS u32x4*)(q - EPROJ + 512); pv_ = *(const GAS u32x4*)(q - EPROJ + 1024); }
                const u32x4 av = *(const GAS u32x4*)(lraw + m * 1536 + 512 + c0), wv = *(const GAS u32x4*)(lraw + m * 1536 + c0);
                const float xr0[8] = {bflo(cr.x), bfhi(cr.x), bflo(cr.y), bfhi(cr.y), bflo(cr.z), bfhi(cr.z), bflo(cr.w), bfhi(cr.w)};
                const float xk0[8] = {bflo(ck.x), bfhi(ck.x), bflo(ck.y), bfhi(ck.y), bflo(ck.z), bfhi(ck.z), bflo(ck.w), bfhi(ck.w)};
                const float xv0[8] = {bflo(cv.x), bfhi(cv.x), bflo(cv.y), bfhi(cv.y), bflo(cv.z), bfhi(cv.z), bflo(cv.w), bfhi(cv.w)};
                const float qr[8] = {bflo(pr_.x), bfhi(pr_.x), bflo(pr_.y), bfhi(pr_.y), bflo(pr_.z), bfhi(pr_.z), bflo(pr_.w), bfhi(pr_.w)};
                const float qk[8] = {bflo(pk_.x), bfhi(pk_.x), bflo(pk_.y), bfhi(pk_.y), bflo(pk_.z), bfhi(pk_.z), bflo(pk_.w), bfhi(pk_.w)};
                const float qv[8] = {bflo(pv_.x), bfhi(pv_.x), bflo(pv_.y), bfhi(pv_.y), bflo(pv_.z), bfhi(pv_.z), bflo(pv_.w), bfhi(pv_.w)};
                const float ar[8] = {bflo(av.x), bfhi(av.x), bflo(av.y), bfhi(av.y), bflo(av.z), bfhi(av.z), bflo(av.w), bfhi(av.w)};
                const float wr_[8] = {bflo(wv.x), bfhi(wv.x), bflo(wv.y), bfhi(wv.y), bflo(wv.z), bfhi(wv.z), bflo(wv.w), bfhi(wv.w)};
                float xr[8], xk[8], xv[8], a[8], wd[8], kkw[8], kmod[8]; float ss = 0.f, bs = 0.f;
#pragma unroll
                for (int j = 0; j < 8; ++j) {
                    xr[j] = xr0[j] + (qr[j] - xr0[j]) * mu_r[j]; xk[j] = xk0[j] + (qk[j] - xk0[j]) * mu_k[j]; xv[j] = xv0[j] + (qv[j] - xv0[j]) * mu_v[j];
                    a[j] = sigmoidf_(ar[j] + a0p[j]); wd[j] = __expf(-0.60653066f * sigmoidf_(wr_[j] + w0p[j]));
                    kkw[j] = xk[j] * kkp[j]; ss += kkw[j] * kkw[j];
                    kmod[j] = xk[j] * ((a[j] - 1.0f) * kap[j] + 1.0f); bs += xr[j] * kmod[j] * rkp[j];
                }
                ss = allred8(ss); bs = allred8(bs);
                const float inv = rsqrtf(fmaxf(ss, 1e-24f));
                if (ok) {
                    if (hf == 0 && (ts & 7) == 0) bsum[m * 8 + h] = bs;
                    LAS float* sp = st + (c & 1) * (TC * 384) + s_st * 384 + j8;
                    *(LAS f32x4*)(sp) = (f32x4){xr[0], xr[1], xr[2], xr[3]}; *(LAS f32x4*)(sp + 4) = (f32x4){xr[4], xr[5], xr[6], xr[7]};
                    *(LAS f32x4*)(sp + 64) = (f32x4){wd[0], wd[1], wd[2], wd[3]}; *(LAS f32x4*)(sp + 68) = (f32x4){wd[4], wd[5], wd[6], wd[7]};
                    *(LAS f32x4*)(sp + 128) = (f32x4){kmod[0], kmod[1], kmod[2], kmod[3]}; *(LAS f32x4*)(sp + 132) = (f32x4){kmod[4], kmod[5], kmod[6], kmod[7]};
                    *(LAS f32x4*)(sp + 192) = (f32x4){-kkw[0] * inv, -kkw[1] * inv, -kkw[2] * inv, -kkw[3] * inv}; *(LAS f32x4*)(sp + 196) = (f32x4){-kkw[4] * inv, -kkw[5] * inv, -kkw[6] * inv, -kkw[7] * inv};
                    *(LAS f32x4*)(sp + 256) = (f32x4){kkw[0] * inv * a[0], kkw[1] * inv * a[1], kkw[2] * inv * a[2], kkw[3] * inv * a[3]};
                    *(LAS f32x4*)(sp + 260) = (f32x4){kkw[4] * inv * a[4], kkw[5] * inv * a[5], kkw[6] * inv * a[6], kkw[7] * inv * a[7]};
                    *(LAS f32x4*)(sp + 320) = (f32x4){xv[0], xv[1], xv[2], xv[3]}; *(LAS f32x4*)(sp + 324) = (f32x4){xv[4], xv[5], xv[6], xv[7]};
                }
            }
            __syncthreads();
        }
        __syncthreads();
    } else {
        __builtin_amdgcn_s_setprio(2);
        const int rowl = wave * 8 + (lane >> 3), row = hf * 32 + rowl, l = lane & 7;
        f32x2_ S[4];
#pragma unroll
        for (int j = 0; j < 4; ++j) S[j] = (f32x2_){0.f, 0.f};
        __syncthreads();
        for (int c = 0; c < NCH; ++c) {
            const int nsteps = (TP - c * TC) < TC ? (TP - c * TC) : TC;
            GAS float* yp = oraw + ((size_t)b * TP + (size_t)c * TC + l) * 1024 + 512 + h * 64 + row;
            const LAS float* sp = st + (c & 1) * (TC * 384);
#define RW_LD(X, ptr) const f32x4 X##r0 = *(const LAS f32x4*)((ptr) + 8 * l), X##r1 = *(const LAS f32x4*)((ptr) + 8 * l + 4), X##w0 = *(const LAS f32x4*)((ptr) + 64 + 8 * l), X##w1 = *(const LAS f32x4*)((ptr) + 68 + 8 * l), \
                X##k0 = *(const LAS f32x4*)((ptr) + 128 + 8 * l), X##k1 = *(const LAS f32x4*)((ptr) + 132 + 8 * l), X##n0 = *(const LAS f32x4*)((ptr) + 192 + 8 * l), X##n1 = *(const LAS f32x4*)((ptr) + 196 + 8 * l), \
                X##a0 = *(const LAS f32x4*)((ptr) + 256 + 8 * l), X##a1 = *(const LAS f32x4*)((ptr) + 260 + 8 * l); const float X##v = (ptr)[320 + row]
#define RW_LDV(X, ptr) f32x4 X##r0 = *(const LAS f32x4*)((ptr) + 8 * l), X##r1 = *(const LAS f32x4*)((ptr) + 8 * l + 4), X##w0 = *(const LAS f32x4*)((ptr) + 64 + 8 * l), X##w1 = *(const LAS f32x4*)((ptr) + 68 + 8 * l), \
                X##k0 = *(const LAS f32x4*)((ptr) + 128 + 8 * l), X##k1 = *(const LAS f32x4*)((ptr) + 132 + 8 * l), X##n0 = *(const LAS f32x4*)((ptr) + 192 + 8 * l), X##n1 = *(const LAS f32x4*)((ptr) + 196 + 8 * l), \
                X##a0 = *(const LAS f32x4*)((ptr) + 256 + 8 * l), X##a1 = *(const LAS f32x4*)((ptr) + 260 + 8 * l); float X##v = (ptr)[320 + row]
#define RW_LDA(X, ptr) do { X##r0 = *(const LAS f32x4*)((ptr) + 8 * l); X##r1 = *(const LAS f32x4*)((ptr) + 8 * l + 4); X##w0 = *(const LAS f32x4*)((ptr) + 64 + 8 * l); X##w1 = *(const LAS f32x4*)((ptr) + 68 + 8 * l); \
                X##k0 = *(const LAS f32x4*)((ptr) + 128 + 8 * l); X##k1 = *(const LAS f32x4*)((ptr) + 132 + 8 * l); X##n0 = *(const LAS f32x4*)((ptr) + 192 + 8 * l); X##n1 = *(const LAS f32x4*)((ptr) + 196 + 8 * l); \
                X##a0 = *(const LAS f32x4*)((ptr) + 256 + 8 * l); X##a1 = *(const LAS f32x4*)((ptr) + 260 + 8 * l); X##v = (ptr)[320 + row]; } while (0)
#define RW_STEP(X, ssv) do { \
                const f32x2_ nn[4] = {X##n0.xy, X##n0.zw, X##n1.xy, X##n1.zw}, ww[4] = {X##w0.xy, X##w0.zw, X##w1.xy, X##w1.zw}, aa[4] = {X##a0.xy, X##a0.zw, X##a1.xy, X##a1.zw}; \
                const f32x2_ kq[4] = {X##k0.xy, X##k0.zw, X##k1.xy, X##k1.zw}, rr[4] = {X##r0.xy, X##r0.zw, X##r1.xy, X##r1.zw}; \
                const f32x2_ sp2 = (S[0] * nn[0] + S[1] * nn[1]) + (S[2] * nn[2] + S[3] * nn[3]); \
                float sa = sp2.x + sp2.y; sa = allred8(sa); \
                _Pragma("unroll") for (int j = 0; j < 4; ++j) S[j] = S[j] * ww[j] + (aa[j] * sa + kq[j] * X##v); \
                const f32x2_ yp2 = (S[0] * rr[0] + S[1] * rr[1]) + (S[2] * rr[2] + S[3] * rr[3]); \
                float y = yp2.x + yp2.y; y = allred8(y); ycap = (l == (ssv)) ? y : ycap; } while (0)
            RW_LDV(A0_, sp);
            for (int s0 = 0; s0 < nsteps; s0 += 8) {
                float ycap = 0.f;
#define SB_ __builtin_amdgcn_sched_barrier(0);
                { RW_LD(B_, sp + 384); SB_ RW_STEP(A0_, 0); SB_ RW_LD(A_, sp + 768); SB_ RW_STEP(B_, 1); SB_
                  RW_LD(B2_, sp + 1152); SB_ RW_STEP(A_, 2); SB_ RW_LD(A2_, sp + 1536); SB_ RW_STEP(B2_, 3); SB_
                  RW_LD(B3_, sp + 1920); SB_ RW_STEP(A2_, 4); SB_ RW_LD(A3_, sp + 2304); SB_ RW_STEP(B3_, 5); SB_
                  RW_LD(B4_, sp + 2688); SB_ RW_STEP(A3_, 6); SB_ RW_LDA(A0_, sp + 3072); SB_ RW_STEP(B4_, 7); SB_ }
#undef SB_
                sp += 8 * 384;
                yp[(size_t)s0 * 1024] = ycap;
            }
#undef RW_LD
#undef RW_LDV
#undef RW_LDA
#undef RW_STEP
            __syncthreads();
        }
        __builtin_amdgcn_s_setprio(0);
        GAS float* So = p.out + O_RP + ((((size_t)e * NB + b) * 8 + h) * 64 + row) * 64 + 8 * l;
        *(GAS f32x4*)So = (f32x4){S[0].x, S[0].y, S[1].x, S[1].y}; *(GAS f32x4*)(So + 4) = (f32x4){S[2].x, S[2].y, S[3].x, S[3].y};
    }
}

__device__ __forceinline__ unsigned short f2bf_c(float x) { unsigned u = __float_as_uint(x); u += 0x7fffu + ((u >> 16) & 1u); return (unsigned short)(u >> 16); }
__device__ __forceinline__ unsigned pkc(float lo, float hi) { return (unsigned)f2bf_c(lo) | ((unsigned)f2bf_c(hi) << 16); }
template <bool GLA>
__device__ __forceinline__ void gla_mfma_scan(const Ctx& p, int o, int bh, int part, LAS unsigned char* lds) {
    constexpr int DV = GLA ? 256 : 128, LDP = GLA ? OPROJ : EPROJ, QS = 136  , TS = 40  ;
    constexpr int OFF_QD = 0, OFF_KD = 32 * QS * 2, OFF_KDT = 2 * 32 * QS * 2, OFF_VT = OFF_KDT + 128 * TS * 2, OFF_EL = OFF_VT + 32 * TS * 2, STG = OFF_EL + 512;
    constexpr int OFF_SB = 2 * STG, SBB = 8192;
    constexpr float SC = 0.08838834764831845f;
    const int tid = p.tid, lane = tid & 63, w = tid >> 6, b = bh >> 2, h = bh & 3, colbase = part * 32;
    GAS unsigned char* ws = p.ws;
    const GAS bf16_t* proj = (const GAS bf16_t*)(ws + WS_PROJ); GAS float* oraw = (GAS float*)(ws + WS_ORAW);
    const int kk = lane & 15, tq = lane >> 4, k = 16 * w + kk;
    const int vv = tid & 31, sg = tid >> 5;
    const int r16 = lane & 15, quad = lane >> 4;
    f32x4 S0 = {0.f, 0.f, 0.f, 0.f}, S1 = {0.f, 0.f, 0.f, 0.f};
    u32x4 Aq, Ak, At, Bq, Bk, Bt; unsigned Av0, Av1, Bv0, Bv1; float Ael, Bel;
    const GAS bf16_t* QDg = (const GAS bf16_t*)(ws + WS_MIXB); const GAS bf16_t* KDg = QDg + (size_t)MT * 512; const GAS bf16_t* KDTg = (const GAS bf16_t*)(ws + WS_KDT); const GAS float* ELg = (const GAS float*)(ws + WS_ELG);
    const int tr = tid >> 4, c8 = (tid & 15) * 8, kq = tid >> 2, ps = tid & 3;
#define GM_LOAD(X, cc) do { const size_t r0_ = (size_t)b * TP + (size_t)(cc) * 32;   \
        X##q = *(const GAS u32x4*)(QDg + (r0_ + tr) * 512 + h * 128 + c8); X##k = *(const GAS u32x4*)(KDg + (r0_ + tr) * 512 + h * 128 + c8); \
        X##t = *(const GAS u32x4*)(KDTg + ((((size_t)b * 65 + (cc)) * 512 + h * 128 + kq) * 32 + ps * 8)); \
        const GAS bf16_t* pv_ = proj + (r0_ + 2 * sg) * LDP + 1024 + h * DV + colbase + vv; X##v0 = (unsigned)pv_[0]; X##v1 = (unsigned)pv_[LDP]; \
        X##el = ELg[((size_t)b * 65 + (cc)) * 512 + h * 128 + (tid & 127)]; } while (0)
#define GM_STAGE(X, cc) do { LAS unsigned char* sb_ = lds + ((cc) & 1) * STG; const u32x4 z_ = {0u, 0u, 0u, 0u}; \
        const bool okr_ = (cc) * 32 + tr < TP, okt_ = (cc) * 32 + ps * 8 < TP; \
        *(LAS u32x4*)(sb_ + OFF_QD + (tr * QS + c8) * 2) = okr_ ? X##q : z_; *(LAS u32x4*)(sb_ + OFF_KD + (tr * QS + c8) * 2) = okr_ ? X##k : z_; \
        *(LAS u32x4*)(sb_ + OFF_KDT + (kq * TS + ps * 8) * 2) = okt_ ? X##t : z_; \
        const unsigned va_ = ((cc) * 32 + 2 * sg < TP) ? X##v0 : 0u, vb_ = ((cc) * 32 + 2 * sg + 1 < TP) ? X##v1 : 0u; \
        *(LAS unsigned*)(sb_ + OFF_VT + (vv * TS + 2 * sg) * 2) = GLA ? (va_ | (vb_ << 16)) : pk2(siluf_(bflo(va_)), siluf_(bflo(vb_))); \
        if (tid < 128) *(LAS float*)(sb_ + OFF_EL + tid * 4) = X##el; } while (0)
#define MFMA16(a, b, c) __builtin_amdgcn_mfma_f32_16x16x32_bf16((a), (b), (c), 0, 0, 0)
    auto chunk = [&](const int c) {
        LAS unsigned char* sb = lds + (c & 1) * STG; LAS unsigned char* sbS = lds + OFF_SB + (c & 1) * SBB;
        if (w < 4) {
            const int tt = w >> 1, vt = w & 1;
            f32x4 sc0 = {0.f, 0.f, 0.f, 0.f}, sc1 = {0.f, 0.f, 0.f, 0.f};
#pragma unroll
            for (int ks = 0; ks < 4; ++ks) {
                const bf16x8 bq = *(const LAS bf16x8*)(sb + OFF_QD + ((tt * 16 + r16) * QS + ks * 32 + quad * 8) * 2);
                const bf16x8 a0 = *(const LAS bf16x8*)(sb + OFF_KD + ((r16) * QS + ks * 32 + quad * 8) * 2);
                sc0 = MFMA16(a0, bq, sc0);
                if (tt == 1) { const bf16x8 a1 = *(const LAS bf16x8*)(sb + OFF_KD + ((16 + r16) * QS + ks * 32 + quad * 8) * 2); sc1 = MFMA16(a1, bq, sc1); }
            }
            const int s0 = quad * 4;
            f32x4 dg = tt ? sc1 : sc0;
            dg.x = (s0 + 0 <= r16) ? dg.x : 0.f; dg.y = (s0 + 1 <= r16) ? dg.y : 0.f; dg.z = (s0 + 2 <= r16) ? dg.z : 0.f; dg.w = (s0 + 3 <= r16) ? dg.w : 0.f;
            const f32x4 lo = tt ? sc0 : dg, hi = tt ? dg : (f32x4){0.f, 0.f, 0.f, 0.f};
            const u32x4 au = {pkc(lo.x, lo.y), pkc(lo.z, lo.w), pkc(hi.x, hi.y), pkc(hi.z, hi.w)};
            const u32x2 v0 = *(const LAS u32x2*)(sb + OFF_VT + ((vt * 16 + r16) * TS + quad * 4) * 2), v1 = *(const LAS u32x2*)(sb + OFF_VT + ((vt * 16 + r16) * TS + 16 + quad * 4) * 2);
            f32x4 oacc = MFMA16(__builtin_bit_cast(bf16x8, au), __builtin_bit_cast(bf16x8, ((u32x4){v0.x, v0.y, v1.x, v1.y})), ((f32x4){0.f, 0.f, 0.f, 0.f}));
#pragma unroll
            for (int ks = 0; ks < 4; ++ks) {
                const u32x2 q0 = *(const LAS u32x2*)(sb + OFF_QD + ((tt * 16 + r16) * QS + ks * 32 + quad * 4) * 2), q1 = *(const LAS u32x2*)(sb + OFF_QD + ((tt * 16 + r16) * QS + ks * 32 + 16 + quad * 4) * 2);
                const u32x2 t0 = *(const LAS u32x2*)(sbS + ((vt * 8 + 2 * ks) * 64 + lane) * 8), t1 = *(const LAS u32x2*)(sbS + ((vt * 8 + 2 * ks + 1) * 64 + lane) * 8);
                oacc = MFMA16(__builtin_bit_cast(bf16x8, ((u32x4){q0.x, q0.y, q1.x, q1.y})), __builtin_bit_cast(bf16x8, ((u32x4){t0.x, t0.y, t1.x, t1.y})), oacc);
            }
            const float ov[4] = {oacc.x, oacc.y, oacc.z, oacc.w};
#pragma unroll
            for (int j = 0; j < 4; ++j) { const int tok = c * 32 + tt * 16 + quad * 4 + j; if (tok < TP) oraw[((size_t)b * TP + tok) * 1024 + h * DV + colbase + vt * 16 + r16] = ov[j]; }
        }
        {
            const bf16x8 ak = *(const LAS bf16x8*)(sb + OFF_KDT + ((16 * w + r16) * TS + quad * 8) * 2);
            const bf16x8 b0 = *(const LAS bf16x8*)(sb + OFF_VT + ((r16) * TS + quad * 8) * 2), b1 = *(const LAS bf16x8*)(sb + OFF_VT + ((16 + r16) * TS + quad * 8) * 2);
            S0 = MFMA16(ak, b0, S0); S1 = MFMA16(ak, b1, S1);
            const f32x4 el = *(const LAS f32x4*)(sb + OFF_EL + (16 * w + quad * 4) * 4);
            S0 = S0 * el; S1 = S1 * el;
        }
    };
    auto publish = [&](const int c) {
        LAS unsigned char* sbS = lds + OFF_SB + (c & 1) * SBB;
        *(LAS u32x2*)(sbS + ((0 * 8 + w) * 64 + lane) * 8) = (u32x2){pkc(S0.x, S0.y), pkc(S0.z, S0.w)};
        *(LAS u32x2*)(sbS + ((1 * 8 + w) * 64 + lane) * 8) = (u32x2){pkc(S1.x, S1.y), pkc(S1.z, S1.w)};
    };
    __syncthreads();
    GM_LOAD(A, 0); GM_STAGE(A, 0); GM_LOAD(B, 1);
    for (int c = 0; c < NCH; c += 2) {
        publish(c);
        __syncthreads();
        if (c + 2 < NCH) GM_LOAD(A, c + 2);
        chunk(c);
        if (c + 1 < NCH) {
            GM_STAGE(B, c + 1);
            publish(c + 1);
            __syncthreads();
            if (c + 3 < NCH) GM_LOAD(B, c + 3);
            chunk(c + 1);
            if (c + 2 < NCH) GM_STAGE(A, c + 2);
        }
    }
#undef GM_LOAD
#undef GM_STAGE
#undef MFMA16
    GAS float* So = p.out + (GLA ? O_GP : O_HP) + ((((size_t)o * NB + b) * 4 + h) * 128 + 16 * w + quad * 4) * DV + colbase + r16;
    So[0 * DV] = S0.x; So[1 * DV] = S0.y; So[2 * DV] = S0.z; So[3 * DV] = S0.w;
    So[0 * DV + 16] = S1.x; So[1 * DV + 16] = S1.y; So[2 * DV + 16] = S1.z; So[3 * DV + 16] = S1.w;
}

__device__ __forceinline__ void phase_scan_even(const Ctx& p, int e, LAS unsigned char* lds) {
    const int G = p.G;
    const int sfirst = G > 128 ? 128 : 0, sstride = G - sfirst;
    for (int r = 0; r < (((p.probe >> 11) & 1) ? 2 : 1); ++r)
    for (int task = p.bid - sfirst; task >= 0 && task < 512 + 1024; task += sstride) {
        if (task < 512) glalike_sample<false>(p, e, task >> 2, task & 3, lds);
        else rwkv_sample(p, e, (task - 512) >> 3, (task - 512) & 7, lds);
    }
    for (int task = p.bid; task < 256; task += G) {
        if (task < 128) rwkv_prompt_scan(p, e, task >> 1, task & 1, lds);
        else gla_mfma_scan<false>(p, e, (task - 128) >> 2, (task - 128) & 3, lds);
    }
}
__device__ __forceinline__ void phase_scan_odd(const Ctx& p, int o, LAS unsigned char* lds) {
    const int G = p.G;
    for (int r = 0; r < (((p.probe >> 11) & 1) ? 2 : 1); ++r)
    for (int task = p.bid; task < 512; task += G) glalike_sample<true>(p, o, task >> 2, task & 3, lds);
    for (int task = p.bid; task < 256; task += G) gla_mfma_scan<true>(p, o, task >> 3, task & 7, lds);
}

__device__ __forceinline__ void phase_post_even(const Ctx& p, int e) {
    const int tid = p.tid, lane = tid & 63, wave = tid >> 6;
    GAS unsigned char* ws = p.ws;
    const GAS bf16_t* proj = (const GAS bf16_t*)(ws + WS_PROJ); const GAS float* oraw = (const GAS float*)(ws + WS_ORAW); const GAS bf16_t* lraw = (const GAS bf16_t*)(ws + WS_LRAW);
    const GAS float* bsum = (const GAS float*)(ws + WS_BSUM); GAS bf16_t* mixb = (GAS bf16_t*)(ws + WS_MIXB);
    const int c = lane * 8;
    const GAS float* hn = p.in(I_HNORM) + e * 512 + c; const GAS float* lw = p.in(I_LNW) + e * 512 + c; const GAS float* lbi = p.in(I_LNB) + e * 512 + c;
    const GAS float* mu = p.in(I_MU) + (size_t)e * 1792 + 1024 + c;
    for (int m = p.bid * NWAVES + wave; m < MT; m += p.G * NWAVES) {
        {
            const f32x4 o0 = *(const GAS f32x4*)(oraw + (size_t)m * 1024 + c), o1 = *(const GAS f32x4*)(oraw + (size_t)m * 1024 + c + 4);
            const u32x4 gu = *(const GAS u32x4*)(proj + (size_t)m * EPROJ + 1536 + c);
            float z[8] = {o0.x, o0.y, o0.z, o0.w, o1.x, o1.y, o1.z, o1.w};
            const float ga[8] = {bflo(gu.x), bfhi(gu.x), bflo(gu.y), bfhi(gu.y), bflo(gu.z), bfhi(gu.z), bflo(gu.w), bfhi(gu.w)};
            float ss = 0.f;
#pragma unroll
            for (int j = 0; j < 8; ++j) { z[j] *= sigmoidf_(ga[j]); ss += z[j] * z[j]; }
            ss = wave_sum(ss); const float rs = rsqrtf(ss * (1.0f / 512.0f) + 1e-6f);
            u32x4 w; w.x = pk2(z[0] * rs * hn[0], z[1] * rs * hn[1]); w.y = pk2(z[2] * rs * hn[2], z[3] * rs * hn[3]);
            w.z = pk2(z[4] * rs * hn[4], z[5] * rs * hn[5]); w.w = pk2(z[6] * rs * hn[6], z[7] * rs * hn[7]);
            *(GAS u32x4*)(mixb + (size_t)m * 1024 + c) = w;
        }
        {
            const f32x4 y0 = *(const GAS f32x4*)(oraw + (size_t)m * 1024 + 512 + c), y1 = *(const GAS f32x4*)(oraw + (size_t)m * 1024 + 512 + c + 4);
            float y[8] = {y0.x, y0.y, y0.z, y0.w, y1.x, y1.y, y1.z, y1.w};
            float s1 = 0.f;
#pragma unroll
            for (int j = 0; j < 8; ++j) s1 += y[j];
            s1 = allred8(s1); const float mean = s1 * (1.0f / 64.0f);
            float s2 = 0.f;
#pragma unroll
            for (int j = 0; j < 8; ++j) { y[j] -= mean; s2 += y[j] * y[j]; }
            s2 = allred8(s2); const float rs = rsqrtf(s2 * (1.0f / 64.0f) + 64e-5f);
            const u32x4 cu = *(const GAS u32x4*)(proj + (size_t)m * EPROJ + 2048 + 1024 + c);
            const float cur[8] = {bflo(cu.x), bfhi(cu.x), bflo(cu.y), bfhi(cu.y), bflo(cu.z), bfhi(cu.z), bflo(cu.w), bfhi(cu.w)};
            float prv[8];
            if (m >= MP) { const GAS float* s = p.in(I_SS) + ((size_t)e * NS + (m - MP)) * 1792 + 1024 + c; const f32x4 a = *(const GAS f32x4*)s, b = *(const GAS f32x4*)(s + 4);
                prv[0] = a.x; prv[1] = a.y; prv[2] = a.z; prv[3] = a.w; prv[4] = b.x; prv[5] = b.y; prv[6] = b.z; prv[7] = b.w; }
            else if ((m % TP) == 0) {
#pragma unroll
                for (int j = 0; j < 8; ++j) prv[j] = 0.f; }
            else { const u32x4 pu = *(const GAS u32x4*)(proj + (size_t)(m - 1) * EPROJ + 2048 + 1024 + c);
                prv[0] = bflo(pu.x); prv[1] = bfhi(pu.x); prv[2] = bflo(pu.y); prv[3] = bfhi(pu.y); prv[4] = bflo(pu.z); prv[5] = bfhi(pu.z); prv[6] = bflo(pu.w); prv[7] = bfhi(pu.w); }
            const float bonus = bsum[(size_t)m * 8 + (lane >> 3)];
            const u32x4 gg = *(const GAS u32x4*)(lraw + (size_t)m * 1536 + 1024 + c);
            const float g[8] = {bflo(gg.x), bfhi(gg.x), bflo(gg.y), bfhi(gg.y), bflo(gg.z), bfhi(gg.z), bflo(gg.w), bfhi(gg.w)};
            float ob[8];
#pragma unroll
            for (int j = 0; j < 8; ++j) { const float v = cur[j] + (prv[j] - cur[j]) * mu[j]; ob[j] = (y[j] * rs * lw[j] + lbi[j] + bonus * v) * g[j]; }
            u32x4 w; w.x = pk2(ob[0], ob[1]); w.y = pk2(ob[2], ob[3]); w.z = pk2(ob[4], ob[5]); w.w = pk2(ob[6], ob[7]);
            *(GAS u32x4*)(mixb + (size_t)m * 1024 + 512 + c) = w;
        }
    }
}
__device__ __forceinline__ void phase_post_odd(const Ctx& p, int o) {
    const int tid = p.tid, lane = tid & 63, wave = tid >> 6;
    GAS unsigned char* ws = p.ws;
    const GAS bf16_t* proj = (const GAS bf16_t*)(ws + WS_PROJ); const GAS float* oraw = (const GAS float*)(ws + WS_ORAW); GAS bf16_t* mixb = (GAS bf16_t*)(ws + WS_MIXB);
    const f32x4 gn = *(const GAS f32x4*)(p.in(I_GNORM) + o * 256 + 4 * lane);
    for (int m = p.bid * NWAVES + wave; m < MT; m += p.G * NWAVES) {
#pragma unroll
        for (int h = 0; h < 4; ++h) {
            const int c = h * 256 + 4 * lane;
            const f32x4 v = *(const GAS f32x4*)(oraw + (size_t)m * 1024 + c);
            float ss = (v.x * v.x + v.y * v.y) + (v.z * v.z + v.w * v.w); ss = wave_sum(ss);
            const float rs = rsqrtf(ss * (1.0f / 256.0f) + 1e-6f);
            const u32x2 gu = *(const GAS u32x2*)(proj + (size_t)m * OPROJ + 2048 + c);
            u32x2 w; w.x = pk2(v.x * rs * gn.x * siluf_(bflo(gu.x)), v.y * rs * gn.y * siluf_(bfhi(gu.x)));
            w.y = pk2(v.z * rs * gn.z * siluf_(bflo(gu.y)), v.w * rs * gn.w * siluf_(bfhi(gu.y)));
            *(GAS u32x2*)(mixb + (size_t)m * 1024 + c) = w;
        }
    }
}
__device__ __forceinline__ void phase_fix(const Ctx& p, int arg_, int rep_) {
    int sel = arg_ * 2 + (rep_ ? 1 : 0); asm volatile("" : "+s"(sel));
    const int nk = (sel & 2) ? 4 : 11; const float scale = (sel & 1) ? 0.f : ((sel & 2) ? 1.0f : 0.5f);
    const int tid = p.tid, lane = tid & 63, wave = tid >> 6;
    GAS float* xf = (GAS float*)(p.ws + WS_XF); GAS bf16_t* xb = (GAS bf16_t*)(p.ws + WS_XB); GAS float* ssq = (GAS float*)(p.ws + WS_SSQ);
    const GAS float* part = (const GAS float*)(p.ws + WS_PART);
    for (int r = p.bid * NWAVES + wave; r < 256; r += p.G * NWAVES) {
        const int m = MT - 256 + r; float ss = 0.f;
#pragma unroll
        for (int j = 0; j < 4; ++j) {
            const int c = 4 * lane + 256 * j;
            f32x4 a = {0.f, 0.f, 0.f, 0.f};
            for (int k = 0; k < nk; ++k) a = a + *(const GAS f32x4*)(part + ((size_t)k * 256 + r) * 1024 + c);
            f32x4 x = *(const GAS f32x4*)(xf + (size_t)m * D + c); x = x + a * scale;
            *(GAS f32x4*)(xf + (size_t)m * D + c) = x;
            u32x2 w; w.x = pk2(x.x, x.y); w.y = pk2(x.z, x.w); *(GAS u32x2*)(xb + (size_t)m * D + c) = w;
            ss += (x.x * x.x + x.y * x.y) + (x.z * x.z + x.w * x.w);
        }
        ss = wave_sum(ss);
        if (lane < 16) ssq[(size_t)m * 16 + lane] = lane == 0 ? ss : 0.f;
        if (lane == 0) ((GAS float*)(p.ws + WS_RSTD))[m] = rsqrtf(ss * (1.0f / 1024.0f) + 1e-6f);
    }
    for (int m = p.bid * NTHREADS + tid; m < MT - 256; m += p.G * NTHREADS) ((GAS float*)(p.ws + WS_RSTD))[m] = rstd_of(ssq, m);
}
__device__ __forceinline__ void phase_final(const Ctx& p) {
    const int tid = p.tid, lane = tid & 63, wave = tid >> 6;
    const GAS bf16_t* xb = (const GAS bf16_t*)(p.ws + WS_XB); const GAS float* ssq = (const GAS float*)(p.ws + WS_SSQ);
    for (int m = p.bid * NWAVES + wave; m < MT; m += p.G * NWAVES) {
        GAS float* dst;
        if (m < MP) { const int b = m / TP, t = m % TP; if (t < 16) continue; dst = p.out + O_YP + ((size_t)b * 2048 + (t - 16)) * D; }
        else dst = p.out + O_YS + (size_t)(m - MP) * D;
        const float rs = rstd_of(ssq, m);
#pragma unroll
        for (int j = 0; j < 4; ++j) {
            const int c = 4 * lane + 256 * j; const u32x2 xo = *(const GAS u32x2*)(xb + (size_t)m * D + c); const f32x4 x = {bflo(xo.x), bfhi(xo.x), bflo(xo.y), bfhi(xo.y)}, g = *(const GAS f32x4*)(p.in(I_FNORM) + c);
            __builtin_nontemporal_store(x * rs * g, (GAS f32x4*)(dst + c));
        }
    }
}

#define XB_TMO      128
#define XB_XCNT(j)  (256  + 64 * (j))
#define XB_XSUB(j)  (1280 + 64 * (j))
#define XB_XGEN(j)  (2304 + 64 * (j))
#define XB_TOP      3328
#define XB_TOPGEN   3392
#define XCD_BAR_WORDS 3456
#define XB_SPIN_CAP (1u << 22)
__device__ __forceinline__ unsigned xb_ld(unsigned* p)              { return __hip_atomic_load(p, __ATOMIC_RELAXED, __HIP_MEMORY_SCOPE_AGENT); }
__device__ __forceinline__ unsigned xb_add(unsigned* p, unsigned v) { return __hip_atomic_fetch_add(p, v, __ATOMIC_RELAXED, __HIP_MEMORY_SCOPE_AGENT); }
__device__ __forceinline__ unsigned xb_xcc_id() { return (unsigned)__builtin_amdgcn_s_getreg((3 << 11) | 20) & 0xFu; }
#define XB_SPIN(cond, bar) do { unsigned _sp = 0; while (cond) { __builtin_amdgcn_s_sleep(1); \
    if ((++_sp & 255u) == 0u) { if (xb_ld(&(bar)[XB_TMO])) break; if (_sp > XB_SPIN_CAP) { atomicAdd(&(bar)[XB_TMO], 1u); break; } } } } while (0)
struct XcdBarrier { unsigned* bar; unsigned x; volatile LAS unsigned* st; };
__device__ __forceinline__ void xcd_barrier_complete(unsigned* bar, unsigned x, unsigned G, unsigned& nloc, unsigned& nx) {
    unsigned sum, cnt, mine, sp = 0u;
    for (;;) {
        sum = 0u; cnt = 0u; mine = 0u;
#pragma unroll
        for (unsigned j = 0; j < 16; ++j) { const unsigned c = xb_ld(&bar[XB_XCNT(j)]); sum += c; cnt += (c > 0u) ? 1u : 0u; mine = (j == x) ? c : mine; }
        if (sum == G) break;
        __builtin_amdgcn_s_sleep(1);
        if ((++sp & 255u) == 0u) { if (xb_ld(&bar[XB_TMO])) break; if (sp > XB_SPIN_CAP) { atomicAdd(&bar[XB_TMO], 1u); break; } }
    }
    nloc = mine > 0u ? mine : 1u; nx = cnt > 0u ? cnt : 1u;
}
__device__ __forceinline__ void xcd_barrier(const XcdBarrier& b, int tid, unsigned G) {
    asm volatile("s_waitcnt vmcnt(0)" ::: "memory");
    __syncthreads();
    if (tid == 0) {
        unsigned* bar = b.bar;
        __builtin_amdgcn_s_waitcnt(0);
        unsigned nloc = b.st[0], nx = b.st[1];
        if (nloc == 0u) { xcd_barrier_complete(bar, b.x, G, nloc, nx); b.st[0] = nloc; b.st[1] = nx; }
        const unsigned old = xb_add(&bar[XB_XSUB(b.x)], 1u);
        const unsigned gen = old / nloc;
        if (old + 1u == (gen + 1u) * nloc) {
            __builtin_amdgcn_fence(__ATOMIC_RELEASE, "agent");
            asm volatile("s_waitcnt vmcnt(0)" ::: "memory");
            const unsigned og = xb_add(&bar[XB_TOP], 1u);
            const unsigned tg = og / nx;
            if (og + 1u == (tg + 1u) * nx) xb_add(&bar[XB_TOPGEN], 1u);
            else XB_SPIN(xb_ld(&bar[XB_TOPGEN]) == tg, bar);
            __builtin_amdgcn_fence(__ATOMIC_ACQUIRE, "agent");
            xb_add(&bar[XB_XGEN(b.x)], 1u);
            asm volatile("s_waitcnt vmcnt(0)" ::: "memory");
        } else {
            XB_SPIN(xb_ld(&bar[XB_XGEN(b.x)]) == gen, bar);
            __builtin_amdgcn_fence(__ATOMIC_ACQUIRE, "agent");
            asm volatile("s_waitcnt vmcnt(0)" ::: "memory");
        }
    }
    __syncthreads();
}

#define TAILCNT(ph, pn) (3520 + (ph) * 4 + (pn))
__device__ __forceinline__ void tail_fixup(const Ctx& p, int ph, int nk, float scale) {
    const int tid = p.tid, lane = tid & 63, wave = tid >> 6, nmain = 64 * 4, ntail = 4 * nk;
    unsigned* bar = (unsigned*)(unsigned char*)(p.ws + WS_BAR);
    GAS float* xf = (GAS float*)(p.ws + WS_XF); GAS bf16_t* xb = (GAS bf16_t*)(p.ws + WS_XB); GAS float* ssq = (GAS float*)(p.ws + WS_SSQ);
    const GAS float* part = (const GAS float*)(p.ws + WS_PART);
    for (int L = p.bid; L < nmain + ntail; L += p.G) {
        if (L < nmain) continue;
        const int j = L - nmain, pn = j % 4, kc = j / 4;
        asm volatile("s_waitcnt vmcnt(0)" ::: "memory");
        __syncthreads();
        if (tid == 0) {
            __builtin_amdgcn_fence(__ATOMIC_RELEASE, "agent");
            asm volatile("s_waitcnt vmcnt(0)" ::: "memory");
            (void)xb_add(&bar[TAILCNT(ph, pn)], 1u);
            XB_SPIN(xb_ld(&bar[TAILCNT(ph, pn)]) < (unsigned)nk, bar);
            __builtin_amdgcn_fence(__ATOMIC_ACQUIRE, "agent");
            asm volatile("s_waitcnt vmcnt(0)" ::: "memory");
        }
        __syncthreads();
        const int r_lo = (kc * 256) / nk, r_hi = ((kc + 1) * 256) / nk, c4 = pn * 256 + 4 * lane;
        for (int r = r_lo + wave; r < r_hi; r += NWAVES) {
            const int m = MT - 256 + r;
            f32x4 sl[11];
#pragma unroll
            for (int k = 0; k < 11; ++k) sl[k] = (k < nk) ? *(const GAS f32x4*)(part + ((size_t)k * 256 + r) * 1024 + c4) : (f32x4){0.f, 0.f, 0.f, 0.f};
            f32x4 a = sl[0];
#pragma unroll
            for (int k = 1; k < 11; ++k) a = a + sl[k];
            const u32x2 xo = *(const GAS u32x2*)(xb + (size_t)m * D + c4); f32x4 x = {bflo(xo.x), bfhi(xo.x), bflo(xo.y), bfhi(xo.y)}; x = x + a * scale;
            u32x2 w; w.x = pk2(x.x, x.y); w.y = pk2(x.z, x.w); *(GAS u32x2*)(xb + (size_t)m * D + c4) = w;
            float ss = (x.x * x.x + x.y * x.y) + (x.z * x.z + x.w * x.w); ss = wave_sum(ss);
            if (lane < 4) ssq[(size_t)m * 16 + pn * 4 + lane] = lane == 0 ? ss : 0.f;
        }
    }
}

__global__ void __launch_bounds__(NTHREADS, 2) mega_fwd(Params pp) {
    extern __shared__ __attribute__((aligned(16))) unsigned char shm[];
    LAS unsigned char* lds = (LAS unsigned char*)shm;
    cg::grid_group grid = cg::this_grid();
    if (threadIdx.x < N_IN) {
        const unsigned long long v = (unsigned long long)pp.in[threadIdx.x];
        LAS unsigned* t = (LAS unsigned*)(lds + TAB_OFF) + 2 * threadIdx.x; t[0] = (unsigned)v; t[1] = (unsigned)(v >> 32);
    }
    #define MK_GBAR() XcdBarrier gbar; gbar.bar = (unsigned*)(pp.ws + WS_BAR); gbar.x = xb_xcc_id(); gbar.st = (volatile LAS unsigned*)(lds + TAB_OFF + 320)
    if (threadIdx.x == 0) { MK_GBAR(); gbar.st[0] = 0u; gbar.st[1] = 0u; (void)xb_add(&gbar.bar[XB_XCNT(gbar.x)], 1u); }
    __syncthreads();
    const int wave_s = __builtin_amdgcn_readfirstlane((int)(threadIdx.x >> 6));
    for (int ph = pp.ph_lo; ph < pp.ph_hi; ++ph) {
        const int kind = PROG[ph][0], arg = PROG[ph][1];
        const int nrep = (((pp.probe_mask >> kind) & 1) || (kind == K_SCAN && (arg & 1) && ((pp.probe_mask >> 12) & 1))) ? 2 : 1;
        for (int rep = 0; rep < nrep; ++rep) {
        int lane_l; asm volatile("v_mbcnt_lo_u32_b32 %0, -1, 0\n\tv_mbcnt_hi_u32_b32 %0, -1, %0" : "=v"(lane_l));
        int tid = wave_s * 64 + lane_l, bid = blockIdx.x; unsigned char* ws_ = pp.ws; float* outp_ = pp.out; LAS unsigned char* ldsl = lds;
        asm volatile("" : "+v"(tid)); asm volatile("" : "+s"(bid)); asm volatile("" : "+s"(ws_)); asm volatile("" : "+s"(outp_)); asm volatile("" : "+s"(ldsl));
        GAS unsigned char* ws = (GAS unsigned char*)ws_; GAS float* outp = (GAS float*)outp_;
        Ctx p; p.lds = ldsl; p.out = outp; p.ws = ws; p.tid = tid; p.bid = bid; p.G = gridDim.x; p.probe = pp.probe_mask;
        if (rep) { MK_GBAR(); xcd_barrier(gbar, tid, (unsigned)gridDim.x); }
        GAS bf16_t* xb = (GAS bf16_t*)(ws + WS_XB); GAS float* xf = (GAS float*)(ws + WS_XF); GAS float* ssq = (GAS float*)(ws + WS_SSQ);
        GAS bf16_t* projb = (GAS bf16_t*)(ws + WS_PROJ);
        if (kind == K_P0) phase_p0(p, ldsl);
        else if (kind == K_GU || kind == K_DN || kind == K_OUT || kind == K_IN || kind == K_LORA) {
            pg8::Gemm g; Epi E; E.ws = ws; E.scale = 1.0f; E.ldo = 0;
            if (kind == K_GU) { g = pg8::Gemm{xb, (const GAS bf16_t*)(ws + WS_WGU) + (size_t)arg * 5632 * 1024, MT, 5632, 1024}; E.mode = 0; }
            else if (kind == K_DN) { g = pg8::Gemm{projb, (const GAS bf16_t*)(ws + WS_WD) + (size_t)arg * 1024 * FF, MT, 1024, FF}; E.mode = 1; E.scale = rep ? 0.f : 0.5f; }
            else if (kind == K_OUT) { g = pg8::Gemm{(const GAS bf16_t*)(ws + WS_MIXB), (const GAS bf16_t*)(ws + WS_WOUT) + (size_t)arg * D * D, MT, 1024, 1024}; E.mode = 1; E.scale = rep ? 0.f : 1.0f; }
            else if (kind == K_IN) { const int odd = arg & 1, idx = arg >> 1;
                g = pg8::Gemm{xb, odd ? (const GAS bf16_t*)(ws + WS_WINO) + (size_t)idx * OPROJ * 1024 : (const GAS bf16_t*)(ws + WS_WINE) + (size_t)idx * EPROJ * 1024, MT, odd ? OPROJ : EPROJ, 1024};
                E.mode = 2; E.ldo = odd ? OPROJ : EPROJ; }
            else { g = pg8::Gemm{(const GAS bf16_t*)(ws + WS_LIN), (const GAS bf16_t*)(ws + WS_WLORA) + (size_t)(arg >> 1) * 1536 * 256, MT, 1536, 256}; E.mode = 3; E.ldo = 1536; }
            pg8::StaticOrder S; S.init(g.M, g.N, g.K, p.G, bid, E.mode == 1);
            pg8::gemm_phase(ldsl, g, S, E, tid);
            if (E.mode == 1) tail_fixup(p, ph, g.K / 256, E.scale);
        } else if (kind == K_LIN) { phase_fprep(p, arg & 1, arg >> 1); if (!(arg & 1)) phase_lin(p, arg >> 1); }
        else if (kind == K_SCAN) { if (arg & 1) phase_scan_odd(p, arg >> 1, ldsl); else phase_scan_even(p, arg >> 1, ldsl); }
        else if (kind == K_FIX) phase_fix(p, arg, rep);
        else if (kind == K_POST) { if (arg & 1) phase_post_odd(p, arg >> 1); else phase_post_even(p, arg >> 1); }
        else phase_final(p);
        }
        if (ph + 1 < pp.ph_hi) { if (pp.ph_lo < 0) grid.sync();   else { MK_GBAR(); int lane_b; asm volatile("v_mbcnt_lo_u32_b32 %0, -1, 0\n\tv_mbcnt_hi_u32_b32 %0, -1, %0" : "=v"(lane_b)); xcd_barrier(gbar, wave_s * 64 + lane_b, (unsigned)gridDim.x); } }
    }
}

extern "C" void kernel_launch(void* const* d_in, const int* in_sizes, int n_in, void* d_out, int out_size, void* d_ws, size_t ws_size, hipStream_t stream) {
    static int grid_blocks = 0;
    if (grid_blocks == 0) {
        if (n_in != N_IN || (size_t)out_size != O_END || ws_size < WS_END) {
            fprintf(stderr, "kernel_launch: unexpected shapes: n_in %d out %d ws %zu (need %zu)\n", n_in, out_size, ws_size, (size_t)WS_END);
            grid_blocks = -1; return;
        }
        int dev = 0, cus = 0, per_cu = 0;
        hipGetDevice(&dev);
        hipDeviceGetAttribute(&cus, hipDeviceAttributeMultiprocessorCount, dev);
        if (hipFuncSetAttribute((const void*)mega_fwd, hipFuncAttributeMaxDynamicSharedMemorySize, LDS_BYTES) != hipSuccess) fprintf(stderr, "kernel_launch: hipFuncSetAttribute failed\n");
        hipOccupancyMaxActiveBlocksPerMultiprocessor(&per_cu, (const void*)mega_fwd, NTHREADS, LDS_BYTES);
        (void)hipGetLastError();
        if (per_cu < 1) fprintf(stderr, "kernel_launch: occupancy query reports %d blocks per CU\n", per_cu);
        grid_blocks = cus > 0 ? cus : 256;
    }
    if (grid_blocks < 0) return;
    if (hipMemsetAsync((char*)d_ws + WS_BAR, 0, 16384, stream) != hipSuccess) { fprintf(stderr, "kernel_launch: memset failed\n"); return; }
    Params p{};
    for (int i = 0; i < N_IN; ++i) p.in[i] = (const float*)d_in[i];
    p.out = (float*)d_out; p.ws = (unsigned char*)d_ws; p.ph_lo = 0; p.ph_hi = NPHASES; p.probe_mask = PROBE_MASK;
    void* args[] = {&p};
    hipError_t e = hipLaunchCooperativeKernel((const void*)mega_fwd, dim3(grid_blocks), dim3(NTHREADS), args, LDS_BYTES, stream);
    if (e != hipSuccess) fprintf(stderr, "cooperative launch failed: %s (grid %d)\n", hipGetErrorString(e), grid_blocks);
}
```

```cpp
#include <hip/hip_runtime.h>
#include <hip/hip_cooperative_groups.h>
#include <cstdio>
#include <cstdint>
namespace cg = cooperative_groups;

#define LAS __attribute__((address_space(3)))
#define GAS __attribute__((address_space(1)))
typedef unsigned short bf16_t;
typedef short bf16x8 __attribute__((ext_vector_type(8)));
typedef float f32x4 __attribute__((ext_vector_type(4)));
typedef unsigned u32x4 __attribute__((ext_vector_type(4)));
typedef unsigned u32x2 __attribute__((ext_vector_type(2)));
typedef float f32x2_ __attribute__((ext_vector_type(2)));

constexpr int D = 1024, FF = 2816, TP = 2064, NB = 8, NS = 128, MP = NB * TP  , MT = MP + NS  ;
constexpr int EPROJ = 3840, OPROJ = 3328  , OSRC = 3088;
constexpr int NTHREADS = 512, NWAVES = 8;
#define PROBE_MASK 0
constexpr int LDS_BYTES = 131072 + 512;
constexpr int TAB_OFF = 131072;

enum { I_XP = 0, I_XS, I_SH, I_SR, I_SS, I_SG, I_META, I_NF1, I_F1G, I_F1U, I_F1D, I_NMIX, I_EWIN, I_LB, I_HNORM, I_MU, I_W0, I_W2, I_A0, I_A2, I_G2,
       I_KK, I_KA, I_RK, I_LNW, I_LNB, I_EWOUT, I_OWIN, I_GUP, I_GB, I_GNORM, I_OWOUT, I_NF2, I_F2G, I_F2U, I_F2D, I_FNORM, N_IN };

constexpr size_t O_YP = 0, O_YS = 16777216, O_HP = O_YS + 131072, O_RP = O_HP + 1048576, O_SP = O_RP + 524288, O_GP = O_SP + 28672,
                 O_HS = O_GP + 2097152, O_RS = O_HS + 16777216, O_SSH = O_RS + 8388608, O_GS = O_SSH + 458752, O_END = O_GS + 33554432;

constexpr size_t WS_BAR = 0;
constexpr size_t WS_WGU = 16384;
constexpr size_t WS_WD = WS_WGU + (size_t)8 * 5632 * 1024 * 2;
constexpr size_t WS_WINE = WS_WD + (size_t)8 * 1024 * 2816 * 2;
constexpr size_t WS_WINO = WS_WINE + (size_t)2 * EPROJ * 1024 * 2;
constexpr size_t WS_WOUT = WS_WINO + (size_t)2 * OPROJ * 1024 * 2;
constexpr size_t WS_WLORA = WS_WOUT + (size_t)4 * 1024 * 1024 * 2;
constexpr size_t WS_XF = WS_WLORA + (size_t)2 * 1536 * 256 * 2;
constexpr size_t WS_XB = WS_XF + (size_t)MT * 1024 * 4;
constexpr size_t WS_SSQ = WS_XB + (size_t)MT * 1024 * 2;
constexpr size_t WS_PROJ = WS_SSQ + (size_t)MT * 16 * 4;
constexpr size_t WS_LIN = WS_PROJ + (size_t)MT * EPROJ * 2;
constexpr size_t WS_LRAW = WS_LIN + (size_t)MT * 256 * 2;
constexpr size_t WS_ORAW = WS_LRAW + (size_t)MT * 1536 * 2;
constexpr size_t WS_BSUM = WS_ORAW + (size_t)MT * 1024 * 4;
constexpr size_t WS_MIXB = WS_BSUM + (size_t)MT * 8 * 4;
constexpr size_t WS_PART = WS_MIXB + (size_t)MT * 1024 * 2;
constexpr size_t WS_RSTD = WS_PART + (size_t)11 * 256 * 1024 * 4;
constexpr size_t WS_KDT = WS_RSTD + (size_t)MT * 4;
constexpr size_t WS_ELG = WS_KDT + (size_t)8 * 65 * 512 * 32 * 2;
constexpr size_t WS_END = WS_ELG + (size_t)8 * 65 * 512 * 4;

struct Params { const float* in[N_IN]; float* out; unsigned char* ws; int ph_lo, ph_hi, probe_mask, pad_; };
struct Ctx {
    LAS unsigned char* lds; GAS float* out; GAS unsigned char* ws; int tid, bid, G, probe;
    __device__ __forceinline__ const GAS float* in(int i) const {
        const LAS unsigned* t = (const LAS unsigned*)(lds + TAB_OFF) + 2 * i;
        const unsigned lo = __builtin_amdgcn_readfirstlane(t[0]), hi = __builtin_amdgcn_readfirstlane(t[1]);
        return (const GAS float*)(((unsigned long long)hi << 32) | lo);
    }
};

enum { K_P0 = 0, K_GU, K_DN, K_IN, K_LIN, K_LORA, K_SCAN, K_POST, K_OUT, K_FINAL, K_FIX };
constexpr int NPHASES = 40;
__constant__ unsigned char PROG[NPHASES][2] = {
    {K_P0, 0},
    {K_GU, 0}, {K_DN, 0}, {K_IN, 0}, {K_LIN, 0}, {K_LORA, 0}, {K_SCAN, 0}, {K_POST, 0}, {K_OUT, 0}, {K_GU, 1}, {K_DN, 1},
    {K_GU, 2}, {K_DN, 2}, {K_IN, 1}, {K_LIN, 1}, {K_SCAN, 1}, {K_POST, 1}, {K_OUT, 1}, {K_GU, 3}, {K_DN, 3},
    {K_GU, 4}, {K_DN, 4}, {K_IN, 2}, {K_LIN, 2}, {K_LORA, 2}, {K_SCAN, 2}, {K_POST, 2}, {K_OUT, 2}, {K_GU, 5}, {K_DN, 5},
    {K_GU, 6}, {K_DN, 6}, {K_IN, 3}, {K_LIN, 3}, {K_SCAN, 3}, {K_POST, 3}, {K_OUT, 3}, {K_GU, 7}, {K_DN, 7},
    {K_FINAL, 0}};

__device__ __forceinline__ float bf2f(unsigned short b) { return __uint_as_float(((unsigned)b) << 16); }
__device__ __forceinline__ float bflo(unsigned u) { return __uint_as_float(u << 16); }
__device__ __forceinline__ float bfhi(unsigned u) { return __uint_as_float(u & 0xffff0000u); }
__device__ __forceinline__ unsigned pk2(float lo, float hi) { unsigned r; asm volatile("v_cvt_pk_bf16_f32 %0, %1, %2" : "=v"(r) : "v"(lo), "v"(hi)); return r; }
__device__ __forceinline__ float sigmoidf_(float x) { return __builtin_amdgcn_rcpf(1.0f + __expf(-x)); }
__device__ __forceinline__ float siluf_(float x) { return x * __builtin_amdgcn_rcpf(1.0f + __expf(-x)); }
__device__ __forceinline__ float wave_sum(float v) {
#pragma unroll
    for (int o = 1; o < 64; o <<= 1) v += __shfl_xor(v, o);
    return v;
}
template <int CTRL> __device__ __forceinline__ float dppf(float v) { return __int_as_float(__builtin_amdgcn_update_dpp(0, __float_as_int(v), CTRL, 0xF, 0xF, true)); }
__device__ __forceinline__ float allred8(float v) { v += dppf<0xB1>(v); v += dppf<0x4E>(v); v += dppf<0x141>(v); return v; }
__device__ __forceinline__ float allred16(float v) { v = allred8(v); v += dppf<0x140>(v); return v; }
#define LDS_WAIT() asm volatile("s_waitcnt lgkmcnt(0)" ::: "memory")
__device__ __forceinline__ float amul(float a, float b) { float r; asm("v_mul_f32 %0, %1, %2" : "=v"(r) : "v"(a), "v"(b)); return r; }
__device__ __forceinline__ float afma(float a, float b, float c) { float r; asm("v_fma_f32 %0, %1, %2, %3" : "=v"(r) : "v"(a), "v"(b), "v"(c)); return r; }

__device__ __forceinline__ float rstd_of(const GAS float* ssq, int row) {
    const GAS f32x4* p = (const GAS f32x4*)(ssq + (size_t)row * 16);
    const f32x4 a = p[0], b = p[1], c = p[2], d = p[3];
    const float s = ((a.x + a.y) + (a.z + a.w)) + ((b.x + b.y) + (b.z + b.w)) + ((c.x + c.y) + (c.z + c.w)) + ((d.x + d.y) + (d.z + d.w));
    return rsqrtf(s * (1.0f / 1024.0f) + 1e-6f);
}

namespace pg8 {
constexpr int BM = 256, BK = 64, HALF = 128, HTB = HALF * BK * 2, NXCD = 8, WGM = 8;
__device__ __forceinline__ int lds_byte(int r, int c) { const int st = (r >> 4) * 2 + (c >> 5), rr = r & 15, cc = c & 31, ob = rr * 64 + cc * 2; return st * 1024 + (ob ^ (((ob >> 9) & 1) << 5)); }
__device__ __forceinline__ void stage_rc(int b, int& R, int& C) { const int st = b / 1024, sb = b % 1024, swz = sb ^ (((sb >> 9) & 1) << 5); R = (st >> 1) * 16 + swz / 64; C = (st & 1) * 32 + (swz % 64) / 2; }
struct Unit { int pm, pn, k0, nt, kc; };
struct Gemm { const GAS bf16_t* A; const GAS bf16_t* Bt; int M, N, K; };
struct StaticOrder {
    int nM, nN, nwg, G, c, ntK, ntail, split;
    __device__ __forceinline__ void init(int M, int N, int K, int G_, int c_, int tail) { nM = M / BM - 1; nN = N / BM; nwg = nM * nN; G = G_; c = c_; ntK = K / BK; split = tail; ntail = tail ? nN * (K / 256) : nN; }
    __device__ __forceinline__ bool next(int i, Unit& u) const {
        const long L = (long)i * G + c; if (L >= nwg + ntail) return false;
        const bool tl = L >= nwg; const int j = tl ? (int)L - nwg : 0;
        int wgid = tl ? 0 : (int)L; { const int q = nwg / NXCD, r = nwg % NXCD, xcd = wgid % NXCD, off = wgid / NXCD; wgid = (xcd < r ? xcd * (q + 1) : r * (q + 1) + (xcd - r) * q) + off; }
        const int nig = WGM * nN, gid = wgid / nig, fm = gid * WGM, gsz = (nM - fm) < WGM ? (nM - fm) : WGM;
        const int pm_ = fm + ((wgid % nig) % gsz), pn_ = (wgid % nig) / gsz, kc_ = j / nN; const bool sk = tl && split;
        u.pm = tl ? nM : pm_; u.pn = tl ? j % nN : pn_; u.k0 = sk ? kc_ * 256 : 0; u.nt = sk ? 4 : ntK; u.kc = sk ? kc_ : -1;
        return true;
    }
};

template <class Epi>
__device__ __forceinline__ void gemm_phase(LAS unsigned char* lds, const Gemm g, const StaticOrder& S, const Epi& E, const int tid) {
    const int wid = __builtin_amdgcn_readfirstlane(tid >> 6), lane = tid & 63, wr = wid >> 2, wc = wid & 3, fr = lane & 15, fq = lane >> 4;
    const int K = g.K;
    unsigned voffA[2];
#pragma unroll
    for (int i = 0; i < 2; ++i) { int R, C; stage_rc(tid * 16 + i * 8192, R, C); voffA[i] = (unsigned)(R * K + C) * 2u; }
    const size_t kstep = (size_t)(BK * 2);
    const size_t hstep = (size_t)HALF * K * 2;
    const size_t tstep = 2 * hstep;
    const unsigned ldsw = (unsigned)wid * 1024u;
    const int aoff = lds_byte(wr * 64 + fr, fq * 8), boff = lds_byte(wc * 32 + fr, fq * 8);
#define PG8_SA(b, h) (((b) * 2 + (h)) * HTB)
#define PG8_SB(b, h) ((4 + (b) * 2 + (h)) * HTB)
#define PG8_STAGE(bufoff, gbase, voff) do { _Pragma("unroll") for (int _i = 0; _i < 2; ++_i) \
        __builtin_amdgcn_global_load_lds((const unsigned*)((const char*)(gbase) + (voff)[_i]), (LAS unsigned*)(lds + (bufoff) + ldsw + _i * 8192), 16, 0, 0); } while (0)
#define PG8_LDA(dst, b, h) do { _Pragma("unroll") for (int m = 0; m < 4; ++m) _Pragma("unroll") for (int k = 0; k < 2; ++k) dst[m][k] = *(const LAS bf16x8*)(lds + PG8_SA(b, h) + aoff + m * 2048 + k * 1024); } while (0)
#define PG8_LDB(dst, b, h) do { _Pragma("unroll") for (int n = 0; n < 2; ++n) _Pragma("unroll") for (int k = 0; k < 2; ++k) dst[n][k] = *(const LAS bf16x8*)(lds + PG8_SB(b, h) + boff + n * 2048 + k * 1024); } while (0)
#define PG8_MMA(ai, bj, At, Bt) do { __builtin_amdgcn_s_setprio(1); _Pragma("unroll") for (int m = 0; m < 4; ++m) _Pragma("unroll") for (int n = 0; n < 2; ++n) _Pragma("unroll") for (int k = 0; k < 2; ++k) \
        acc[ai][bj][m][n] = __builtin_amdgcn_mfma_f32_16x16x32_bf16(Bt[n][k], At[m][k], acc[ai][bj][m][n], 0, 0, 0); __builtin_amdgcn_s_setprio(0); } while (0)
#define PG8_WAIT_V(n) asm volatile("s_waitcnt vmcnt(" #n ")" ::: "memory")
#define PG8_WAIT_L(n) asm volatile("s_waitcnt lgkmcnt(" #n ")" ::: "memory")
#define PG8_BAR __builtin_amdgcn_s_barrier()
#define PG8_SCHED __builtin_amdgcn_sched_barrier(0)
    Unit cur, nxt; int ui = 0;
    if (!S.next(0, cur)) return;
    f32x4 acc[2][2][4][2];
#pragma unroll
    for (int a = 0; a < 2; ++a)
#pragma unroll
        for (int b = 0; b < 2; ++b)
#pragma unroll
            for (int m = 0; m < 4; ++m)
#pragma unroll
                for (int n = 0; n < 2; ++n) acc[a][b][m][n] = (f32x4){0.f, 0.f, 0.f, 0.f};
    bf16x8 At[4][2], B0[2][2], B1[2][2];
    const char* cA = (const char*)g.A + (size_t)cur.pm * tstep + (size_t)cur.k0 * 2; const char* cB = (const char*)g.Bt + (size_t)cur.pn * tstep + (size_t)cur.k0 * 2;
    PG8_STAGE(PG8_SB(0, 0), cB, voffA); PG8_STAGE(PG8_SA(0, 0), cA, voffA); PG8_STAGE(PG8_SB(0, 1), cB + hstep, voffA); PG8_STAGE(PG8_SA(0, 1), cA + hstep, voffA);
    if (wr == 1) PG8_BAR;
    PG8_WAIT_V(4); PG8_BAR;
    PG8_STAGE(PG8_SB(1, 0), cB + kstep, voffA); PG8_STAGE(PG8_SA(1, 0), cA + kstep, voffA); PG8_STAGE(PG8_SB(1, 1), cB + hstep + kstep, voffA);
    PG8_WAIT_V(6); PG8_BAR;
    for (;;) {
        const bool has_next = S.next(ui + 1, nxt);
        const char* nA = has_next ? (const char*)g.A + (size_t)nxt.pm * tstep + (size_t)nxt.k0 * 2 : cA; const char* nB = has_next ? (const char*)g.Bt + (size_t)nxt.pn * tstep + (size_t)nxt.k0 * 2 : cB;
        const int nt = cur.nt;
        for (int t = 0; t < nt; t += 2) {
            const bool last = (t == nt - 2);
            const char* a1 = cA + (size_t)(t + 1) * kstep;
            const char* a2 = last ? nA : cA + (size_t)(t + 2) * kstep; const char* b2 = last ? nB : cB + (size_t)(t + 2) * kstep;
            const char* a3 = a2 + kstep; const char* b3 = b2 + kstep;
            PG8_LDB(B0, 0, 0); PG8_SCHED; PG8_LDA(At, 0, 0); PG8_STAGE(PG8_SA(1, 1), a1 + hstep, voffA);
            PG8_WAIT_L(8); PG8_BAR; PG8_WAIT_L(0); PG8_MMA(0, 0, At, B0); PG8_BAR; PG8_SCHED;
            PG8_LDB(B1, 0, 1); PG8_STAGE(PG8_SB(0, 0), b2, voffA);
            PG8_BAR; PG8_WAIT_L(0); PG8_MMA(0, 1, At, B1); PG8_BAR;
            PG8_LDA(At, 0, 1); PG8_STAGE(PG8_SA(0, 0), a2, voffA);
            PG8_BAR; PG8_WAIT_L(0); PG8_MMA(1, 0, At, B0); PG8_BAR; PG8_SCHED;
            PG8_STAGE(PG8_SB(0, 1), b2 + hstep, voffA);
            PG8_WAIT_V(6); PG8_BAR; PG8_MMA(1, 1, At, B1); PG8_BAR;
            PG8_LDB(B0, 1, 0); PG8_SCHED; PG8_LDA(At, 1, 0); PG8_STAGE(PG8_SA(0, 1), a2 + hstep, voffA);
            PG8_WAIT_L(8); PG8_BAR; PG8_WAIT_L(0); PG8_MMA(0, 0, At, B0); PG8_BAR; PG8_SCHED;
            PG8_LDB(B1, 1, 1); PG8_STAGE(PG8_SB(1, 0), b3, voffA);
            PG8_BAR; PG8_WAIT_L(0); PG8_MMA(0, 1, At, B1); PG8_BAR;
            PG8_LDA(At, 1, 1); PG8_STAGE(PG8_SA(1, 0), a3, voffA);
            PG8_BAR; PG8_WAIT_L(0); PG8_MMA(1, 0, At, B0); PG8_BAR; PG8_SCHED;
            PG8_STAGE(PG8_SB(1, 1), b3 + hstep, voffA);
            PG8_WAIT_V(6); PG8_BAR; PG8_MMA(1, 1, At, B1); PG8_BAR;
        }
        E(acc, cur, wr, wc, fr, fq);
        if (!has_next) break;
#pragma unroll
        for (int a = 0; a < 2; ++a)
#pragma unroll
            for (int b = 0; b < 2; ++b)
#pragma unroll
                for (int m = 0; m < 4; ++m)
#pragma unroll
                    for (int n = 0; n < 2; ++n) acc[a][b][m][n] = (f32x4){0.f, 0.f, 0.f, 0.f};
        cur = nxt; cA = nA; cB = nB; ++ui;
    }
    PG8_WAIT_V(0);
    if (wr == 0) PG8_BAR;
    PG8_BAR;
#undef PG8_SA
#undef PG8_SB
#undef PG8_STAGE
#undef PG8_LDA
#undef PG8_LDB
#undef PG8_MMA
#undef PG8_WAIT_V
#undef PG8_WAIT_L
#undef PG8_BAR
#undef PG8_SCHED
}
}
using pg8::Unit;

struct Epi {
    int mode, ldo; float scale; GAS unsigned char* ws;
    __device__ __forceinline__ void operator()(const f32x4 (&acc)[2][2][4][2], const Unit& u, int wr, int wc, int fr, int fq) const {
        const int row0 = u.pm * 256 + wr * 64 + fr, col0 = u.pn * 256 + wc * 32 + 4 * fq;
        const GAS float* ssq_in = (const GAS float*)(ws + WS_SSQ); GAS float* ssq_out = (GAS float*)(ws + WS_SSQ); GAS float* xf = (GAS float*)(ws + WS_XF); GAS bf16_t* xb = (GAS bf16_t*)(ws + WS_XB);
        GAS float* part = (GAS float*)(ws + WS_PART); GAS bf16_t* O = (GAS bf16_t*)(ws + (mode == 3 ? WS_LRAW : WS_PROJ));
        if (u.kc >= 0) {
#pragma unroll
            for (int ai = 0; ai < 2; ++ai)
#pragma unroll
                for (int m = 0; m < 4; ++m) {
                    GAS float* rp = part + ((size_t)u.kc * 256 + (wr * 64 + fr + ai * 128 + m * 16)) * 1024 + col0;
#pragma unroll
                    for (int bj = 0; bj < 2; ++bj)
#pragma unroll
                        for (int n = 0; n < 2; ++n) *(GAS f32x4*)(rp + bj * 128 + n * 16) = acc[ai][bj][m][n];
                }
        } else if (mode == 0) {
#pragma unroll
            for (int ai = 0; ai < 2; ++ai)
#pragma unroll
                for (int m = 0; m < 4; ++m) {
                    const int row = row0 + ai * 128 + m * 16; float rs; { const f32x4 pz = *(const GAS f32x4*)(ssq_in + (size_t)row * 16 + 4 * fq); float sq = (pz.x + pz.y) + (pz.z + pz.w); sq += __shfl_xor(sq, 16); sq += __shfl_xor(sq, 32); rs = rsqrtf(sq * (1.0f / 1024.0f) + 1e-6f); }
#pragma unroll
                    for (int bj = 0; bj < 2; ++bj) {
                        const int hid = (u.pn * 256 + bj * 128 + wc * 32) / 2 + 4 * fq;
                        const f32x4 gg = acc[ai][bj][m][0] * rs, uu = acc[ai][bj][m][1] * rs;
                        u32x2 w; w.x = pk2(siluf_(gg.x) * uu.x, siluf_(gg.y) * uu.y); w.y = pk2(siluf_(gg.z) * uu.z, siluf_(gg.w) * uu.w);
                        *(GAS u32x2*)(O + (size_t)row * FF + hid) = w;
                    }
                }
        } else if (mode == 1) {
#pragma unroll
            for (int ai = 0; ai < 2; ++ai)
#pragma unroll
                for (int m = 0; m < 4; ++m) {
                    const int row = row0 + ai * 128 + m * 16; float ss = 0.f;
#pragma unroll
                    for (int bj = 0; bj < 2; ++bj)
#pragma unroll
                        for (int n = 0; n < 2; ++n) {
                            const int c = col0 + bj * 128 + n * 16;
                            GAS u32x2* xp = (GAS u32x2*)(xb + (size_t)row * D + c);
                            const u32x2 xo = *xp; f32x4 x = {bflo(xo.x), bfhi(xo.x), bflo(xo.y), bfhi(xo.y)}; x = x + acc[ai][bj][m][n] * scale;
                            u32x2 w; w.x = pk2(x.x, x.y); w.y = pk2(x.z, x.w); *xp = w;
                            ss += (x.x * x.x + x.y * x.y) + (x.z * x.z + x.w * x.w);
                        }
                    ss += __shfl_xor(ss, 16); ss += __shfl_xor(ss, 32);
                    if (fq == 0) ssq_out[(size_t)row * 16 + u.pn * 4 + wc] = ss;
                }
        } else {
#pragma unroll
            for (int ai = 0; ai < 2; ++ai)
#pragma unroll
                for (int m = 0; m < 4; ++m) {
                    const int row = row0 + ai * 128 + m * 16; float rs = 1.0f; if (mode == 2) { const f32x4 pz = *(const GAS f32x4*)(ssq_in + (size_t)row * 16 + 4 * fq); float sq = (pz.x + pz.y) + (pz.z + pz.w); sq += __shfl_xor(sq, 16); sq += __shfl_xor(sq, 32); rs = rsqrtf(sq * (1.0f / 1024.0f) + 1e-6f); }
#pragma unroll
                    for (int bj = 0; bj < 2; ++bj)
#pragma unroll
                        for (int n = 0; n < 2; ++n) {
                            const int c = col0 + bj * 128 + n * 16; const f32x4 v = acc[ai][bj][m][n] * rs;
                            u32x2 w; w.x = pk2(v.x, v.y); w.y = pk2(v.z, v.w); *(GAS u32x2*)(O + (size_t)row * ldo + c) = w;
                        }
                }
        }
    }
};

__device__ __forceinline__ int map_col(int n, int kind) {
    if (kind == 1) return ((n >> 4) << 5) + (n & 15);
    if (kind == 2) return ((n >> 4) << 5) + 16 + (n & 15);
    if (kind == 3) return n < 2048 ? n : (n < 2064 ? 3072 + (n - 2048) : n - 16);
    return n;
}
struct TItem { const GAS float* W; const GAS float* gsc; GAS bf16_t* WT; int K, Nsrc, kind, k0, n0; };
__device__ __forceinline__ void titem_load(const TItem& t, f32x4 (&v)[8], int lane) {
    const int nq = t.n0 + (lane & 7) * 4;
#pragma unroll
    for (int i = 0; i < 8; ++i) { const int kk = 8 * i + (lane >> 3); v[i] = (nq < t.Nsrc) ? *(const GAS f32x4*)(t.W + (size_t)(t.k0 + kk) * t.Nsrc + nq) : (f32x4){0.f, 0.f, 0.f, 0.f}; }
}
__device__ __forceinline__ void titem_store(const TItem& t, const f32x4 (&v)[8], LAS float* scr, int lane) {
#pragma unroll
    for (int i = 0; i < 8; ++i) {
        const int kk = 8 * i + (lane >> 3); const float g = t.gsc ? t.gsc[t.k0 + kk] : 1.0f;
        LAS float* d = scr + kk * 33 + (lane & 7) * 4;
        d[0] = v[i].x * g; d[1] = v[i].y * g; d[2] = v[i].z * g; d[3] = v[i].w * g;
    }
    LDS_WAIT();
    const int c = lane & 7;
#pragma unroll
    for (int j = 0; j < 4; ++j) {
        const int nl = (lane >> 3) + 8 * j, n = t.n0 + nl;
        if (n < t.Nsrc) {
            const LAS float* s = scr + (8 * c) * 33 + nl;
            u32x4 o; o.x = pk2(s[0 * 33], s[1 * 33]); o.y = pk2(s[2 * 33], s[3 * 33]); o.z = pk2(s[4 * 33], s[5 * 33]); o.w = pk2(s[6 * 33], s[7 * 33]);
            *(GAS u32x4*)(t.WT + (size_t)map_col(n, t.kind) * t.K + t.k0 + 8 * c) = o;
        }
    }
    LDS_WAIT();
}
__device__ __forceinline__ TItem titem_decode(const Ctx& p, int it) {
    GAS unsigned char* ws = p.ws;
    constexpr int IT_G = 176, N_G = 8 * IT_G, IT_E = 240, N_E = 2 * IT_E, IT_O = 200, N_O = 2 * IT_O, IT_W = 64;
    TItem t; int r = it, nblk;
    if (r < 2 * N_G) {
        const int up = r >= N_G; if (up) r -= N_G;
        const int mat = r / IT_G, l = mat >> 1, f = mat & 1; r %= IT_G;
        t.W = p.in(f ? (up ? I_F2U : I_F2G) : (up ? I_F1U : I_F1G)) + (size_t)l * D * FF; t.gsc = p.in(f ? I_NF2 : I_NF1) + l * D;
        t.WT = (GAS bf16_t*)(ws + WS_WGU) + (size_t)mat * 5632 * 1024; t.K = D; t.Nsrc = FF; t.kind = up ? 2 : 1;
    } else if ((r -= 2 * N_G) < N_G) {
        const int mat = r / IT_G, l = mat >> 1, f = mat & 1; r %= IT_G;
        t.W = p.in(f ? I_F2D : I_F1D) + (size_t)l * FF * D; t.gsc = nullptr; t.WT = (GAS bf16_t*)(ws + WS_WD) + (size_t)mat * 1024 * FF; t.K = FF; t.Nsrc = D; t.kind = 0;
    } else if ((r -= N_G) < N_E) {
        const int mat = r / IT_E; r %= IT_E;
        t.W = p.in(I_EWIN) + (size_t)mat * D * EPROJ; t.gsc = p.in(I_NMIX) + (2 * mat) * D; t.WT = (GAS bf16_t*)(ws + WS_WINE) + (size_t)mat * EPROJ * 1024; t.K = D; t.Nsrc = EPROJ; t.kind = 0;
    } else if ((r -= N_E) < N_O) {
        const int mat = r / IT_O; r %= IT_O;
        t.W = p.in(I_OWIN) + (size_t)mat * D * OSRC; t.gsc = p.in(I_NMIX) + (2 * mat + 1) * D; t.WT = (GAS bf16_t*)(ws + WS_WINO) + (size_t)mat * OPROJ * 1024; t.K = D; t.Nsrc = OSRC; t.kind = 3;
    } else {
        r -= N_O; const int mat = r / IT_W; r %= IT_W;
        t.W = (mat & 1) ? p.in(I_OWOUT) + (size_t)(mat >> 1) * D * D : p.in(I_EWOUT) + (size_t)(mat >> 1) * D * D; t.gsc = nullptr;
        t.WT = (GAS bf16_t*)(ws + WS_WOUT) + (size_t)mat * D * D; t.K = D; t.Nsrc = D; t.kind = 0;
    }
    nblk = (t.Nsrc + 127) / 128; t.k0 = 128 * (r / nblk); t.n0 = 128 * (r % nblk);
    return t;
}

__device__ __forceinline__ void phase_p0(const Ctx& p, LAS unsigned char* lds) {
    const int tid = p.tid, lane = tid & 63, wave = tid >> 6;
    const int gw = p.bid * NWAVES + wave, NGW = p.G * NWAVES;
    GAS unsigned char* ws = p.ws;
    GAS bf16_t* WINO = (GAS bf16_t*)(ws + WS_WINO); GAS bf16_t* WLORA = (GAS bf16_t*)(ws + WS_WLORA);
    constexpr int NITEMS = 3 * 8 * 1408 + 2 * 1920 + 2 * 1552 + 4 * 512;
    {
        constexpr int NTILES = 3 * 8 * 176 + 2 * 240 + 2 * 200 + 4 * 64;
        LAS float* tile = (LAS float*)lds;
        const int q = tid & 31, r0 = tid >> 5;
        for (int tix = p.bid; tix < NTILES; tix += p.G) {
            const TItem t = titem_decode(p, tix);
            const int nq = t.n0 + 4 * q;
            f32x4 v[8]; float g8[8];
#pragma unroll
            for (int i = 0; i < 8; ++i) { const int kk = r0 + 16 * i; v[i] = (nq < t.Nsrc) ? *(const GAS f32x4*)(t.W + (size_t)(t.k0 + kk) * t.Nsrc + nq) : (f32x4){0.f, 0.f, 0.f, 0.f}; g8[i] = t.gsc ? t.gsc[t.k0 + kk] : 1.0f; }
            __syncthreads();
#pragma unroll
            for (int i = 0; i < 8; ++i) { LAS float* d = tile + (r0 + 16 * i) * 129 + 4 * q; d[0] = v[i].x * g8[i]; d[1] = v[i].y * g8[i]; d[2] = v[i].z * g8[i]; d[3] = v[i].w * g8[i]; }
            __syncthreads();
#pragma unroll
            for (int j = 0; j < 4; ++j) {
                const int id = tid + NTHREADS * j, nl = id >> 4, c16 = id & 15, n = t.n0 + nl;
                if (n < t.Nsrc) {
                    const LAS float* sp = tile + (8 * c16) * 129 + nl;
                    u32x4 o; o.x = pk2(sp[0 * 129], sp[1 * 129]); o.y = pk2(sp[2 * 129], sp[3 * 129]); o.z = pk2(sp[4 * 129], sp[5 * 129]); o.w = pk2(sp[6 * 129], sp[7 * 129]);
                    *(GAS u32x4*)(t.WT + (size_t)map_col(n, t.kind) * t.K + t.k0 + 8 * c16) = o;
                }
            }
        }
        __syncthreads();
    }
    const size_t gt = (size_t)p.bid * NTHREADS + tid, GT = (size_t)p.G * NTHREADS;
    for (size_t i = gt; i < (size_t)2 * 240 * 1024 / 2; i += GT) {
        const size_t mat = i / (240 * 512), r = i % (240 * 512);
        ((GAS unsigned*)(WINO + (size_t)mat * OPROJ * 1024 + (size_t)OSRC * 1024))[r] = 0u;
    }
    for (size_t i = gt; i < (size_t)2 * 1536 * 256; i += GT) {
        const int e = (int)(i / (1536 * 256)), n = (int)((i / 256) % 1536), k = (int)(i % 256), region = n >> 9, ch = n & 511;
        float v = 0.f;
        if (region == 0) { if (k < 64) v = p.in(I_W2)[((size_t)e * 64 + k) * 512 + ch]; }
        else if (region == 1) { if (k >= 64 && k < 128) v = p.in(I_A2)[((size_t)e * 64 + (k - 64)) * 512 + ch]; }
        else { if (k >= 128) v = p.in(I_G2)[((size_t)e * 128 + (k - 128)) * 512 + ch]; }
        WLORA[i] = (bf16_t)(pk2(v, 0.f) & 0xffffu);
    }
    GAS float* xf = (GAS float*)(ws + WS_XF); GAS bf16_t* xb = (GAS bf16_t*)(ws + WS_XB); GAS float* ssq = (GAS float*)(ws + WS_SSQ);
    for (int m = gw; m < MT; m += NGW) {
        const GAS float* src;
        if (m < MP) { const int b = m / TP, t = m % TP; src = t < 16 ? p.in(I_META) + (size_t)t * D : p.in(I_XP) + ((size_t)b * 2048 + (t - 16)) * D; }
        else src = p.in(I_XS) + (size_t)(m - MP) * D;
        float ss = 0.f;
#pragma unroll
        for (int j = 0; j < 4; ++j) {
            const int c = 4 * lane + 256 * j; const f32x4 x = *(const GAS f32x4*)(src + c);
            u32x2 w; w.x = pk2(x.x, x.y); w.y = pk2(x.z, x.w); *(GAS u32x2*)(xb + (size_t)m * D + c) = w;
            ss += (x.x * x.x + x.y * x.y) + (x.z * x.z + x.w * x.w);
        }
        ss = wave_sum(ss);
        if (lane < 16) ssq[(size_t)m * 16 + lane] = lane == 0 ? ss : 0.f;
        if (lane == 0) ((GAS float*)(ws + WS_RSTD))[m] = rsqrtf(ss * (1.0f / 1024.0f) + 1e-6f);
    }
}

__device__ __forceinline__ float lbval(const Ctx& p, int e, int ch) { return e == 0 ? 0.f : __builtin_amdgcn_rcpf(1.0f + __expf(p.in(I_LB)[ch] - p.in(I_LB)[512 + ch])); }

__device__ __forceinline__ void phase_fprep(const Ctx& p, int odd, int idx) {
    GAS unsigned char* ws = p.ws;
    const GAS bf16_t* proj = (const GAS bf16_t*)(ws + WS_PROJ);
    GAS bf16_t* QDg = (GAS bf16_t*)(ws + WS_MIXB); GAS bf16_t* KDg = QDg + (size_t)MT * 512; GAS bf16_t* KDTg = (GAS bf16_t*)(ws + WS_KDT); GAS float* ELg = (GAS float*)(ws + WS_ELG);
    const int LDP = odd ? OPROJ : EPROJ;
    constexpr float SC = 0.08838834764831845f;
    const int tid = p.tid, lane = tid & 63, wv = tid >> 6, cg = lane & 15, tq = lane >> 4, c4 = (wv * 16 + cg) * 4;
    f32x4 gu[16]; f32x4 gbv = {0.f, 0.f, 0.f, 0.f}; float lb[4] = {0.f, 0.f, 0.f, 0.f};
    if (odd) {
#pragma unroll
        for (int r = 0; r < 16; ++r) gu[r] = *(const GAS f32x4*)(p.in(I_GUP) + ((size_t)idx * 16 + r) * 512 + c4);
        gbv = *(const GAS f32x4*)(p.in(I_GB) + (size_t)idx * 512 + c4);
    } else {
#pragma unroll
        for (int r = 0; r < 16; ++r) gu[r] = (f32x4){0.f, 0.f, 0.f, 0.f};
#pragma unroll
        for (int i = 0; i < 4; ++i) lb[i] = lbval(p, idx, c4 + i);
    }
    for (int pair = p.bid; pair < 8 * 65; pair += p.G) {
        const int b = pair / 65, ch = pair % 65, tok0 = ch * 32 + tq * 8;
        const size_t m0 = (size_t)b * TP + tok0;
        u32x2 qv[8], kv[8];
#pragma unroll
        for (int j = 0; j < 8; ++j) { const GAS bf16_t* row = proj + (m0 + j) * LDP; qv[j] = *(const GAS u32x2*)(row + c4); kv[j] = *(const GAS u32x2*)(row + 512 + c4); }
        f32x4 lf[8];
        if (odd) {
            u32x4 g0[8], g1[8];
#pragma unroll
            for (int j = 0; j < 8; ++j) { const GAS bf16_t* row = proj + (m0 + j) * LDP; g0[j] = *(const GAS u32x4*)(row + 3072); g1[j] = *(const GAS u32x4*)(row + 3080); }
#pragma unroll
            for (int j = 0; j < 8; ++j) {
                const float gd[16] = {bflo(g0[j].x), bfhi(g0[j].x), bflo(g0[j].y), bfhi(g0[j].y), bflo(g0[j].z), bfhi(g0[j].z), bflo(g0[j].w), bfhi(g0[j].w),
                                      bflo(g1[j].x), bfhi(g1[j].x), bflo(g1[j].y), bfhi(g1[j].y), bflo(g1[j].z), bfhi(g1[j].z), bflo(g1[j].w), bfhi(g1[j].w)};
                f32x4 gk = gbv;
#pragma unroll
                for (int r = 0; r < 16; ++r) gk = gk + gu[r] * gd[r];
                lf[j].x = (fminf(gk.x, 0.f) - __logf(1.0f + __expf(-fabsf(gk.x)))) * 0.0625f; lf[j].y = (fminf(gk.y, 0.f) - __logf(1.0f + __expf(-fabsf(gk.y)))) * 0.0625f;
                lf[j].z = (fminf(gk.z, 0.f) - __logf(1.0f + __expf(-fabsf(gk.z)))) * 0.0625f; lf[j].w = (fminf(gk.w, 0.f) - __logf(1.0f + __expf(-fabsf(gk.w)))) * 0.0625f;
            }
        } else {
#pragma unroll
            for (int j = 0; j < 8; ++j) {
                const float fa[4] = {bflo(kv[j].x), bfhi(kv[j].x), bflo(kv[j].y), bfhi(kv[j].y)}; float l4[4];
#pragma unroll
                for (int i = 0; i < 4; ++i) l4[i] = __logf(1.0f - (1.0f - lb[i]) * __builtin_amdgcn_rcpf(1.0f + __expf(fa[i])));
                lf[j] = (f32x4){l4[0], l4[1], l4[2], l4[3]};
            }
        }
        f32x4 kk[8];
#pragma unroll
        for (int j = 0; j < 8; ++j) {
            const bool ok = tok0 + j < TP;
            if (odd) kk[j] = (f32x4){bflo(kv[j].x), bfhi(kv[j].x), bflo(kv[j].y), bfhi(kv[j].y)};
            else kk[j] = (f32x4){1.0f - __expf(lf[j].x), 1.0f - __expf(lf[j].y), 1.0f - __expf(lf[j].z), 1.0f - __expf(lf[j].w)};
            if (!ok) { lf[j] = (f32x4){0.f, 0.f, 0.f, 0.f}; kk[j] = lf[j]; qv[j] = (u32x2){0u, 0u}; }
            if (j) lf[j] = lf[j] + lf[j - 1];
        }
        f32x4 pre = {0.f, 0.f, 0.f, 0.f};
        {
            const float tot[4] = {lf[7].x, lf[7].y, lf[7].z, lf[7].w}; float pr4[4];
#pragma unroll
            for (int i = 0; i < 4; ++i) {
                const float p0 = __int_as_float(__builtin_amdgcn_ds_bpermute(cg << 2, __float_as_int(tot[i]))), p1 = __int_as_float(__builtin_amdgcn_ds_bpermute((cg + 16) << 2, __float_as_int(tot[i]))),
                            p2 = __int_as_float(__builtin_amdgcn_ds_bpermute((cg + 32) << 2, __float_as_int(tot[i])));
                pr4[i] = (tq > 0 ? p0 : 0.f) + (tq > 1 ? p1 : 0.f) + (tq > 2 ? p2 : 0.f);
            }
            pre = (f32x4){pr4[0], pr4[1], pr4[2], pr4[3]};
        }
        u32x4 kt[4];
        unsigned ktw[4][4];
#pragma unroll
        for (int j = 0; j < 8; j += 2) {
            f32x4 kd2[2];
#pragma unroll
            for (int jj = 0; jj < 2; ++jj) {
                const f32x4 cu4 = lf[j + jj] + pre; const float cu[4] = {fmaxf(cu4.x, -85.0f), fmaxf(cu4.y, -85.0f), fmaxf(cu4.z, -85.0f), fmaxf(cu4.w, -85.0f)};
                const float q4[4] = {bflo(qv[j + jj].x), bfhi(qv[j + jj].x), bflo(qv[j + jj].y), bfhi(qv[j + jj].y)}; const float k4[4] = {kk[j + jj].x, kk[j + jj].y, kk[j + jj].z, kk[j + jj].w};
                float qd[4], kd[4];
#pragma unroll
                for (int i = 0; i < 4; ++i) { qd[i] = q4[i] * SC * __expf(cu[i]); kd[i] = k4[i] * __expf(-cu[i]); }
                kd2[jj] = (f32x4){kd[0], kd[1], kd[2], kd[3]};
                if (tok0 + j + jj < TP) {
                    *(GAS u32x2*)(QDg + (m0 + j + jj) * 512 + c4) = (u32x2){pk2(qd[0], qd[1]), pk2(qd[2], qd[3])};
                    *(GAS u32x2*)(KDg + (m0 + j + jj) * 512 + c4) = (u32x2){pk2(kd[0], kd[1]), pk2(kd[2], kd[3])};
                }
            }
            ktw[0][j >> 1] = pk2(kd2[0].x, kd2[1].x); ktw[1][j >> 1] = pk2(kd2[0].y, kd2[1].y); ktw[2][j >> 1] = pk2(kd2[0].z, kd2[1].z); ktw[3][j >> 1] = pk2(kd2[0].w, kd2[1].w);
        }
#pragma unroll
        for (int i = 0; i < 4; ++i) { kt[i] = (u32x4){ktw[i][0], ktw[i][1], ktw[i][2], ktw[i][3]};
            *(GAS u32x4*)(KDTg + (((size_t)b * 65 + ch) * 512 + c4 + i) * 32 + tq * 8) = kt[i]; }
        if (tq == 3) {
            const f32x4 ce = lf[7] + pre;
            *(GAS f32x4*)(ELg + ((size_t)b * 65 + ch) * 512 + c4) = (f32x4){__expf(fmaxf(ce.x, -85.0f)), __expf(fmaxf(ce.y, -85.0f)), __expf(fmaxf(ce.z, -85.0f)), __expf(fmaxf(ce.w, -85.0f))};
        }
    }
}

__device__ __forceinline__ void phase_lin(const Ctx& p, int e) {
    GAS unsigned char* ws = p.ws;
    const GAS bf16_t* proj = (const GAS bf16_t*)(ws + WS_PROJ); GAS bf16_t* lin = (GAS bf16_t*)(ws + WS_LIN);
    const GAS float* mu = p.in(I_MU) + (size_t)e * 1792; const GAS float* sst = p.in(I_SS) + (size_t)e * NS * 1792;
    const size_t gt = (size_t)p.bid * NTHREADS + p.tid, GT = (size_t)p.G * NTHREADS;
    for (size_t i = gt; i < (size_t)MT * 32; i += GT) {
        const int m = (int)(i >> 5), j8 = (int)(i & 31) * 8;
        const u32x4 cu = *(const GAS u32x4*)(proj + (size_t)m * EPROJ + 3584 + j8);
        float cur[8] = {bflo(cu.x), bfhi(cu.x), bflo(cu.y), bfhi(cu.y), bflo(cu.z), bfhi(cu.z), bflo(cu.w), bfhi(cu.w)};
        float prv[8];
        if (m >= MP) { const GAS float* s = sst + (size_t)(m - MP) * 1792 + 1536 + j8; const f32x4 a = *(const GAS f32x4*)s, b = *(const GAS f32x4*)(s + 4);
            prv[0] = a.x; prv[1] = a.y; prv[2] = a.z; prv[3] = a.w; prv[4] = b.x; prv[5] = b.y; prv[6] = b.z; prv[7] = b.w; }
        else if ((m % TP) == 0) {
#pragma unroll
            for (int j = 0; j < 8; ++j) prv[j] = 0.f; }
        else { const u32x4 pu = *(const GAS u32x4*)(proj + (size_t)(m - 1) * EPROJ + 3584 + j8);
            prv[0] = bflo(pu.x); prv[1] = bfhi(pu.x); prv[2] = bflo(pu.y); prv[3] = bfhi(pu.y); prv[4] = bflo(pu.z); prv[5] = bfhi(pu.z); prv[6] = bflo(pu.w); prv[7] = bfhi(pu.w); }
        const f32x4 m0 = *(const GAS f32x4*)(mu + 1536 + j8), m1 = *(const GAS f32x4*)(mu + 1536 + j8 + 4);
        const float mm[8] = {m0.x, m0.y, m0.z, m0.w, m1.x, m1.y, m1.z, m1.w};
        float o[8];
#pragma unroll
        for (int j = 0; j < 8; ++j) { const float x = cur[j] + (prv[j] - cur[j]) * mm[j]; o[j] = j8 < 64 ? 1.0f - 2.0f * __builtin_amdgcn_rcpf(1.0f + __expf(2.0f * x)) : (j8 < 128 ? x : sigmoidf_(x)); }
        u32x4 w; w.x = pk2(o[0], o[1]); w.y = pk2(o[2], o[3]); w.z = pk2(o[4], o[5]); w.w = pk2(o[6], o[7]);
        *(GAS u32x4*)(lin + (size_t)m * 256 + j8) = w;
    }
    for (size_t i = gt; i < (size_t)(NB + NS) * 1792; i += GT) {
        const int s = (int)(i / 1792), c = (int)(i % 1792);
        if (s < NB) p.out[O_SP + ((size_t)e * NB + s) * 1792 + c] = bf2f(proj[((size_t)s * TP + TP - 1) * EPROJ + 2048 + c]);
        else p.out[O_SSH + ((size_t)e * NS + (s - NB)) * 1792 + c] = bf2f(proj[((size_t)MP + (s - NB)) * EPROJ + 2048 + c]);
    }
}

constexpr int TC = 32, NCH = (TP + TC - 1) / TC;

template <bool GLA>
__device__ __forceinline__ void glalike_sample(const Ctx& p, int idx  , int i, int h, LAS unsigned char* lds) {
    constexpr int DV = GLA ? 256 : 128, LDP = GLA ? OPROJ : EPROJ, KR = GLA ? 8 : 16, RPT = 128 / KR, VT = DV / 4;
    const int tid = p.tid, m = MP + i;
    GAS unsigned char* ws = p.ws;
    const GAS bf16_t* pr = (const GAS bf16_t*)(ws + WS_PROJ) + (size_t)m * LDP; GAS float* oraw = (GAS float*)(ws + WS_ORAW);
    LAS float* sq = (LAS float*)lds; LAS float* sk = sq + 128; LAS float* sf = sk + 128; LAS float* sv = sf + 128; LAS float* red = sv + 256;
    __syncthreads();
    if (tid < 128) {
        const int ch = h * 128 + tid;
        if (!GLA) {
            const float qa = bf2f(pr[ch]), fa = bf2f(pr[512 + ch]); const float lb = lbval(p, idx, ch);
            const float kk = (1.0f - lb) / (1.0f + __expf(fa));
            sq[tid] = qa * 0.08838834764831845f; sk[tid] = kk; sf[tid] = 1.0f - kk;
        } else {
            float gk = p.in(I_GB)[(size_t)idx * 512 + ch];
#pragma unroll
            for (int r = 0; r < 16; ++r) gk += bf2f(pr[3072 + r]) * p.in(I_GUP)[((size_t)idx * 16 + r) * 512 + ch];
            const float ls = fminf(gk, 0.f) - __logf(1.0f + __expf(-fabsf(gk)));
            sq[tid] = bf2f(pr[ch]) * 0.08838834764831845f; sk[tid] = bf2f(pr[512 + ch]); sf[tid] = __expf(ls * 0.0625f);
        }
    }
    if (tid >= 128 && tid < 128 + DV) {
        const int c = tid - 128;
        if (!GLA) sv[c] = siluf_(bf2f(pr[1024 + h * 128 + c])); else sv[c] = bf2f(pr[1024 + h * 256 + c]);
    }
    __syncthreads();
    const int v4 = (tid % VT) * 4, kr = tid / VT;
    const size_t soff = ((((size_t)idx * NS + i) * 4 + h) * 128) * DV;
    const GAS float* Sin = p.in(GLA ? I_SG : I_SH) + soff; GAS float* Sout = p.out + (GLA ? O_GS : O_HS) + soff;
    const f32x4 vv = *(const LAS f32x4*)(sv + v4); f32x4 o = {0.f, 0.f, 0.f, 0.f};
#pragma unroll 4
    for (int jj = 0; jj < RPT; ++jj) {
        const int k = kr * RPT + jj;
        f32x4 s = *(const GAS f32x4*)(Sin + (size_t)k * DV + v4);
        s = s * sf[k] + vv * sk[k];
        *(GAS f32x4*)(Sout + (size_t)k * DV + v4) = s;
        o = o + s * sq[k];
    }
    *(LAS f32x4*)(red + kr * DV + v4) = o;
    __syncthreads();
    if (tid < DV) { float a = 0.f;
#pragma unroll
        for (int r = 0; r < KR; ++r) a += red[r * DV + tid];
        oraw[(size_t)m * 1024 + h * DV + tid] = a; }
}

__device__ __forceinline__ void rwkv_sample(const Ctx& p, int e, int i, int h, LAS unsigned char* lds) {
    const int tid = p.tid, m = MP + i;
    GAS unsigned char* ws = p.ws;
    const GAS bf16_t* pb = (const GAS bf16_t*)(ws + WS_PROJ) + (size_t)m * EPROJ + 2048; GAS float* oraw = (GAS float*)(ws + WS_ORAW);
    const GAS bf16_t* lraw = (const GAS bf16_t*)(ws + WS_LRAW); GAS float* bsum = (GAS float*)(ws + WS_BSUM);
    LAS float* sr = (LAS float*)lds; LAS float* sw = sr + 64; LAS float* sk = sw + 64; LAS float* sn = sk + 64; LAS float* sa_ = sn + 64; LAS float* sv = sa_ + 64;
    __syncthreads();
    if (tid < 64) {
        const int c = h * 64 + tid;
        const GAS float* prev = p.in(I_SS) + ((size_t)e * NS + i) * 1792; const GAS float* mu = p.in(I_MU) + (size_t)e * 1792;
        const float xr = bf2f(pb[c]), xk = bf2f(pb[512 + c]), xv = bf2f(pb[1024 + c]);
        const float r = xr + (prev[c] - xr) * mu[c], k_ = xk + (prev[512 + c] - xk) * mu[512 + c], v = xv + (prev[1024 + c] - xv) * mu[1024 + c];
        const float a = sigmoidf_(p.in(I_A0)[e * 512 + c] + bf2f(lraw[(size_t)m * 1536 + 512 + c]));
        const float w = __expf(-0.60653066f * sigmoidf_(p.in(I_W0)[e * 512 + c] + bf2f(lraw[(size_t)m * 1536 + c])));
        const float kkw = k_ * p.in(I_KK)[e * 512 + c];
        const float nrm = fmaxf(sqrtf(wave_sum(kkw * kkw)), 1e-12f), kk = kkw / nrm;
        const float kmod = k_ * (1.0f + (a - 1.0f) * p.in(I_KA)[e * 512 + c]);
        const float bs = wave_sum(r * kmod * p.in(I_RK)[e * 512 + c]);
        if (tid == 0) bsum[(size_t)m * 8 + h] = bs;
        sr[tid] = r; sw[tid] = w; sk[tid] = kmod; sn[tid] = -kk; sa_[tid] = kk * a; sv[tid] = v;
    }
    __syncthreads();
    const int row = tid >> 3, l = tid & 7;
    const size_t soff = ((((size_t)e * NS + i) * 8 + h) * 64 + row) * 64 + 8 * l;
    const GAS float* Sin = p.in(I_SR) + soff; GAS float* Sout = p.out + O_RS + soff;
    f32x4 s0 = *(const GAS f32x4*)Sin, s1 = *(const GAS f32x4*)(Sin + 4);
    const f32x4 n0 = *(const LAS f32x4*)(sn + 8 * l), n1 = *(const LAS f32x4*)(sn + 8 * l + 4);
    float sa = (s0.x * n0.x + s0.y * n0.y) + (s0.z * n0.z + s0.w * n0.w) + (s1.x * n1.x + s1.y * n1.y) + (s1.z * n1.z + s1.w * n1.w);
    sa = allred8(sa);
    const f32x4 w0 = *(const LAS f32x4*)(sw + 8 * l), w1 = *(const LAS f32x4*)(sw + 8 * l + 4), a0 = *(const LAS f32x4*)(sa_ + 8 * l), a1 = *(const LAS f32x4*)(sa_ + 8 * l + 4);
    const f32x4 k0 = *(const LAS f32x4*)(sk + 8 * l), k1 = *(const LAS f32x4*)(sk + 8 * l + 4), r0 = *(const LAS f32x4*)(sr + 8 * l), r1 = *(const LAS f32x4*)(sr + 8 * l + 4);
    const float v = sv[row];
    s0 = s0 * w0 + a0 * sa + k0 * v; s1 = s1 * w1 + a1 * sa + k1 * v;
    float y = (s0.x * r0.x + s0.y * r0.y) + (s0.z * r0.z + s0.w * r0.w) + (s1.x * r1.x + s1.y * r1.y) + (s1.z * r1.z + s1.w * r1.w);
    y = allred8(y);
    if (l == 0) oraw[(size_t)m * 1024 + 512 + h * 64 + row] = y;
    *(GAS f32x4*)Sout = s0; *(GAS f32x4*)(Sout + 4) = s1;
}

__device__ __forceinline__ void rwkv_prompt_scan(const Ctx& p, int e, int bh, int hf, LAS unsigned char* lds) {
    const int tid = p.tid, lane = tid & 63, wave = tid >> 6, b = bh >> 3, h = bh & 7;
    GAS unsigned char* ws = p.ws;
    const GAS bf16_t* proj = (const GAS bf16_t*)(ws + WS_PROJ); GAS float* oraw = (GAS float*)(ws + WS_ORAW);
    const GAS bf16_t* lraw = (const GAS bf16_t*)(ws + WS_LRAW); GAS float* bsum = (GAS float*)(ws + WS_BSUM);
    LAS float* st = (LAS float*)lds;
    __syncthreads();
    if (wave >= 4) {
        const int ts = tid - 256, s_st = ts >> 3, j8 = (ts & 7) * 8, c0 = h * 64 + j8;
        const GAS float* mu = p.in(I_MU) + (size_t)e * 1792;
        float mu_r[8], mu_k[8], mu_v[8], w0p[8], a0p[8], kkp[8], kap[8], rkp[8];
#pragma unroll
        for (int j = 0; j < 8; ++j) { mu_r[j] = mu[c0 + j]; mu_k[j] = mu[512 + c0 + j]; mu_v[j] = mu[1024 + c0 + j]; w0p[j] = p.in(I_W0)[e * 512 + c0 + j]; a0p[j] = p.in(I_A0)[e * 512 + c0 + j];
            kkp[j] = p.in(I_KK)[e * 512 + c0 + j]; kap[j] = p.in(I_KA)[e * 512 + c0 + j]; rkp[j] = p.in(I_RK)[e * 512 + c0 + j]; }
        for (int c = 0; c < NCH; ++c) {
            {
                const int t = c * TC + s_st; const bool ok = t < TP; const size_t m = (size_t)b * TP + (ok ? t : 0);
                const GAS bf16_t* q = proj + m * EPROJ + 2048 + c0;
                const u32x4 cr = *(const GAS u32x4*)q, ck = *(const GAS u32x4*)(q + 512), cv = *(const GAS u32x4*)(q + 1024);
                u32x4 pr_ = {0u, 0u, 0u, 0u}, pk_ = pr_, pv_ = pr_;
                if (ok && t > 0) { pr_ = *(const GAS u32x4*)(q - EPROJ); pk_ = *(const GAS u32x4*)(q - EPROJ + 512); pv_ = *(const GAS u32x4*)(q - EPROJ + 1024); }
                const u32x4 av = *(const GAS u32x4*)(lraw + m * 1536 + 512 + c0), wv = *(const GAS u32x4*)(lraw + m * 1536 + c0);
                const float xr0[8] = {bflo(cr.x), bfhi(cr.x), bflo(cr.y), bfhi(cr.y), bflo(cr.z), bfhi(cr.z), bflo(cr.w), bfhi(cr.w)};
                const float xk0[8] = {bflo(ck.x), bfhi(ck.x), bflo(ck.y), bfhi(ck.y), bflo(ck.z), bfhi(ck.z), bflo(ck.w), bfhi(ck.w)};
                const float xv0[8] = {bflo(cv.x), bfhi(cv.x), bflo(cv.y), bfhi(cv.y), bflo(cv.z), bfhi(cv.z), bflo(cv.w), bfhi(cv.w)};
                const float qr[8] = {bflo(pr_.x), bfhi(pr_.x), bflo(pr_.y), bfhi(pr_.y), bflo(pr_.z), bfhi(pr_.z), bflo(pr_.w), bfhi(pr_.w)};
                const float qk[8] = {bflo(pk_.x), bfhi(pk_.x), bflo(pk_.y), bfhi(pk_.y), bflo(pk_.z), bfhi(pk_.z), bflo(pk_.w), bfhi(pk_.w)};
                const float qv[8] = {bflo(pv_.x), bfhi(pv_.x), bflo(pv_.y), bfhi(pv_.y), bflo(pv_.z), bfhi(pv_.z), bflo(pv_.w), bfhi(pv_.w)};
                const float ar[8] = {bflo(av.x), bfhi(av.x), bflo(av.y), bfhi(av.y), bflo(av.z), bfhi(av.z), bflo(av.w), bfhi(av.w)};
                const float wr_[8] = {bflo(wv.x), bfhi(wv.x), bflo(wv.y), bfhi(wv.y), bflo(wv.z), bfhi(wv.z), bflo(wv.w), bfhi(wv.w)};
                float xr[8], xk[8], xv[8], a[8], wd[8], kkw[8], kmod[8]; float ss = 0.f, bs = 0.f;
#pragma unroll
                for (int j = 0; j < 8; ++j) {
                    xr[j] = xr0[j] + (qr[j] - xr0[j]) * mu_r[j]; xk[j] = xk0[j] + (qk[j] - xk0[j]) * mu_k[j]; xv[j] = xv0[j] + (qv[j] - xv0[j]) * mu_v[j];
                    a[j] = sigmoidf_(ar[j] + a0p[j]); wd[j] = __expf(-0.60653066f * sigmoidf_(wr_[j] + w0p[j]));
                    kkw[j] = xk[j] * kkp[j]; ss += kkw[j] * kkw[j];
                    kmod[j] = xk[j] * ((a[j] - 1.0f) * kap[j] + 1.0f); bs += xr[j] * kmod[j] * rkp[j];
                }
                ss = allred8(ss); bs = allred8(bs);
                const float inv = rsqrtf(fmaxf(ss, 1e-24f));
                if (ok) {
                    if (hf == 0 && (ts & 7) == 0) bsum[m * 8 + h] = bs;
                    LAS float* sp = st + (c & 1) * (TC * 384) + s_st * 384 + j8;
                    *(LAS f32x4*)(sp) = (f32x4){xr[0], xr[1], xr[2], xr[3]}; *(LAS f32x4*)(sp + 4) = (f32x4){xr[4], xr[5], xr[6], xr[7]};
                    *(LAS f32x4*)(sp + 64) = (f32x4){wd[0], wd[1], wd[2], wd[3]}; *(LAS f32x4*)(sp + 68) = (f32x4){wd[4], wd[5], wd[6], wd[7]};
                    *(LAS f32x4*)(sp + 128) = (f32x4){kmod[0], kmod[1], kmod[2], kmod[3]}; *(LAS f32x4*)(sp + 132) = (f32x4){kmod[4], kmod[5], kmod[6], kmod[7]};
                    *(LAS f32x4*)(sp + 192) = (f32x4){-kkw[0] * inv, -kkw[1] * inv, -kkw[2] * inv, -kkw[3] * inv}; *(LAS f32x4*)(sp + 196) = (f32x4){-kkw[4] * inv, -kkw[5] * inv, -kkw[6] * inv, -kkw[7] * inv};
                    *(LAS f32x4*)(sp + 256) = (f32x4){kkw[0] * inv * a[0], kkw[1] * inv * a[1], kkw[2] * inv * a[2], kkw[3] * inv * a[3]};
                    *(LAS f32x4*)(sp + 260) = (f32x4){kkw[4] * inv * a[4], kkw[5] * inv * a[5], kkw[6] * inv * a[6], kkw[7] * inv * a[7]};
                    *(LAS f32x4*)(sp + 320) = (f32x4){xv[0], xv[1], xv[2], xv[3]}; *(LAS f32x4*)(sp + 324) = (f32x4){xv[4], xv[5], xv[6], xv[7]};
                }
            }
            __syncthreads();
        }
        __syncthreads();
    } else {
        __builtin_amdgcn_s_setprio(2);
        const int rowl = wave * 8 + (lane >> 3), row = hf * 32 + rowl, l = lane & 7;
        f32x2_ S[4];
#pragma unroll
        for (int j = 0; j < 4; ++j) S[j] = (f32x2_){0.f, 0.f};
        __syncthreads();
        for (int c = 0; c < NCH; ++c) {
            const int nsteps = (TP - c * TC) < TC ? (TP - c * TC) : TC;
            GAS float* yp = oraw + ((size_t)b * TP + (size_t)c * TC + l) * 1024 + 512 + h * 64 + row;
            const LAS float* sp = st + (c & 1) * (TC * 384);
#define RW_LD(X, ptr) const f32x4 X##r0 = *(const LAS f32x4*)((ptr) + 8 * l), X##r1 = *(const LAS f32x4*)((ptr) + 8 * l + 4), X##w0 = *(const LAS f32x4*)((ptr) + 64 + 8 * l), X##w1 = *(const LAS f32x4*)((ptr) + 68 + 8 * l), \
                X##k0 = *(const LAS f32x4*)((ptr) + 128 + 8 * l), X##k1 = *(const LAS f32x4*)((ptr) + 132 + 8 * l), X##n0 = *(const LAS f32x4*)((ptr) + 192 + 8 * l), X##n1 = *(const LAS f32x4*)((ptr) + 196 + 8 * l), \
                X##a0 = *(const LAS f32x4*)((ptr) + 256 + 8 * l), X##a1 = *(const LAS f32x4*)((ptr) + 260 + 8 * l); const float X##v = (ptr)[320 + row]
#define RW_LDV(X, ptr) f32x4 X##r0 = *(const LAS f32x4*)((ptr) + 8 * l), X##r1 = *(const LAS f32x4*)((ptr) + 8 * l + 4), X##w0 = *(const LAS f32x4*)((ptr) + 64 + 8 * l), X##w1 = *(const LAS f32x4*)((ptr) + 68 + 8 * l), \
                X##k0 = *(const LAS f32x4*)((ptr) + 128 + 8 * l), X##k1 = *(const LAS f32x4*)((ptr) + 132 + 8 * l), X##n0 = *(const LAS f32x4*)((ptr) + 192 + 8 * l), X##n1 = *(const LAS f32x4*)((ptr) + 196 + 8 * l), \
                X##a0 = *(const LAS f32x4*)((ptr) + 256 + 8 * l), X##a1 = *(const LAS f32x4*)((ptr) + 260 + 8 * l); float X##v = (ptr)[320 + row]
#define RW_LDA(X, ptr) do { X##r0 = *(const LAS f32x4*)((ptr) + 8 * l); X##r1 = *(const LAS f32x4*)((ptr) + 8 * l + 4); X##w0 = *(const LAS f32x4*)((ptr) + 64 + 8 * l); X##w1 = *(const LAS f32x4*)((ptr) + 68 + 8 * l); \
                X##k0 = *(const LAS f32x4*)((ptr) + 128 + 8 * l); X##k1 = *(const LAS f32x4*)((ptr) + 132 + 8 * l); X##n0 = *(const LAS f32x4*)((ptr) + 192 + 8 * l); X##n1 = *(const LAS f32x4*)((ptr) + 196 + 8 * l); \
                X##a0 = *(const LAS f32x4*)((ptr) + 256 + 8 * l); X##a1 = *(const LAS f32x4*)((ptr) + 260 + 8 * l); X##v = (ptr)[320 + row]; } while (0)
#define RW_STEP(X, ssv) do { \
                const f32x2_ nn[4] = {X##n0.xy, X##n0.zw, X##n1.xy, X##n1.zw}, ww[4] = {X##w0.xy, X##w0.zw, X##w1.xy, X##w1.zw}, aa[4] = {X##a0.xy, X##a0.zw, X##a1.xy, X##a1.zw}; \
                const f32x2_ kq[4] = {X##k0.xy, X##k0.zw, X##k1.xy, X##k1.zw}, rr[4] = {X##r0.xy, X##r0.zw, X##r1.xy, X##r1.zw}; \
                const f32x2_ sp2 = (S[0] * nn[0] + S[1] * nn[1]) + (S[2] * nn[2] + S[3] * nn[3]); \
                float sa = sp2.x + sp2.y; sa = allred8(sa); \
                _Pragma("unroll") for (int j = 0; j < 4; ++j) S[j] = S[j] * ww[j] + (aa[j] * sa + kq[j] * X##v); \
                const f32x2_ yp2 = (S[0] * rr[0] + S[1] * rr[1]) + (S[2] * rr[2] + S[3] * rr[3]); \
                float y = yp2.x + yp2.y; y = allred8(y); ycap = (l == (ssv)) ? y : ycap; } while (0)
            RW_LDV(A0_, sp);
            for (int s0 = 0; s0 < nsteps; s0 += 8) {
                float ycap = 0.f;
#define SB_ __builtin_amdgcn_sched_barrier(0);
                { RW_LD(B_, sp + 384); SB_ RW_STEP(A0_, 0); SB_ RW_LD(A_, sp + 768); SB_ RW_STEP(B_, 1); SB_
                  RW_LD(B2_, sp + 1152); SB_ RW_STEP(A_, 2); SB_ RW_LD(A2_, sp + 1536); SB_ RW_STEP(B2_, 3); SB_
                  RW_LD(B3_, sp + 1920); SB_ RW_STEP(A2_, 4); SB_ RW_LD(A3_, sp + 2304); SB_ RW_STEP(B3_, 5); SB_
                  RW_LD(B4_, sp + 2688); SB_ RW_STEP(A3_, 6); SB_ RW_LDA(A0_, sp + 3072); SB_ RW_STEP(B4_, 7); SB_ }
#undef SB_
                sp += 8 * 384;
                yp[(size_t)s0 * 1024] = ycap;
            }
#undef RW_LD
#undef RW_LDV
#undef RW_LDA
#undef RW_STEP
            __syncthreads();
        }
        __builtin_amdgcn_s_setprio(0);
        GAS float* So = p.out + O_RP + ((((size_t)e * NB + b) * 8 + h) * 64 + row) * 64 + 8 * l;
        *(GAS f32x4*)So = (f32x4){S[0].x, S[0].y, S[1].x, S[1].y}; *(GAS f32x4*)(So + 4) = (f32x4){S[2].x, S[2].y, S[3].x, S[3].y};
    }
}

__device__ __forceinline__ unsigned short f2bf_c(float x) { unsigned u = __float_as_uint(x); u += 0x7fffu + ((u >> 16) & 1u); return (unsigned short)(u >> 16); }
__device__ __forceinline__ unsigned pkc(float lo, float hi) { return (unsigned)f2bf_c(lo) | ((unsigned)f2bf_c(hi) << 16); }
template <bool GLA>
__device__ __forceinline__ void gla_mfma_scan(const Ctx& p, int o, int bh, int part, LAS unsigned char* lds) {
    constexpr int DV = GLA ? 256 : 128, LDP = GLA ? OPROJ : EPROJ, QS = 136  , TS = 40  ;
    constexpr int OFF_QD = 0, OFF_KD = 32 * QS * 2, OFF_KDT = 2 * 32 * QS * 2, OFF_VT = OFF_KDT + 128 * TS * 2, OFF_EL = OFF_VT + 32 * TS * 2, STG = OFF_EL + 512;
    constexpr int OFF_SB = 2 * STG, SBB = 8192;
    constexpr float SC = 0.08838834764831845f;
    const int tid = p.tid, lane = tid & 63, w = tid >> 6, b = bh >> 2, h = bh & 3, colbase = part * 32;
    GAS unsigned char* ws = p.ws;
    const GAS bf16_t* proj = (const GAS bf16_t*)(ws + WS_PROJ); GAS float* oraw = (GAS float*)(ws + WS_ORAW);
    const int kk = lane & 15, tq = lane >> 4, k = 16 * w + kk;
    const int vv = tid & 31, sg = tid >> 5;
    const int r16 = lane & 15, quad = lane >> 4;
    f32x4 S0 = {0.f, 0.f, 0.f, 0.f}, S1 = {0.f, 0.f, 0.f, 0.f};
    u32x4 Aq, Ak, At, Bq, Bk, Bt; unsigned Av0, Av1, Bv0, Bv1; float Ael, Bel;
    const GAS bf16_t* QDg = (const GAS bf16_t*)(ws + WS_MIXB); const GAS bf16_t* KDg = QDg + (size_t)MT * 512; const GAS bf16_t* KDTg = (const GAS bf16_t*)(ws + WS_KDT); const GAS float* ELg = (const GAS float*)(ws + WS_ELG);
    const int tr = tid >> 4, c8 = (tid & 15) * 8, kq = tid >> 2, ps = tid & 3;
#define GM_LOAD(X, cc) do { const size_t r0_ = (size_t)b * TP + (size_t)(cc) * 32;   \
        X##q = *(const GAS u32x4*)(QDg + (r0_ + tr) * 512 + h * 128 + c8); X##k = *(const GAS u32x4*)(KDg + (r0_ + tr) * 512 + h * 128 + c8); \
        X##t = *(const GAS u32x4*)(KDTg + ((((size_t)b * 65 + (cc)) * 512 + h * 128 + kq) * 32 + ps * 8)); \
        const GAS bf16_t* pv_ = proj + (r0_ + 2 * sg) * LDP + 1024 + h * DV + colbase + vv; X##v0 = (unsigned)pv_[0]; X##v1 = (unsigned)pv_[LDP]; \
        X##el = ELg[((size_t)b * 65 + (cc)) * 512 + h * 128 + (tid & 127)]; } while (0)
#define GM_STAGE(X, cc) do { LAS unsigned char* sb_ = lds + ((cc) & 1) * STG; const u32x4 z_ = {0u, 0u, 0u, 0u}; \
        const bool okr_ = (cc) * 32 + tr < TP, okt_ = (cc) * 32 + ps * 8 < TP; \
        *(LAS u32x4*)(sb_ + OFF_QD + (tr * QS + c8) * 2) = okr_ ? X##q : z_; *(LAS u32x4*)(sb_ + OFF_KD + (tr * QS + c8) * 2) = okr_ ? X##k : z_; \
        *(LAS u32x4*)(sb_ + OFF_KDT + (kq * TS + ps * 8) * 2) = okt_ ? X##t : z_; \
        const unsigned va_ = ((cc) * 32 + 2 * sg < TP) ? X##v0 : 0u, vb_ = ((cc) * 32 + 2 * sg + 1 < TP) ? X##v1 : 0u; \
        *(LAS unsigned*)(sb_ + OFF_VT + (vv * TS + 2 * sg) * 2) = GLA ? (va_ | (vb_ << 16)) : pk2(siluf_(bflo(va_)), siluf_(bflo(vb_))); \
        if (tid < 128) *(LAS float*)(sb_ + OFF_EL + tid * 4) = X##el; } while (0)
#define MFMA16(a, b, c) __builtin_amdgcn_mfma_f32_16x16x32_bf16((a), (b), (c), 0, 0, 0)
    auto chunk = [&](const int c) {
        LAS unsigned char* sb = lds + (c & 1) * STG; LAS unsigned char* sbS = lds + OFF_SB + (c & 1) * SBB;
        if (w < 4) {
            const int tt = w >> 1, vt = w & 1;
            f32x4 sc0 = {0.f, 0.f, 0.f, 0.f}, sc1 = {0.f, 0.f, 0.f, 0.f};
#pragma unroll
            for (int ks = 0; ks < 4; ++ks) {
                const bf16x8 bq = *(const LAS bf16x8*)(sb + OFF_QD + ((tt * 16 + r16) * QS + ks * 32 + quad * 8) * 2);
                const bf16x8 a0 = *(const LAS bf16x8*)(sb + OFF_KD + ((r16) * QS + ks * 32 + quad * 8) * 2);
                sc0 = MFMA16(a0, bq, sc0);
                if (tt == 1) { const bf16x8 a1 = *(const LAS bf16x8*)(sb + OFF_KD + ((16 + r16) * QS + ks * 32 + quad * 8) * 2); sc1 = MFMA16(a1, bq, sc1); }
            }
            const int s0 = quad * 4;
            f32x4 dg = tt ? sc1 : sc0;
            dg.x = (s0 + 0 <= r16) ? dg.x : 0.f; dg.y = (s0 + 1 <= r16) ? dg.y : 0.f; dg.z = (s0 + 2 <= r16) ? dg.z : 0.f; dg.w = (s0 + 3 <= r16) ? dg.w : 0.f;
            const f32x4 lo = tt ? sc0 : dg, hi = tt ? dg : (f32x4){0.f, 0.f, 0.f, 0.f};
            const u32x4 au = {pkc(lo.x, lo.y), pkc(lo.z, lo.w), pkc(hi.x, hi.y), pkc(hi.z, hi.w)};
            const u32x2 v0 = *(const LAS u32x2*)(sb + OFF_VT + ((vt * 16 + r16) * TS + quad * 4) * 2), v1 = *(const LAS u32x2*)(sb + OFF_VT + ((vt * 16 + r16) * TS + 16 + quad * 4) * 2);
            f32x4 oacc = MFMA16(__builtin_bit_cast(bf16x8, au), __builtin_bit_cast(bf16x8, ((u32x4){v0.x, v0.y, v1.x, v1.y})), ((f32x4){0.f, 0.f, 0.f, 0.f}));
#pragma unroll
            for (int ks = 0; ks < 4; ++ks) {
                const u32x2 q0 = *(const LAS u32x2*)(sb + OFF_QD + ((tt * 16 + r16) * QS + ks * 32 + quad * 4) * 2), q1 = *(const LAS u32x2*)(sb + OFF_QD + ((tt * 16 + r16) * QS + ks * 32 + 16 + quad * 4) * 2);
                const u32x2 t0 = *(const LAS u32x2*)(sbS + ((vt * 8 + 2 * ks) * 64 + lane) * 8), t1 = *(const LAS u32x2*)(sbS + ((vt * 8 + 2 * ks + 1) * 64 + lane) * 8);
                oacc = MFMA16(__builtin_bit_cast(bf16x8, ((u32x4){q0.x, q0.y, q1.x, q1.y})), __builtin_bit_cast(bf16x8, ((u32x4){t0.x, t0.y, t1.x, t1.y})), oacc);
            }
            const float ov[4] = {oacc.x, oacc.y, oacc.z, oacc.w};
#pragma unroll
            for (int j = 0; j < 4; ++j) { const int tok = c * 32 + tt * 16 + quad * 4 + j; if (tok < TP) oraw[((size_t)b * TP + tok) * 1024 + h * DV + colbase + vt * 16 + r16] = ov[j]; }
        }
        {
            const bf16x8 ak = *(const LAS bf16x8*)(sb + OFF_KDT + ((16 * w + r16) * TS + quad * 8) * 2);
            const bf16x8 b0 = *(const LAS bf16x8*)(sb + OFF_VT + ((r16) * TS + quad * 8) * 2), b1 = *(const LAS bf16x8*)(sb + OFF_VT + ((16 + r16) * TS + quad * 8) * 2);
            S0 = MFMA16(ak, b0, S0); S1 = MFMA16(ak, b1, S1);
            const f32x4 el = *(const LAS f32x4*)(sb + OFF_EL + (16 * w + quad * 4) * 4);
            S0 = S0 * el; S1 = S1 * el;
        }
    };
    auto publish = [&](const int c) {
        LAS unsigned char* sbS = lds + OFF_SB + (c & 1) * SBB;
        *(LAS u32x2*)(sbS + ((0 * 8 + w) * 64 + lane) * 8) = (u32x2){pkc(S0.x, S0.y), pkc(S0.z, S0.w)};
        *(LAS u32x2*)(sbS + ((1 * 8 + w) * 64 + lane) * 8) = (u32x2){pkc(S1.x, S1.y), pkc(S1.z, S1.w)};
    };
    __syncthreads();
    GM_LOAD(A, 0); GM_STAGE(A, 0); GM_LOAD(B, 1);
    for (int c = 0; c < NCH; c += 2) {
        publish(c);
        __syncthreads();
        if (c + 2 < NCH) GM_LOAD(A, c + 2);
        chunk(c);
        if (c + 1 < NCH) {
            GM_STAGE(B, c + 1);
            publish(c + 1);
            __syncthreads();
            if (c + 3 < NCH) GM_LOAD(B, c + 3);
            chunk(c + 1);
            if (c + 2 < NCH) GM_STAGE(A, c + 2);
        }
    }
#undef GM_LOAD
#undef GM_STAGE
#undef MFMA16
    GAS float* So = p.out + (GLA ? O_GP : O_HP) + ((((size_t)o * NB + b) * 4 + h) * 128 + 16 * w + quad * 4) * DV + colbase + r16;
    So[0 * DV] = S0.x; So[1 * DV] = S0.y; So[2 * DV] = S0.z; So[3 * DV] = S0.w;
    So[0 * DV + 16] = S1.x; So[1 * DV + 16] = S1.y; So[2 * DV + 16] = S1.z; So[3 * DV + 16] = S1.w;
}

__device__ __forceinline__ void phase_scan_even(const Ctx& p, int e, LAS unsigned char* lds) {
    const int G = p.G;
    const int sfirst = G > 128 ? 128 : 0, sstride = G - sfirst;
    for (int r = 0; r < (((p.probe >> 11) & 1) ? 2 : 1); ++r)
    for (int task = p.bid - sfirst; task >= 0 && task < 512 + 1024; task += sstride) {
        if (task < 512) glalike_sample<false>(p, e, task >> 2, task & 3, lds);
        else rwkv_sample(p, e, (task - 512) >> 3, (task - 512) & 7, lds);
    }
    for (int task = p.bid; task < 256; task += G) {
        if (task < 128) rwkv_prompt_scan(p, e, task >> 1, task & 1, lds);
        else gla_mfma_scan<false>(p, e, (task - 128) >> 2, (task - 128) & 3, lds);
    }
}
__device__ __forceinline__ void phase_scan_odd(const Ctx& p, int o, LAS unsigned char* lds) {
    const int G = p.G;
    for (int r = 0; r < (((p.probe >> 11) & 1) ? 2 : 1); ++r)
    for (int task = p.bid; task < 512; task += G) glalike_sample<true>(p, o, task >> 2, task & 3, lds);
    for (int task = p.bid; task < 256; task += G) gla_mfma_scan<true>(p, o, task >> 3, task & 7, lds);
}

__device__ __forceinline__ void phase_post_even(const Ctx& p, int e) {
    const int tid = p.tid, lane = tid & 63, wave = tid >> 6;
    GAS unsigned char* ws = p.ws;
    const GAS bf16_t* proj = (const GAS bf16_t*)(ws + WS_PROJ); const GAS float* oraw = (const GAS float*)(ws + WS_ORAW); const GAS bf16_t* lraw = (const GAS bf16_t*)(ws + WS_LRAW);
    const GAS float* bsum = (const GAS float*)(ws + WS_BSUM); GAS bf16_t* mixb = (GAS bf16_t*)(ws + WS_MIXB);
    const int c = lane * 8;
    const GAS float* hn = p.in(I_HNORM) + e * 512 + c; const GAS float* lw = p.in(I_LNW) + e * 512 + c; const GAS float* lbi = p.in(I_LNB) + e * 512 + c;
    const GAS float* mu = p.in(I_MU) + (size_t)e * 1792 + 1024 + c;
    for (int m = p.bid * NWAVES + wave; m < MT; m += p.G * NWAVES) {
        {
            const f32x4 o0 = *(const GAS f32x4*)(oraw + (size_t)m * 1024 + c), o1 = *(const GAS f32x4*)(oraw + (size_t)m * 1024 + c + 4);
            const u32x4 gu = *(const GAS u32x4*)(proj + (size_t)m * EPROJ + 1536 + c);
            float z[8] = {o0.x, o0.y, o0.z, o0.w, o1.x, o1.y, o1.z, o1.w};
            const float ga[8] = {bflo(gu.x), bfhi(gu.x), bflo(gu.y), bfhi(gu.y), bflo(gu.z), bfhi(gu.z), bflo(gu.w), bfhi(gu.w)};
            float ss = 0.f;
#pragma unroll
            for (int j = 0; j < 8; ++j) { z[j] *= sigmoidf_(ga[j]); ss += z[j] * z[j]; }
            ss = wave_sum(ss); const float rs = rsqrtf(ss * (1.0f / 512.0f) + 1e-6f);
            u32x4 w; w.x = pk2(z[0] * rs * hn[0], z[1] * rs * hn[1]); w.y = pk2(z[2] * rs * hn[2], z[3] * rs * hn[3]);
            w.z = pk2(z[4] * rs * hn[4], z[5] * rs * hn[5]); w.w = pk2(z[6] * rs * hn[6], z[7] * rs * hn[7]);
            *(GAS u32x4*)(mixb + (size_t)m * 1024 + c) = w;
        }
        {
            const f32x4 y0 = *(const GAS f32x4*)(oraw + (size_t)m * 1024 + 512 + c), y1 = *(const GAS f32x4*)(oraw + (size_t)m * 1024 + 512 + c + 4);
            float y[8] = {y0.x, y0.y, y0.z, y0.w, y1.x, y1.y, y1.z, y1.w};
            float s1 = 0.f;
#pragma unroll
            for (int j = 0; j < 8; ++j) s1 += y[j];
            s1 = allred8(s1); const float mean = s1 * (1.0f / 64.0f);
            float s2 = 0.f;
#pragma unroll
            for (int j = 0; j < 8; ++j) { y[j] -= mean; s2 += y[j] * y[j]; }
            s2 = allred8(s2); const float rs = rsqrtf(s2 * (1.0f / 64.0f) + 64e-5f);
            const u32x4 cu = *(const GAS u32x4*)(proj + (size_t)m * EPROJ + 2048 + 1024 + c);
            const float cur[8] = {bflo(cu.x), bfhi(cu.x), bflo(cu.y), bfhi(cu.y), bflo(cu.z), bfhi(cu.z), bflo(cu.w), bfhi(cu.w)};
            float prv[8];
            if (m >= MP) { const GAS float* s = p.in(I_SS) + ((size_t)e * NS + (m - MP)) * 1792 + 1024 + c; const f32x4 a = *(const GAS f32x4*)s, b = *(const GAS f32x4*)(s + 4);
                prv[0] = a.x; prv[1] = a.y; prv[2] = a.z; prv[3] = a.w; prv[4] = b.x; prv[5] = b.y; prv[6] = b.z; prv[7] = b.w; }
            else if ((m % TP) == 0) {
#pragma unroll
                for (int j = 0; j < 8; ++j) prv[j] = 0.f; }
            else { const u32x4 pu = *(const GAS u32x4*)(proj + (size_t)(m - 1) * EPROJ + 2048 + 1024 + c);
                prv[0] = bflo(pu.x); prv[1] = bfhi(pu.x); prv[2] = bflo(pu.y); prv[3] = bfhi(pu.y); prv[4] = bflo(pu.z); prv[5] = bfhi(pu.z); prv[6] = bflo(pu.w); prv[7] = bfhi(pu.w); }
            const float bonus = bsum[(size_t)m * 8 + (lane >> 3)];
            const u32x4 gg = *(const GAS u32x4*)(lraw + (size_t)m * 1536 + 1024 + c);
            const float g[8] = {bflo(gg.x), bfhi(gg.x), bflo(gg.y), bfhi(gg.y), bflo(gg.z), bfhi(gg.z), bflo(gg.w), bfhi(gg.w)};
            float ob[8];
#pragma unroll
            for (int j = 0; j < 8; ++j) { const float v = cur[j] + (prv[j] - cur[j]) * mu[j]; ob[j] = (y[j] * rs * lw[j] + lbi[j] + bonus * v) * g[j]; }
            u32x4 w; w.x = pk2(ob[0], ob[1]); w.y = pk2(ob[2], ob[3]); w.z = pk2(ob[4], ob[5]); w.w = pk2(ob[6], ob[7]);
            *(GAS u32x4*)(mixb + (size_t)m * 1024 + 512 + c) = w;
        }
    }
}
__device__ __forceinline__ void phase_post_odd(const Ctx& p, int o) {
    const int tid = p.tid, lane = tid & 63, wave = tid >> 6;
    GAS unsigned char* ws = p.ws;
    const GAS bf16_t* proj = (const GAS bf16_t*)(ws + WS_PROJ); const GAS float* oraw = (const GAS float*)(ws + WS_ORAW); GAS bf16_t* mixb = (GAS bf16_t*)(ws + WS_MIXB);
    const f32x4 gn = *(const GAS f32x4*)(p.in(I_GNORM) + o * 256 + 4 * lane);
    for (int m = p.bid * NWAVES + wave; m < MT; m += p.G * NWAVES) {
#pragma unroll
        for (int h = 0; h < 4; ++h) {
            const int c = h * 256 + 4 * lane;
            const f32x4 v = *(const GAS f32x4*)(oraw + (size_t)m * 1024 + c);
            float ss = (v.x * v.x + v.y * v.y) + (v.z * v.z + v.w * v.w); ss = wave_sum(ss);
            const float rs = rsqrtf(ss * (1.0f / 256.0f) + 1e-6f);
            const u32x2 gu = *(const GAS u32x2*)(proj + (size_t)m * OPROJ + 2048 + c);
            u32x2 w; w.x = pk2(v.x * rs * gn.x * siluf_(bflo(gu.x)), v.y * rs * gn.y * siluf_(bfhi(gu.x)));
            w.y = pk2(v.z * rs * gn.z * siluf_(bflo(gu.y)), v.w * rs * gn.w * siluf_(bfhi(gu.y)));
            *(GAS u32x2*)(mixb + (size_t)m * 1024 + c) = w;
        }
    }
}
__device__ __forceinline__ void phase_fix(const Ctx& p, int arg_, int rep_) {
    int sel = arg_ * 2 + (rep_ ? 1 : 0); asm volatile("" : "+s"(sel));
    const int nk = (sel & 2) ? 4 : 11; const float scale = (sel & 1) ? 0.f : ((sel & 2) ? 1.0f : 0.5f);
    const int tid = p.tid, lane = tid & 63, wave = tid >> 6;
    GAS float* xf = (GAS float*)(p.ws + WS_XF); GAS bf16_t* xb = (GAS bf16_t*)(p.ws + WS_XB); GAS float* ssq = (GAS float*)(p.ws + WS_SSQ);
    const GAS float* part = (const GAS float*)(p.ws + WS_PART);
    for (int r = p.bid * NWAVES + wave; r < 256; r += p.G * NWAVES) {
        const int m = MT - 256 + r; float ss = 0.f;
#pragma unroll
        for (int j = 0; j < 4; ++j) {
            const int c = 4 * lane + 256 * j;
            f32x4 a = {0.f, 0.f, 0.f, 0.f};
            for (int k = 0; k < nk; ++k) a = a + *(const GAS f32x4*)(part + ((size_t)k * 256 + r) * 1024 + c);
            f32x4 x = *(const GAS f32x4*)(xf + (size_t)m * D + c); x = x + a * scale;
            *(GAS f32x4*)(xf + (size_t)m * D + c) = x;
            u32x2 w; w.x = pk2(x.x, x.y); w.y = pk2(x.z, x.w); *(GAS u32x2*)(xb + (size_t)m * D + c) = w;
            ss += (x.x * x.x + x.y * x.y) + (x.z * x.z + x.w * x.w);
        }
        ss = wave_sum(ss);
        if (lane < 16) ssq[(size_t)m * 16 + lane] = lane == 0 ? ss : 0.f;
        if (lane == 0) ((GAS float*)(p.ws + WS_RSTD))[m] = rsqrtf(ss * (1.0f / 1024.0f) + 1e-6f);
    }
    for (int m = p.bid * NTHREADS + tid; m < MT - 256; m += p.G * NTHREADS) ((GAS float*)(p.ws + WS_RSTD))[m] = rstd_of(ssq, m);
}
__device__ __forceinline__ void phase_final(const Ctx& p) {
    const int tid = p.tid, lane = tid & 63, wave = tid >> 6;
    const GAS bf16_t* xb = (const GAS bf16_t*)(p.ws + WS_XB); const GAS float* ssq = (const GAS float*)(p.ws + WS_SSQ);
    for (int m = p.bid * NWAVES + wave; m < MT; m += p.G * NWAVES) {
        GAS float* dst;
        if (m < MP) { const int b = m / TP, t = m % TP; if (t < 16) continue; dst = p.out + O_YP + ((size_t)b * 2048 + (t - 16)) * D; }
        else dst = p.out + O_YS + (size_t)(m - MP) * D;
        const float rs = rstd_of(ssq, m);
#pragma unroll
        for (int j = 0; j < 4; ++j) {
            const int c = 4 * lane + 256 * j; const u32x2 xo = *(const GAS u32x2*)(xb + (size_t)m * D + c); const f32x4 x = {bflo(xo.x), bfhi(xo.x), bflo(xo.y), bfhi(xo.y)}, g = *(const GAS f32x4*)(p.in(I_FNORM) + c);
            *(GAS f32x4*)(dst + c) = x * rs * g;
        }
    }
}

#define XB_TMO      128
#define XB_XCNT(j)  (256  + 64 * (j))
#define XB_XSUB(j)  (1280 + 64 * (j))
#define XB_XGEN(j)  (2304 + 64 * (j))
#define XB_TOP      3328
#define XB_TOPGEN   3392
#define XCD_BAR_WORDS 3456
#define XB_SPIN_CAP (1u << 22)
__device__ __forceinline__ unsigned xb_ld(unsigned* p)              { return __hip_atomic_load(p, __ATOMIC_RELAXED, __HIP_MEMORY_SCOPE_AGENT); }
__device__ __forceinline__ unsigned xb_add(unsigned* p, unsigned v) { return __hip_atomic_fetch_add(p, v, __ATOMIC_RELAXED, __HIP_MEMORY_SCOPE_AGENT); }
__device__ __forceinline__ unsigned xb_xcc_id() { return (unsigned)__builtin_amdgcn_s_getreg((3 << 11) | 20) & 0xFu; }
#define XB_SPIN(cond, bar) do { unsigned _sp = 0; while (cond) { __builtin_amdgcn_s_sleep(1); \
    if ((++_sp & 255u) == 0u) { if (xb_ld(&(bar)[XB_TMO])) break; if (_sp > XB_SPIN_CAP) { atomicAdd(&(bar)[XB_TMO], 1u); break; } } } } while (0)
struct XcdBarrier { unsigned* bar; unsigned x; volatile LAS unsigned* st; };
__device__ __forceinline__ void xcd_barrier_complete(unsigned* bar, unsigned x, unsigned G, unsigned& nloc, unsigned& nx) {
    unsigned sum, cnt, mine, sp = 0u;
    for (;;) {
        sum = 0u; cnt = 0u; mine = 0u;
#pragma unroll
        for (unsigned j = 0; j < 16; ++j) { const unsigned c = xb_ld(&bar[XB_XCNT(j)]); sum += c; cnt += (c > 0u) ? 1u : 0u; mine = (j == x) ? c : mine; }
        if (sum == G) break;
        __builtin_amdgcn_s_sleep(1);
        if ((++sp & 255u) == 0u) { if (xb_ld(&bar[XB_TMO])) break; if (sp > XB_SPIN_CAP) { atomicAdd(&bar[XB_TMO], 1u); break; } }
    }
    nloc = mine > 0u ? mine : 1u; nx = cnt > 0u ? cnt : 1u;
}
__device__ __forceinline__ void xcd_barrier(const XcdBarrier& b, int tid, unsigned G) {
    asm volatile("s_waitcnt vmcnt(0)" ::: "memory");
    __syncthreads();
    if (tid == 0) {
        unsigned* bar = b.bar;
        __builtin_amdgcn_s_waitcnt(0);
        unsigned nloc = b.st[0], nx = b.st[1];
        if (nloc == 0u) { xcd_barrier_complete(bar, b.x, G, nloc, nx); b.st[0] = nloc; b.st[1] = nx; }
        const unsigned old = xb_add(&bar[XB_XSUB(b.x)], 1u);
        const unsigned gen = old / nloc;
        if (old + 1u == (gen + 1u) * nloc) {
            __builtin_amdgcn_fence(__ATOMIC_RELEASE, "agent");
            asm volatile("s_waitcnt vmcnt(0)" ::: "memory");
            const unsigned og = xb_add(&bar[XB_TOP], 1u);
            const unsigned tg = og / nx;
            if (og + 1u == (tg + 1u) * nx) xb_add(&bar[XB_TOPGEN], 1u);
            else XB_SPIN(xb_ld(&bar[XB_TOPGEN]) == tg, bar);
            __builtin_amdgcn_fence(__ATOMIC_ACQUIRE, "agent");
            xb_add(&bar[XB_XGEN(b.x)], 1u);
            asm volatile("s_waitcnt vmcnt(0)" ::: "memory");
        } else {
            XB_SPIN(xb_ld(&bar[XB_XGEN(b.x)]) == gen, bar);
            __builtin_amdgcn_fence(__ATOMIC_ACQUIRE, "agent");
            asm volatile("s_waitcnt vmcnt(0)" ::: "memory");
        }
    }
    __syncthreads();
}

#define TAILCNT(ph, pn) (3520 + (ph) * 4 + (pn))
__device__ __forceinline__ void tail_fixup(const Ctx& p, int ph, int nk, float scale) {
    const int tid = p.tid, lane = tid & 63, wave = tid >> 6, nmain = 64 * 4, ntail = 4 * nk;
    unsigned* bar = (unsigned*)(unsigned char*)(p.ws + WS_BAR);
    GAS float* xf = (GAS float*)(p.ws + WS_XF); GAS bf16_t* xb = (GAS bf16_t*)(p.ws + WS_XB); GAS float* ssq = (GAS float*)(p.ws + WS_SSQ);
    const GAS float* part = (const GAS float*)(p.ws + WS_PART);
    for (int L = p.bid; L < nmain + ntail; L += p.G) {
        if (L < nmain) continue;
        const int j = L - nmain, pn = j % 4, kc = j / 4;
        asm volatile("s_waitcnt vmcnt(0)" ::: "memory");
        __syncthreads();
        if (tid == 0) {
            __builtin_amdgcn_fence(__ATOMIC_RELEASE, "agent");
            asm volatile("s_waitcnt vmcnt(0)" ::: "memory");
            (void)xb_add(&bar[TAILCNT(ph, pn)], 1u);
            XB_SPIN(xb_ld(&bar[TAILCNT(ph, pn)]) < (unsigned)nk, bar);
            __builtin_amdgcn_fence(__ATOMIC_ACQUIRE, "agent");
            asm volatile("s_waitcnt vmcnt(0)" ::: "memory");
        }
        __syncthreads();
        const int r_lo = (kc * 256) / nk, r_hi = ((kc + 1) * 256) / nk, c4 = pn * 256 + 4 * lane;
        for (int r = r_lo + wave; r < r_hi; r += NWAVES) {
            const int m = MT - 256 + r;
            f32x4 sl[11];
#pragma unroll
            for (int k = 0; k < 11; ++k) sl[k] = (k < nk) ? *(const GAS f32x4*)(part + ((size_t)k * 256 + r) * 1024 + c4) : (f32x4){0.f, 0.f, 0.f, 0.f};
            f32x4 a = sl[0];
#pragma unroll
            for (int k = 1; k < 11; ++k) a = a + sl[k];
            const u32x2 xo = *(const GAS u32x2*)(xb + (size_t)m * D + c4); f32x4 x = {bflo(xo.x), bfhi(xo.x), bflo(xo.y), bfhi(xo.y)}; x = x + a * scale;
            u32x2 w; w.x = pk2(x.x, x.y); w.y = pk2(x.z, x.w); *(GAS u32x2*)(xb + (size_t)m * D + c4) = w;
            float ss = (x.x * x.x + x.y * x.y) + (x.z * x.z + x.w * x.w); ss = wave_sum(ss);
            if (lane < 4) ssq[(size_t)m * 16 + pn * 4 + lane] = lane == 0 ? ss : 0.f;
        }
    }
}

__global__ void __launch_bounds__(NTHREADS, 2) mega_fwd(Params pp) {
    extern __shared__ __attribute__((aligned(16))) unsigned char shm[];
    LAS unsigned char* lds = (LAS unsigned char*)shm;
    cg::grid_group grid = cg::this_grid();
    if (threadIdx.x < N_IN) {
        const unsigned long long v = (unsigned long long)pp.in[threadIdx.x];
        LAS unsigned* t = (LAS unsigned*)(lds + TAB_OFF) + 2 * threadIdx.x; t[0] = (unsigned)v; t[1] = (unsigned)(v >> 32);
    }
    #define MK_GBAR() XcdBarrier gbar; gbar.bar = (unsigned*)(pp.ws + WS_BAR); gbar.x = xb_xcc_id(); gbar.st = (volatile LAS unsigned*)(lds + TAB_OFF + 320)
    if (threadIdx.x == 0) { MK_GBAR(); gbar.st[0] = 0u; gbar.st[1] = 0u; (void)xb_add(&gbar.bar[XB_XCNT(gbar.x)], 1u); }
    __syncthreads();
    const int wave_s = __builtin_amdgcn_readfirstlane((int)(threadIdx.x >> 6));
    for (int ph = pp.ph_lo; ph < pp.ph_hi; ++ph) {
        const int kind = PROG[ph][0], arg = PROG[ph][1];
        const int nrep = (((pp.probe_mask >> kind) & 1) || (kind == K_SCAN && (arg & 1) && ((pp.probe_mask >> 12) & 1))) ? 2 : 1;
        for (int rep = 0; rep < nrep; ++rep) {
        int lane_l; asm volatile("v_mbcnt_lo_u32_b32 %0, -1, 0\n\tv_mbcnt_hi_u32_b32 %0, -1, %0" : "=v"(lane_l));
        int tid = wave_s * 64 + lane_l, bid = blockIdx.x; unsigned char* ws_ = pp.ws; float* outp_ = pp.out; LAS unsigned char* ldsl = lds;
        asm volatile("" : "+v"(tid)); asm volatile("" : "+s"(bid)); asm volatile("" : "+s"(ws_)); asm volatile("" : "+s"(outp_)); asm volatile("" : "+s"(ldsl));
        GAS unsigned char* ws = (GAS unsigned char*)ws_; GAS float* outp = (GAS float*)outp_;
        Ctx p; p.lds = ldsl; p.out = outp; p.ws = ws; p.tid = tid; p.bid = bid; p.G = gridDim.x; p.probe = pp.probe_mask;
        if (rep) { MK_GBAR(); xcd_barrier(gbar, tid, (unsigned)gridDim.x); }
        GAS bf16_t* xb = (GAS bf16_t*)(ws + WS_XB); GAS float* xf = (GAS float*)(ws + WS_XF); GAS float* ssq = (GAS float*)(ws + WS_SSQ);
        GAS bf16_t* projb = (GAS bf16_t*)(ws + WS_PROJ);
        if (kind == K_P0) phase_p0(p, ldsl);
        else if (kind == K_GU || kind == K_DN || kind == K_OUT || kind == K_IN || kind == K_LORA) {
            pg8::Gemm g; Epi E; E.ws = ws; E.scale = 1.0f; E.ldo = 0;
            if (kind == K_GU) { g = pg8::Gemm{xb, (const GAS bf16_t*)(ws + WS_WGU) + (size_t)arg * 5632 * 1024, MT, 5632, 1024}; E.mode = 0; }
            else if (kind == K_DN) { g = pg8::Gemm{projb, (const GAS bf16_t*)(ws + WS_WD) + (size_t)arg * 1024 * FF, MT, 1024, FF}; E.mode = 1; E.scale = rep ? 0.f : 0.5f; }
            else if (kind == K_OUT) { g = pg8::Gemm{(const GAS bf16_t*)(ws + WS_MIXB), (const GAS bf16_t*)(ws + WS_WOUT) + (size_t)arg * D * D, MT, 1024, 1024}; E.mode = 1; E.scale = rep ? 0.f : 1.0f; }
            else if (kind == K_IN) { const int odd = arg & 1, idx = arg >> 1;
                g = pg8::Gemm{xb, odd ? (const GAS bf16_t*)(ws + WS_WINO) + (size_t)idx * OPROJ * 1024 : (const GAS bf16_t*)(ws + WS_WINE) + (size_t)idx * EPROJ * 1024, MT, odd ? OPROJ : EPROJ, 1024};
                E.mode = 2; E.ldo = odd ? OPROJ : EPROJ; }
            else { g = pg8::Gemm{(const GAS bf16_t*)(ws + WS_LIN), (const GAS bf16_t*)(ws + WS_WLORA) + (size_t)(arg >> 1) * 1536 * 256, MT, 1536, 256}; E.mode = 3; E.ldo = 1536; }
            pg8::StaticOrder S; S.init(g.M, g.N, g.K, p.G, bid, E.mode == 1);
            pg8::gemm_phase(ldsl, g, S, E, tid);
            if (E.mode == 1) tail_fixup(p, ph, g.K / 256, E.scale);
        } else if (kind == K_LIN) { phase_fprep(p, arg & 1, arg >> 1); if (!(arg & 1)) phase_lin(p, arg >> 1); }
        else if (kind == K_SCAN) { if (arg & 1) phase_scan_odd(p, arg >> 1, ldsl); else phase_scan_even(p, arg >> 1, ldsl); }
        else if (kind == K_FIX) phase_fix(p, arg, rep);
        else if (kind == K_POST) { if (arg & 1) phase_post_odd(p, arg >> 1); else phase_post_even(p, arg >> 1); }
        else phase_final(p);
        }
        if (ph + 1 < pp.ph_hi) { if (pp.ph_lo < 0) grid.sync();   else { MK_GBAR(); int lane_b; asm volatile("v_mbcnt_lo_u32_b32 %0, -1, 0\n\tv_mbcnt_hi_u32_b32 %0, -1, %0" : "=v"(lane_b)); xcd_barrier(gbar, wave_s * 64 + lane_b, (unsigned)gridDim.x); } }
    }
}

extern "C" void kernel_launch(void* const* d_in, const int* in_sizes, int n_in, void* d_out, int out_size, void* d_ws, size_t ws_size, hipStream_t stream) {
    static int grid_blocks = 0;
    if (grid_blocks == 0) {
        if (n_in != N_IN || (size_t)out_size != O_END || ws_size < WS_END) {
            fprintf(stderr, "kernel_launch: unexpected shapes: n_in %d out %d ws %zu (need %zu)\n", n_in, out_size, ws_size, (size_t)WS_END);
            grid_blocks = -1; return;
        }
        int dev = 0, cus = 0, per_cu = 0;
        hipGetDevice(&dev);
        hipDeviceGetAttribute(&cus, hipDeviceAttributeMultiprocessorCount, dev);
        if (hipFuncSetAttribute((const void*)mega_fwd, hipFuncAttributeMaxDynamicSharedMemorySize, LDS_BYTES) != hipSuccess) fprintf(stderr, "kernel_launch: hipFuncSetAttribute failed\n");
        hipOccupancyMaxActiveBlocksPerMultiprocessor(&per_cu, (const void*)mega_fwd, NTHREADS, LDS_BYTES);
        (void)hipGetLastError();
        if (per_cu < 1) fprintf(stderr, "kernel_launch: occupancy query reports %d blocks per CU\n", per_cu);
        grid_blocks = cus > 0 ? cus : 256;
    }
    if (grid_blocks < 0) return;
    if (hipMemsetAsync((char*)d_ws + WS_BAR, 0, 16384, stream) != hipSuccess) { fprintf(stderr, "kernel_launch: memset failed\n"); return; }
    Params p{};
    for (int i = 0; i < N_IN; ++i) p.in[i] = (const float*)d_in[i];
    p.out = (float*)d_out; p.ws = (unsigned char*)d_ws; p.ph_lo = 0; p.ph_hi = NPHASES; p.probe_mask = PROBE_MASK;
    void* args[] = {&p};
    hipError_t e = hipLaunchCooperativeKernel((const void*)mega_fwd, dim3(grid_blocks), dim3(NTHREADS), args, LDS_BYTES, stream);
    if (e != hipSuccess) fprintf(stderr, "cooperative launch failed: %s (grid %d)\n", hipGetErrorString(e), grid_blocks);
}
```

```cpp
#include <hip/hip_runtime.h>
#include <hip/hip_cooperative_groups.h>
#include <cstdio>
#include <cstdint>
namespace cg = cooperative_groups;

#define LAS __attribute__((address_space(3)))
#define GAS __attribute__((address_space(1)))
typedef unsigned short bf16_t;
typedef short bf16x8 __attribute__((ext_vector_type(8)));
typedef float f32x4 __attribute__((ext_vector_type(4)));
typedef unsigned u32x4 __attribute__((ext_vector_type(4)));
typedef unsigned u32x2 __attribute__((ext_vector_type(2)));
typedef float f32x2_ __attribute__((ext_vector_type(2)));

constexpr int D = 1024, FF = 2816, TP = 2064, NB = 8, NS = 128, MP = NB * TP  , MT = MP + NS  ;
constexpr int EPROJ = 3840, OPROJ = 3328  , OSRC = 3088;
constexpr int NTHREADS = 512, NWAVES = 8;
#define PROBE_MASK 0
constexpr int LDS_BYTES = 131072 + 512;
constexpr int TAB_OFF = 131072;

enum { I_XP = 0, I_XS, I_SH, I_SR, I_SS, I_SG, I_META, I_NF1, I_F1G, I_F1U, I_F1D, I_NMIX, I_EWIN, I_LB, I_HNORM, I_MU, I_W0, I_W2, I_A0, I_A2, I_G2,
       I_KK, I_KA, I_RK, I_LNW, I_LNB, I_EWOUT, I_OWIN, I_GUP, I_GB, I_GNORM, I_OWOUT, I_NF2, I_F2G, I_F2U, I_F2D, I_FNORM, N_IN };

constexpr size_t O_YP = 0, O_YS = 16777216, O_HP = O_YS + 131072, O_RP = O_HP + 1048576, O_SP = O_RP + 524288, O_GP = O_SP + 28672,
                 O_HS = O_GP + 2097152, O_RS = O_HS + 16777216, O_SSH = O_RS + 8388608, O_GS = O_SSH + 458752, O_END = O_GS + 33554432;

constexpr size_t WS_BAR = 0;
constexpr size_t WS_WGU = 16384;
constexpr size_t WS_WD = WS_WGU + (size_t)8 * 5632 * 1024 * 2;
constexpr size_t WS_WINE = WS_WD + (size_t)8 * 1024 * 2816 * 2;
constexpr size_t WS_WINO = WS_WINE + (size_t)2 * EPROJ * 1024 * 2;
constexpr size_t WS_WOUT = WS_WINO + (size_t)2 * OPROJ * 1024 * 2;
constexpr size_t WS_WLORA = WS_WOUT + (size_t)4 * 1024 * 1024 * 2;
constexpr size_t WS_XF = WS_WLORA + (size_t)2 * 1536 * 256 * 2;
constexpr size_t WS_XB = WS_XF + (size_t)MT * 1024 * 4;
constexpr size_t WS_SSQ = WS_XB + (size_t)MT * 1024 * 2;
constexpr size_t WS_PROJ = WS_SSQ + (size_t)MT * 16 * 4;
constexpr size_t WS_LIN = WS_PROJ + (size_t)MT * EPROJ * 2;
constexpr size_t WS_LRAW = WS_LIN + (size_t)MT * 256 * 2;
constexpr size_t WS_ORAW = WS_LRAW + (size_t)MT * 1536 * 2;
constexpr size_t WS_BSUM = WS_ORAW + (size_t)MT * 1024 * 4;
constexpr size_t WS_MIXB = WS_BSUM + (size_t)MT * 8 * 4;
constexpr size_t WS_PART = WS_MIXB + (size_t)MT * 1024 * 2;
constexpr size_t WS_RSTD = WS_PART + (size_t)11 * 256 * 1024 * 4;
constexpr size_t WS_KDT = WS_RSTD + (size_t)MT * 4;
constexpr size_t WS_ELG = WS_KDT + (size_t)8 * 65 * 512 * 32 * 2;
constexpr size_t WS_END = WS_ELG + (size_t)8 * 65 * 512 * 4;

struct Params { const float* in[N_IN]; float* out; unsigned char* ws; int ph_lo, ph_hi, probe_mask, pad_; };
struct Ctx {
    LAS unsigned char* lds; GAS float* out; GAS unsigned char* ws; int tid, bid, G, probe;
    __device__ __forceinline__ const GAS float* in(int i) const {
        const LAS unsigned* t = (const LAS unsigned*)(lds + TAB_OFF) + 2 * i;
        const unsigned lo = __builtin_amdgcn_readfirstlane(t[0]), hi = __builtin_amdgcn_readfirstlane(t[1]);
        return (const GAS float*)(((unsigned long long)hi << 32) | lo);
    }
};

enum { K_P0 = 0, K_GU, K_DN, K_IN, K_LIN, K_LORA, K_SCAN, K_POST, K_OUT, K_FINAL, K_FIX };
constexpr int NPHASES = 40;
__constant__ unsigned char PROG[NPHASES][2] = {
    {K_P0, 0},
    {K_GU, 0}, {K_DN, 0}, {K_IN, 0}, {K_LIN, 0}, {K_LORA, 0}, {K_SCAN, 0}, {K_POST, 0}, {K_OUT, 0}, {K_GU, 1}, {K_DN, 1},
    {K_GU, 2}, {K_DN, 2}, {K_IN, 1}, {K_LIN, 1}, {K_SCAN, 1}, {K_POST, 1}, {K_OUT, 1}, {K_GU, 3}, {K_DN, 3},
    {K_GU, 4}, {K_DN, 4}, {K_IN, 2}, {K_LIN, 2}, {K_LORA, 2}, {K_SCAN, 2}, {K_POST, 2}, {K_OUT, 2}, {K_GU, 5}, {K_DN, 5},
    {K_GU, 6}, {K_DN, 6}, {K_IN, 3}, {K_LIN, 3}, {K_SCAN, 3}, {K_POST, 3}, {K_OUT, 3}, {K_GU, 7}, {K_DN, 7},
    {K_FINAL, 0}};

__device__ __forceinline__ float bf2f(unsigned short b) { return __uint_as_float(((unsigned)b) << 16); }
__device__ __forceinline__ float bflo(unsigned u) { return __uint_as_float(u << 16); }
__device__ __forceinline__ float bfhi(unsigned u) { return __uint_as_float(u & 0xffff0000u); }
__device__ __forceinline__ unsigned pk2(float lo, float hi) { unsigned r; asm volatile("v_cvt_pk_bf16_f32 %0, %1, %2" : "=v"(r) : "v"(lo), "v"(hi)); return r; }
__device__ __forceinline__ float sigmoidf_(float x) { return __builtin_amdgcn_rcpf(1.0f + __expf(-x)); }
__device__ __forceinline__ float siluf_(float x) { return x * __builtin_amdgcn_rcpf(1.0f + __expf(-x)); }
__device__ __forceinline__ float wave_sum(float v) {
#pragma unroll
    for (int o = 1; o < 64; o <<= 1) v += __shfl_xor(v, o);
    return v;
}
template <int CTRL> __device__ __forceinline__ float dppf(float v) { return __int_as_float(__builtin_amdgcn_update_dpp(0, __float_as_int(v), CTRL, 0xF, 0xF, true)); }
__device__ __forceinline__ float allred8(float v) { v += dppf<0xB1>(v); v += dppf<0x4E>(v); v += dppf<0x141>(v); return v; }
__device__ __forceinline__ float allred16(float v) { v = allred8(v); v += dppf<0x140>(v); return v; }
#define LDS_WAIT() asm volatile("s_waitcnt lgkmcnt(0)" ::: "memory")
__device__ __forceinline__ float amul(float a, float b) { float r; asm("v_mul_f32 %0, %1, %2" : "=v"(r) : "v"(a), "v"(b)); return r; }
__device__ __forceinline__ float afma(float a, float b, float c) { float r; asm("v_fma_f32 %0, %1, %2, %3" : "=v"(r) : "v"(a), "v"(b), "v"(c)); return r; }

__device__ __forceinline__ float rstd_of(const GAS float* ssq, int row) {
    const GAS f32x4* p = (const GAS f32x4*)(ssq + (size_t)row * 16);
    const f32x4 a = p[0], b = p[1], c = p[2], d = p[3];
    const float s = ((a.x + a.y) + (a.z + a.w)) + ((b.x + b.y) + (b.z + b.w)) + ((c.x + c.y) + (c.z + c.w)) + ((d.x + d.y) + (d.z + d.w));
    return rsqrtf(s * (1.0f / 1024.0f) + 1e-6f);
}

namespace pg8 {
constexpr int BM = 256, BK = 64, HALF = 128, HTB = HALF * BK * 2, NXCD = 8, WGM = 8;
__device__ __forceinline__ int lds_byte(int r, int c) { const int st = (r >> 4) * 2 + (c >> 5), rr = r & 15, cc = c & 31, ob = rr * 64 + cc * 2; return st * 1024 + (ob ^ (((ob >> 9) & 1) << 5)); }
__device__ __forceinline__ void stage_rc(int b, int& R, int& C) { const int st = b / 1024, sb = b % 1024, swz = sb ^ (((sb >> 9) & 1) << 5); R = (st >> 1) * 16 + swz / 64; C = (st & 1) * 32 + (swz % 64) / 2; }
struct Unit { int pm, pn, k0, nt, kc; };
struct Gemm { const GAS bf16_t* A; const GAS bf16_t* Bt; int M, N, K; };
struct StaticOrder {
    int nM, nN, nwg, G, c, ntK, ntail;
    __device__ __forceinline__ void init(int M, int N, int K, int G_, int c_, int tail) { nM = M / BM - (tail ? 1 : 0); nN = N / BM; nwg = nM * nN; G = G_; c = c_; ntK = K / BK; ntail = tail ? nN * (K / 256) : 0; }
    __device__ __forceinline__ bool next(int i, Unit& u) const {
        const long L = (long)i * G + c; if (L >= nwg + ntail) return false;
        const bool tl = L >= nwg; const int j = tl ? (int)L - nwg : 0;
        int wgid = tl ? 0 : (int)L; { const int q = nwg / NXCD, r = nwg % NXCD, xcd = wgid % NXCD, off = wgid / NXCD; wgid = (xcd < r ? xcd * (q + 1) : r * (q + 1) + (xcd - r) * q) + off; }
        const int nig = WGM * nN, gid = wgid / nig, fm = gid * WGM, gsz = (nM - fm) < WGM ? (nM - fm) : WGM;
        const int pm_ = fm + ((wgid % nig) % gsz), pn_ = (wgid % nig) / gsz, kc_ = j / nN;
        u.pm = tl ? nM : pm_; u.pn = tl ? j % nN : pn_; u.k0 = tl ? kc_ * 256 : 0; u.nt = tl ? 4 : ntK; u.kc = tl ? kc_ : -1;
        return true;
    }
};

template <class Epi>
__device__ __forceinline__ void gemm_phase(LAS unsigned char* lds, const Gemm g, const StaticOrder& S, const Epi& E, const int tid) {
    const int wid = __builtin_amdgcn_readfirstlane(tid >> 6), lane = tid & 63, wr = wid >> 2, wc = wid & 3, fr = lane & 15, fq = lane >> 4;
    const int K = g.K;
    unsigned voffA[2];
#pragma unroll
    for (int i = 0; i < 2; ++i) { int R, C; stage_rc(tid * 16 + i * 8192, R, C); voffA[i] = (unsigned)(R * K + C) * 2u; }
    const size_t kstep = (size_t)(BK * 2);
    const size_t hstep = (size_t)HALF * K * 2;
    const size_t tstep = 2 * hstep;
    const unsigned ldsw = (unsigned)wid * 1024u;
    const int aoff = lds_byte(wr * 64 + fr, fq * 8), boff = lds_byte(wc * 32 + fr, fq * 8);
#define PG8_SA(b, h) (((b) * 2 + (h)) * HTB)
#define PG8_SB(b, h) ((4 + (b) * 2 + (h)) * HTB)
#define PG8_STAGE(bufoff, gbase, voff) do { _Pragma("unroll") for (int _i = 0; _i < 2; ++_i) \
        __builtin_amdgcn_global_load_lds((const unsigned*)((const char*)(gbase) + (voff)[_i]), (LAS unsigned*)(lds + (bufoff) + ldsw + _i * 8192), 16, 0, 0); } while (0)
#define PG8_LDA(dst, b, h) do { _Pragma("unroll") for (int m = 0; m < 4; ++m) _Pragma("unroll") for (int k = 0; k < 2; ++k) dst[m][k] = *(const LAS bf16x8*)(lds + PG8_SA(b, h) + aoff + m * 2048 + k * 1024); } while (0)
#define PG8_LDB(dst, b, h) do { _Pragma("unroll") for (int n = 0; n < 2; ++n) _Pragma("unroll") for (int k = 0; k < 2; ++k) dst[n][k] = *(const LAS bf16x8*)(lds + PG8_SB(b, h) + boff + n * 2048 + k * 1024); } while (0)
#define PG8_MMA(ai, bj, At, Bt) do { __builtin_amdgcn_s_setprio(1); _Pragma("unroll") for (int m = 0; m < 4; ++m) _Pragma("unroll") for (int n = 0; n < 2; ++n) _Pragma("unroll") for (int k = 0; k < 2; ++k) \
        acc[ai][bj][m][n] = __builtin_amdgcn_mfma_f32_16x16x32_bf16(Bt[n][k], At[m][k], acc[ai][bj][m][n], 0, 0, 0); __builtin_amdgcn_s_setprio(0); } while (0)
#define PG8_WAIT_V(n) asm volatile("s_waitcnt vmcnt(" #n ")" ::: "memory")
#define PG8_WAIT_L(n) asm volatile("s_waitcnt lgkmcnt(" #n ")" ::: "memory")
#define PG8_BAR __builtin_amdgcn_s_barrier()
#define PG8_SCHED __builtin_amdgcn_sched_barrier(0)
    Unit cur, nxt; int ui = 0;
    if (!S.next(0, cur)) return;
    f32x4 acc[2][2][4][2];
#pragma unroll
    for (int a = 0; a < 2; ++a)
#pragma unroll
        for (int b = 0; b < 2; ++b)
#pragma unroll
            for (int m = 0; m < 4; ++m)
#pragma unroll
                for (int n = 0; n < 2; ++n) acc[a][b][m][n] = (f32x4){0.f, 0.f, 0.f, 0.f};
    bf16x8 At[4][2], B0[2][2], B1[2][2];
    const char* cA = (const char*)g.A + (size_t)cur.pm * tstep + (size_t)cur.k0 * 2; const char* cB = (const char*)g.Bt + (size_t)cur.pn * tstep + (size_t)cur.k0 * 2;
    PG8_STAGE(PG8_SB(0, 0), cB, voffA); PG8_STAGE(PG8_SA(0, 0), cA, voffA); PG8_STAGE(PG8_SB(0, 1), cB + hstep, voffA); PG8_STAGE(PG8_SA(0, 1), cA + hstep, voffA);
    if (wr == 1) PG8_BAR;
    PG8_WAIT_V(4); PG8_BAR;
    PG8_STAGE(PG8_SB(1, 0), cB + kstep, voffA); PG8_STAGE(PG8_SA(1, 0), cA + kstep, voffA); PG8_STAGE(PG8_SB(1, 1), cB + hstep + kstep, voffA);
    PG8_WAIT_V(6); PG8_BAR;
    for (;;) {
        const bool has_next = S.next(ui + 1, nxt);
        const char* nA = has_next ? (const char*)g.A + (size_t)nxt.pm * tstep + (size_t)nxt.k0 * 2 : cA; const char* nB = has_next ? (const char*)g.Bt + (size_t)nxt.pn * tstep + (size_t)nxt.k0 * 2 : cB;
        const int nt = cur.nt;
        for (int t = 0; t < nt; t += 2) {
            const bool last = (t == nt - 2);
            const char* a1 = cA + (size_t)(t + 1) * kstep;
            const char* a2 = last ? nA : cA + (size_t)(t + 2) * kstep; const char* b2 = last ? nB : cB + (size_t)(t + 2) * kstep;
            const char* a3 = a2 + kstep; const char* b3 = b2 + kstep;
            PG8_LDB(B0, 0, 0); PG8_SCHED; PG8_LDA(At, 0, 0); PG8_STAGE(PG8_SA(1, 1), a1 + hstep, voffA);
            PG8_WAIT_L(8); PG8_BAR; PG8_WAIT_L(0); PG8_MMA(0, 0, At, B0); PG8_BAR; PG8_SCHED;
            PG8_LDB(B1, 0, 1); PG8_STAGE(PG8_SB(0, 0), b2, voffA);
            PG8_BAR; PG8_WAIT_L(0); PG8_MMA(0, 1, At, B1); PG8_BAR;
            PG8_LDA(At, 0, 1); PG8_STAGE(PG8_SA(0, 0), a2, voffA);
            PG8_BAR; PG8_WAIT_L(0); PG8_MMA(1, 0, At, B0); PG8_BAR; PG8_SCHED;
            PG8_STAGE(PG8_SB(0, 1), b2 + hstep, voffA);
            PG8_WAIT_V(6); PG8_BAR; PG8_MMA(1, 1, At, B1); PG8_BAR;
            PG8_LDB(B0, 1, 0); PG8_SCHED; PG8_LDA(At, 1, 0); PG8_STAGE(PG8_SA(0, 1), a2 + hstep, voffA);
            PG8_WAIT_L(8); PG8_BAR; PG8_WAIT_L(0); PG8_MMA(0, 0, At, B0); PG8_BAR; PG8_SCHED;
            PG8_LDB(B1, 1, 1); PG8_STAGE(PG8_SB(1, 0), b3, voffA);
            PG8_BAR; PG8_WAIT_L(0); PG8_MMA(0, 1, At, B1); PG8_BAR;
            PG8_LDA(At, 1, 1); PG8_STAGE(PG8_SA(1, 0), a3, voffA);
            PG8_BAR; PG8_WAIT_L(0); PG8_MMA(1, 0, At, B0); PG8_BAR; PG8_SCHED;
            PG8_STAGE(PG8_SB(1, 1), b3 + hstep, voffA);
            PG8_WAIT_V(6); PG8_BAR; PG8_MMA(1, 1, At, B1); PG8_BAR;
        }
        E(acc, cur, wr, wc, fr, fq);
        if (!has_next) break;
#pragma unroll
        for (int a = 0; a < 2; ++a)
#pragma unroll
            for (int b = 0; b < 2; ++b)
#pragma unroll
                for (int m = 0; m < 4; ++m)
#pragma unroll
                    for (int n = 0; n < 2; ++n) acc[a][b][m][n] = (f32x4){0.f, 0.f, 0.f, 0.f};
        cur = nxt; cA = nA; cB = nB; ++ui;
    }
    PG8_WAIT_V(0);
    if (wr == 0) PG8_BAR;
    PG8_BAR;
#undef PG8_SA
#undef PG8_SB
#undef PG8_STAGE
#undef PG8_LDA
#undef PG8_LDB
#undef PG8_MMA
#undef PG8_WAIT_V
#undef PG8_WAIT_L
#undef PG8_BAR
#undef PG8_SCHED
}
}
using pg8::Unit;

struct Epi {
    int mode, ldo; float scale; GAS unsigned char* ws;
    __device__ __forceinline__ void operator()(const f32x4 (&acc)[2][2][4][2], const Unit& u, int wr, int wc, int fr, int fq) const {
        const int row0 = u.pm * 256 + wr * 64 + fr, col0 = u.pn * 256 + wc * 32 + 4 * fq;
        const GAS float* ssq_in = (const GAS float*)(ws + WS_SSQ); GAS float* ssq_out = (GAS float*)(ws + WS_SSQ); GAS float* xf = (GAS float*)(ws + WS_XF); GAS bf16_t* xb = (GAS bf16_t*)(ws + WS_XB);
        GAS float* part = (GAS float*)(ws + WS_PART); GAS bf16_t* O = (GAS bf16_t*)(ws + (mode == 3 ? WS_LRAW : WS_PROJ));
        if (u.kc >= 0) {
#pragma unroll
            for (int ai = 0; ai < 2; ++ai)
#pragma unroll
                for (int m = 0; m < 4; ++m) {
                    GAS float* rp = part + ((size_t)u.kc * 256 + (wr * 64 + fr + ai * 128 + m * 16)) * 1024 + col0;
#pragma unroll
                    for (int bj = 0; bj < 2; ++bj)
#pragma unroll
                        for (int n = 0; n < 2; ++n) *(GAS f32x4*)(rp + bj * 128 + n * 16) = acc[ai][bj][m][n];
                }
        } else if (mode == 0) {
#pragma unroll
            for (int ai = 0; ai < 2; ++ai)
#pragma unroll
                for (int m = 0; m < 4; ++m) {
                    const int row = row0 + ai * 128 + m * 16; const float rs = rstd_of(ssq_in, row);
#pragma unroll
                    for (int bj = 0; bj < 2; ++bj) {
                        const int hid = (u.pn * 256 + bj * 128 + wc * 32) / 2 + 4 * fq;
                        const f32x4 gg = acc[ai][bj][m][0] * rs, uu = acc[ai][bj][m][1] * rs;
                        u32x2 w; w.x = pk2(siluf_(gg.x) * uu.x, siluf_(gg.y) * uu.y); w.y = pk2(siluf_(gg.z) * uu.z, siluf_(gg.w) * uu.w);
                        *(GAS u32x2*)(O + (size_t)row * FF + hid) = w;
                    }
                }
        } else if (mode == 1) {
#pragma unroll
            for (int ai = 0; ai < 2; ++ai)
#pragma unroll
                for (int m = 0; m < 4; ++m) {
                    const int row = row0 + ai * 128 + m * 16; float ss = 0.f;
#pragma unroll
                    for (int bj = 0; bj < 2; ++bj)
#pragma unroll
                        for (int n = 0; n < 2; ++n) {
                            const int c = col0 + bj * 128 + n * 16;
                            GAS u32x2* xp = (GAS u32x2*)(xb + (size_t)row * D + c);
                            const u32x2 xo = *xp; f32x4 x = {bflo(xo.x), bfhi(xo.x), bflo(xo.y), bfhi(xo.y)}; x = x + acc[ai][bj][m][n] * scale;
                            u32x2 w; w.x = pk2(x.x, x.y); w.y = pk2(x.z, x.w); *xp = w;
                            ss += (x.x * x.x + x.y * x.y) + (x.z * x.z + x.w * x.w);
                        }
                    ss += __shfl_xor(ss, 16); ss += __shfl_xor(ss, 32);
                    if (fq == 0) ssq_out[(size_t)row * 16 + u.pn * 4 + wc] = ss;
                }
        } else {
#pragma unroll
            for (int ai = 0; ai < 2; ++ai)
#pragma unroll
                for (int m = 0; m < 4; ++m) {
                    const int row = row0 + ai * 128 + m * 16; const float rs = mode == 2 ? rstd_of(ssq_in, row) : 1.0f;
#pragma unroll
                    for (int bj = 0; bj < 2; ++bj)
#pragma unroll
                        for (int n = 0; n < 2; ++n) {
                            const int c = col0 + bj * 128 + n * 16; const f32x4 v = acc[ai][bj][m][n] * rs;
                            u32x2 w; w.x = pk2(v.x, v.y); w.y = pk2(v.z, v.w); *(GAS u32x2*)(O + (size_t)row * ldo + c) = w;
                        }
                }
        }
    }
};

__device__ __forceinline__ int map_col(int n, int kind) {
    if (kind == 1) return ((n >> 4) << 5) + (n & 15);
    if (kind == 2) return ((n >> 4) << 5) + 16 + (n & 15);
    if (kind == 3) return n < 2048 ? n : (n < 2064 ? 3072 + (n - 2048) : n - 16);
    return n;
}
struct TItem { const GAS float* W; const GAS float* gsc; GAS bf16_t* WT; int K, Nsrc, kind, k0, n0; };
__device__ __forceinline__ void titem_load(const TItem& t, f32x4 (&v)[8], int lane) {
    const int nq = t.n0 + (lane & 7) * 4;
#pragma unroll
    for (int i = 0; i < 8; ++i) { const int kk = 8 * i + (lane >> 3); v[i] = (nq < t.Nsrc) ? *(const GAS f32x4*)(t.W + (size_t)(t.k0 + kk) * t.Nsrc + nq) : (f32x4){0.f, 0.f, 0.f, 0.f}; }
}
__device__ __forceinline__ void titem_store(const TItem& t, const f32x4 (&v)[8], LAS float* scr, int lane) {
#pragma unroll
    for (int i = 0; i < 8; ++i) {
        const int kk = 8 * i + (lane >> 3); const float g = t.gsc ? t.gsc[t.k0 + kk] : 1.0f;
        LAS float* d = scr + kk * 33 + (lane & 7) * 4;
        d[0] = v[i].x * g; d[1] = v[i].y * g; d[2] = v[i].z * g; d[3] = v[i].w * g;
    }
    LDS_WAIT();
    const int c = lane & 7;
#pragma unroll
    for (int j = 0; j < 4; ++j) {
        const int nl = (lane >> 3) + 8 * j, n = t.n0 + nl;
        if (n < t.Nsrc) {
            const LAS float* s = scr + (8 * c) * 33 + nl;
            u32x4 o; o.x = pk2(s[0 * 33], s[1 * 33]); o.y = pk2(s[2 * 33], s[3 * 33]); o.z = pk2(s[4 * 33], s[5 * 33]); o.w = pk2(s[6 * 33], s[7 * 33]);
            *(GAS u32x4*)(t.WT + (size_t)map_col(n, t.kind) * t.K + t.k0 + 8 * c) = o;
        }
    }
    LDS_WAIT();
}
__device__ __forceinline__ TItem titem_decode(const Ctx& p, int it) {
    GAS unsigned char* ws = p.ws;
    constexpr int IT_G = 176, N_G = 8 * IT_G, IT_E = 240, N_E = 2 * IT_E, IT_O = 200, N_O = 2 * IT_O, IT_W = 64;
    TItem t; int r = it, nblk;
    if (r < 2 * N_G) {
        const int up = r >= N_G; if (up) r -= N_G;
        const int mat = r / IT_G, l = mat >> 1, f = mat & 1; r %= IT_G;
        t.W = p.in(f ? (up ? I_F2U : I_F2G) : (up ? I_F1U : I_F1G)) + (size_t)l * D * FF; t.gsc = p.in(f ? I_NF2 : I_NF1) + l * D;
        t.WT = (GAS bf16_t*)(ws + WS_WGU) + (size_t)mat * 5632 * 1024; t.K = D; t.Nsrc = FF; t.kind = up ? 2 : 1;
    } else if ((r -= 2 * N_G) < N_G) {
        const int mat = r / IT_G, l = mat >> 1, f = mat & 1; r %= IT_G;
        t.W = p.in(f ? I_F2D : I_F1D) + (size_t)l * FF * D; t.gsc = nullptr; t.WT = (GAS bf16_t*)(ws + WS_WD) + (size_t)mat * 1024 * FF; t.K = FF; t.Nsrc = D; t.kind = 0;
    } else if ((r -= N_G) < N_E) {
        const int mat = r / IT_E; r %= IT_E;
        t.W = p.in(I_EWIN) + (size_t)mat * D * EPROJ; t.gsc = p.in(I_NMIX) + (2 * mat) * D; t.WT = (GAS bf16_t*)(ws + WS_WINE) + (size_t)mat * EPROJ * 1024; t.K = D; t.Nsrc = EPROJ; t.kind = 0;
    } else if ((r -= N_E) < N_O) {
        const int mat = r / IT_O; r %= IT_O;
        t.W = p.in(I_OWIN) + (size_t)mat * D * OSRC; t.gsc = p.in(I_NMIX) + (2 * mat + 1) * D; t.WT = (GAS bf16_t*)(ws + WS_WINO) + (size_t)mat * OPROJ * 1024; t.K = D; t.Nsrc = OSRC; t.kind = 3;
    } else {
        r -= N_O; const int mat = r / IT_W; r %= IT_W;
        t.W = (mat & 1) ? p.in(I_OWOUT) + (size_t)(mat >> 1) * D * D : p.in(I_EWOUT) + (size_t)(mat >> 1) * D * D; t.gsc = nullptr;
        t.WT = (GAS bf16_t*)(ws + WS_WOUT) + (size_t)mat * D * D; t.K = D; t.Nsrc = D; t.kind = 0;
    }
    nblk = (t.Nsrc + 127) / 128; t.k0 = 128 * (r / nblk); t.n0 = 128 * (r % nblk);
    return t;
}

__device__ __forceinline__ void phase_p0(const Ctx& p, LAS unsigned char* lds) {
    const int tid = p.tid, lane = tid & 63, wave = tid >> 6;
    const int gw = p.bid * NWAVES + wave, NGW = p.G * NWAVES;
    GAS unsigned char* ws = p.ws;
    GAS bf16_t* WINO = (GAS bf16_t*)(ws + WS_WINO); GAS bf16_t* WLORA = (GAS bf16_t*)(ws + WS_WLORA);
    constexpr int NITEMS = 3 * 8 * 1408 + 2 * 1920 + 2 * 1552 + 4 * 512;
    {
        constexpr int NTILES = 3 * 8 * 176 + 2 * 240 + 2 * 200 + 4 * 64;
        LAS float* tile = (LAS float*)lds;
        const int q = tid & 31, r0 = tid >> 5;
        for (int tix = p.bid; tix < NTILES; tix += p.G) {
            const TItem t = titem_decode(p, tix);
            const int nq = t.n0 + 4 * q;
            f32x4 v[8]; float g8[8];
#pragma unroll
            for (int i = 0; i < 8; ++i) { const int kk = r0 + 16 * i; v[i] = (nq < t.Nsrc) ? *(const GAS f32x4*)(t.W + (size_t)(t.k0 + kk) * t.Nsrc + nq) : (f32x4){0.f, 0.f, 0.f, 0.f}; g8[i] = t.gsc ? t.gsc[t.k0 + kk] : 1.0f; }
            __syncthreads();
#pragma unroll
            for (int i = 0; i < 8; ++i) { LAS float* d = tile + (r0 + 16 * i) * 129 + 4 * q; d[0] = v[i].x * g8[i]; d[1] = v[i].y * g8[i]; d[2] = v[i].z * g8[i]; d[3] = v[i].w * g8[i]; }
            __syncthreads();
#pragma unroll
            for (int j = 0; j < 4; ++j) {
                const int id = tid + NTHREADS * j, nl = id >> 4, c16 = id & 15, n = t.n0 + nl;
                if (n < t.Nsrc) {
                    const LAS float* sp = tile + (8 * c16) * 129 + nl;
                    u32x4 o; o.x = pk2(sp[0 * 129], sp[1 * 129]); o.y = pk2(sp[2 * 129], sp[3 * 129]); o.z = pk2(sp[4 * 129], sp[5 * 129]); o.w = pk2(sp[6 * 129], sp[7 * 129]);
                    *(GAS u32x4*)(t.WT + (size_t)map_col(n, t.kind) * t.K + t.k0 + 8 * c16) = o;
                }
            }
        }
        __syncthreads();
    }
    const size_t gt = (size_t)p.bid * NTHREADS + tid, GT = (size_t)p.G * NTHREADS;
    for (size_t i = gt; i < (size_t)2 * 240 * 1024 / 2; i += GT) {
        const size_t mat = i / (240 * 512), r = i % (240 * 512);
        ((GAS unsigned*)(WINO + (size_t)mat * OPROJ * 1024 + (size_t)OSRC * 1024))[r] = 0u;
    }
    for (size_t i = gt; i < (size_t)2 * 1536 * 256; i += GT) {
        const int e = (int)(i / (1536 * 256)), n = (int)((i / 256) % 1536), k = (int)(i % 256), region = n >> 9, ch = n & 511;
        float v = 0.f;
        if (region == 0) { if (k < 64) v = p.in(I_W2)[((size_t)e * 64 + k) * 512 + ch]; }
        else if (region == 1) { if (k >= 64 && k < 128) v = p.in(I_A2)[((size_t)e * 64 + (k - 64)) * 512 + ch]; }
        else { if (k >= 128) v = p.in(I_G2)[((size_t)e * 128 + (k - 128)) * 512 + ch]; }
        WLORA[i] = (bf16_t)(pk2(v, 0.f) & 0xffffu);
    }
    GAS float* xf = (GAS float*)(ws + WS_XF); GAS bf16_t* xb = (GAS bf16_t*)(ws + WS_XB); GAS float* ssq = (GAS float*)(ws + WS_SSQ);
    for (int m = gw; m < MT; m += NGW) {
        const GAS float* src;
        if (m < MP) { const int b = m / TP, t = m % TP; src = t < 16 ? p.in(I_META) + (size_t)t * D : p.in(I_XP) + ((size_t)b * 2048 + (t - 16)) * D; }
        else src = p.in(I_XS) + (size_t)(m - MP) * D;
        float ss = 0.f;
#pragma unroll
        for (int j = 0; j < 4; ++j) {
            const int c = 4 * lane + 256 * j; const f32x4 x = *(const GAS f32x4*)(src + c);
            u32x2 w; w.x = pk2(x.x, x.y); w.y = pk2(x.z, x.w); *(GAS u32x2*)(xb + (size_t)m * D + c) = w;
            ss += (x.x * x.x + x.y * x.y) + (x.z * x.z + x.w * x.w);
        }
        ss = wave_sum(ss);
        if (lane < 16) ssq[(size_t)m * 16 + lane] = lane == 0 ? ss : 0.f;
        if (lane == 0) ((GAS float*)(ws + WS_RSTD))[m] = rsqrtf(ss * (1.0f / 1024.0f) + 1e-6f);
    }
}

__device__ __forceinline__ float lbval(const Ctx& p, int e, int ch) { return e == 0 ? 0.f : __builtin_amdgcn_rcpf(1.0f + __expf(p.in(I_LB)[ch] - p.in(I_LB)[512 + ch])); }

__device__ __forceinline__ void phase_fprep(const Ctx& p, int odd, int idx) {
    GAS unsigned char* ws = p.ws;
    const GAS bf16_t* proj = (const GAS bf16_t*)(ws + WS_PROJ);
    GAS bf16_t* QDg = (GAS bf16_t*)(ws + WS_MIXB); GAS bf16_t* KDg = QDg + (size_t)MT * 512; GAS bf16_t* KDTg = (GAS bf16_t*)(ws + WS_KDT); GAS float* ELg = (GAS float*)(ws + WS_ELG);
    const int LDP = odd ? OPROJ : EPROJ;
    constexpr float SC = 0.08838834764831845f;
    const int tid = p.tid, lane = tid & 63, wv = tid >> 6, cg = lane & 15, tq = lane >> 4, c4 = (wv * 16 + cg) * 4;
    f32x4 gu[16]; f32x4 gbv = {0.f, 0.f, 0.f, 0.f}; float lb[4] = {0.f, 0.f, 0.f, 0.f};
    if (odd) {
#pragma unroll
        for (int r = 0; r < 16; ++r) gu[r] = *(const GAS f32x4*)(p.in(I_GUP) + ((size_t)idx * 16 + r) * 512 + c4);
        gbv = *(const GAS f32x4*)(p.in(I_GB) + (size_t)idx * 512 + c4);
    } else {
#pragma unroll
        for (int r = 0; r < 16; ++r) gu[r] = (f32x4){0.f, 0.f, 0.f, 0.f};
#pragma unroll
        for (int i = 0; i < 4; ++i) lb[i] = lbval(p, idx, c4 + i);
    }
    for (int pair = p.bid; pair < 8 * 65; pair += p.G) {
        const int b = pair / 65, ch = pair % 65, tok0 = ch * 32 + tq * 8;
        const size_t m0 = (size_t)b * TP + tok0;
        u32x2 qv[8], kv[8];
#pragma unroll
        for (int j = 0; j < 8; ++j) { const GAS bf16_t* row = proj + (m0 + j) * LDP; qv[j] = *(const GAS u32x2*)(row + c4); kv[j] = *(const GAS u32x2*)(row + 512 + c4); }
        f32x4 lf[8];
        if (odd) {
            u32x4 g0[8], g1[8];
#pragma unroll
            for (int j = 0; j < 8; ++j) { const GAS bf16_t* row = proj + (m0 + j) * LDP; g0[j] = *(const GAS u32x4*)(row + 3072); g1[j] = *(const GAS u32x4*)(row + 3080); }
#pragma unroll
            for (int j = 0; j < 8; ++j) {
                const float gd[16] = {bflo(g0[j].x), bfhi(g0[j].x), bflo(g0[j].y), bfhi(g0[j].y), bflo(g0[j].z), bfhi(g0[j].z), bflo(g0[j].w), bfhi(g0[j].w),
                                      bflo(g1[j].x), bfhi(g1[j].x), bflo(g1[j].y), bfhi(g1[j].y), bflo(g1[j].z), bfhi(g1[j].z), bflo(g1[j].w), bfhi(g1[j].w)};
                f32x4 gk = gbv;
#pragma unroll
                for (int r = 0; r < 16; ++r) gk = gk + gu[r] * gd[r];
                lf[j].x = (fminf(gk.x, 0.f) - __logf(1.0f + __expf(-fabsf(gk.x)))) * 0.0625f; lf[j].y = (fminf(gk.y, 0.f) - __logf(1.0f + __expf(-fabsf(gk.y)))) * 0.0625f;
                lf[j].z = (fminf(gk.z, 0.f) - __logf(1.0f + __expf(-fabsf(gk.z)))) * 0.0625f; lf[j].w = (fminf(gk.w, 0.f) - __logf(1.0f + __expf(-fabsf(gk.w)))) * 0.0625f;
            }
        } else {
#pragma unroll
            for (int j = 0; j < 8; ++j) {
                const float fa[4] = {bflo(kv[j].x), bfhi(kv[j].x), bflo(kv[j].y), bfhi(kv[j].y)}; float l4[4];
#pragma unroll
                for (int i = 0; i < 4; ++i) l4[i] = __logf(1.0f - (1.0f - lb[i]) * __builtin_amdgcn_rcpf(1.0f + __expf(fa[i])));
                lf[j] = (f32x4){l4[0], l4[1], l4[2], l4[3]};
            }
        }
        f32x4 kk[8];
#pragma unroll
        for (int j = 0; j < 8; ++j) {
            const bool ok = tok0 + j < TP;
            if (odd) kk[j] = (f32x4){bflo(kv[j].x), bfhi(kv[j].x), bflo(kv[j].y), bfhi(kv[j].y)};
            else kk[j] = (f32x4){1.0f - __expf(lf[j].x), 1.0f - __expf(lf[j].y), 1.0f - __expf(lf[j].z), 1.0f - __expf(lf[j].w)};
            if (!ok) { lf[j] = (f32x4){0.f, 0.f, 0.f, 0.f}; kk[j] = lf[j]; qv[j] = (u32x2){0u, 0u}; }
            if (j) lf[j] = lf[j] + lf[j - 1];
        }
        f32x4 pre = {0.f, 0.f, 0.f, 0.f};
        {
            const float tot[4] = {lf[7].x, lf[7].y, lf[7].z, lf[7].w}; float pr4[4];
#pragma unroll
            for (int i = 0; i < 4; ++i) {
                const float p0 = __int_as_float(__builtin_amdgcn_ds_bpermute(cg << 2, __float_as_int(tot[i]))), p1 = __int_as_float(__builtin_amdgcn_ds_bpermute((cg + 16) << 2, __float_as_int(tot[i]))),
                            p2 = __int_as_float(__builtin_amdgcn_ds_bpermute((cg + 32) << 2, __float_as_int(tot[i])));
                pr4[i] = (tq > 0 ? p0 : 0.f) + (tq > 1 ? p1 : 0.f) + (tq > 2 ? p2 : 0.f);
            }
            pre = (f32x4){pr4[0], pr4[1], pr4[2], pr4[3]};
        }
        u32x4 kt[4];
        unsigned ktw[4][4];
#pragma unroll
        for (int j = 0; j < 8; j += 2) {
            f32x4 kd2[2];
#pragma unroll
            for (int jj = 0; jj < 2; ++jj) {
                const f32x4 cu4 = lf[j + jj] + pre; const float cu[4] = {fmaxf(cu4.x, -85.0f), fmaxf(cu4.y, -85.0f), fmaxf(cu4.z, -85.0f), fmaxf(cu4.w, -85.0f)};
                const float q4[4] = {bflo(qv[j + jj].x), bfhi(qv[j + jj].x), bflo(qv[j + jj].y), bfhi(qv[j + jj].y)}; const float k4[4] = {kk[j + jj].x, kk[j + jj].y, kk[j + jj].z, kk[j + jj].w};
                float qd[4], kd[4];
#pragma unroll
                for (int i = 0; i < 4; ++i) { qd[i] = q4[i] * SC * __expf(cu[i]); kd[i] = k4[i] * __expf(-cu[i]); }
                kd2[jj] = (f32x4){kd[0], kd[1], kd[2], kd[3]};
                if (tok0 + j + jj < TP) {
                    *(GAS u32x2*)(QDg + (m0 + j + jj) * 512 + c4) = (u32x2){pk2(qd[0], qd[1]), pk2(qd[2], qd[3])};
                    *(GAS u32x2*)(KDg + (m0 + j + jj) * 512 + c4) = (u32x2){pk2(kd[0], kd[1]), pk2(kd[2], kd[3])};
                }
            }
            ktw[0][j >> 1] = pk2(kd2[0].x, kd2[1].x); ktw[1][j >> 1] = pk2(kd2[0].y, kd2[1].y); ktw[2][j >> 1] = pk2(kd2[0].z, kd2[1].z); ktw[3][j >> 1] = pk2(kd2[0].w, kd2[1].w);
        }
#pragma unroll
        for (int i = 0; i < 4; ++i) { kt[i] = (u32x4){ktw[i][0], ktw[i][1], ktw[i][2], ktw[i][3]};
            *(GAS u32x4*)(KDTg + (((size_t)b * 65 + ch) * 512 + c4 + i) * 32 + tq * 8) = kt[i]; }
        if (tq == 3) {
            const f32x4 ce = lf[7] + pre;
            *(GAS f32x4*)(ELg + ((size_t)b * 65 + ch) * 512 + c4) = (f32x4){__expf(fmaxf(ce.x, -85.0f)), __expf(fmaxf(ce.y, -85.0f)), __expf(fmaxf(ce.z, -85.0f)), __expf(fmaxf(ce.w, -85.0f))};
        }
    }
}

__device__ __forceinline__ void phase_lin(const Ctx& p, int e) {
    GAS unsigned char* ws = p.ws;
    const GAS bf16_t* proj = (const GAS bf16_t*)(ws + WS_PROJ); GAS bf16_t* lin = (GAS bf16_t*)(ws + WS_LIN);
    const GAS float* mu = p.in(I_MU) + (size_t)e * 1792; const GAS float* sst = p.in(I_SS) + (size_t)e * NS * 1792;
    const size_t gt = (size_t)p.bid * NTHREADS + p.tid, GT = (size_t)p.G * NTHREADS;
    for (size_t i = gt; i < (size_t)MT * 32; i += GT) {
        const int m = (int)(i >> 5), j8 = (int)(i & 31) * 8;
        const u32x4 cu = *(const GAS u32x4*)(proj + (size_t)m * EPROJ + 3584 + j8);
        float cur[8] = {bflo(cu.x), bfhi(cu.x), bflo(cu.y), bfhi(cu.y), bflo(cu.z), bfhi(cu.z), bflo(cu.w), bfhi(cu.w)};
        float prv[8];
        if (m >= MP) { const GAS float* s = sst + (size_t)(m - MP) * 1792 + 1536 + j8; const f32x4 a = *(const GAS f32x4*)s, b = *(const GAS f32x4*)(s + 4);
            prv[0] = a.x; prv[1] = a.y; prv[2] = a.z; prv[3] = a.w; prv[4] = b.x; prv[5] = b.y; prv[6] = b.z; prv[7] = b.w; }
        else if ((m % TP) == 0) {
#pragma unroll
            for (int j = 0; j < 8; ++j) prv[j] = 0.f; }
        else { const u32x4 pu = *(const GAS u32x4*)(proj + (size_t)(m - 1) * EPROJ + 3584 + j8);
            prv[0] = bflo(pu.x); prv[1] = bfhi(pu.x); prv[2] = bflo(pu.y); prv[3] = bfhi(pu.y); prv[4] = bflo(pu.z); prv[5] = bfhi(pu.z); prv[6] = bflo(pu.w); prv[7] = bfhi(pu.w); }
        const f32x4 m0 = *(const GAS f32x4*)(mu + 1536 + j8), m1 = *(const GAS f32x4*)(mu + 1536 + j8 + 4);
        const float mm[8] = {m0.x, m0.y, m0.z, m0.w, m1.x, m1.y, m1.z, m1.w};
        float o[8];
#pragma unroll
        for (int j = 0; j < 8; ++j) { const float x = cur[j] + (prv[j] - cur[j]) * mm[j]; o[j] = j8 < 64 ? 1.0f - 2.0f * __builtin_amdgcn_rcpf(1.0f + __expf(2.0f * x)) : (j8 < 128 ? x : sigmoidf_(x)); }
        u32x4 w; w.x = pk2(o[0], o[1]); w.y = pk2(o[2], o[3]); w.z = pk2(o[4], o[5]); w.w = pk2(o[6], o[7]);
        *(GAS u32x4*)(lin + (size_t)m * 256 + j8) = w;
    }
    for (size_t i = gt; i < (size_t)(NB + NS) * 1792; i += GT) {
        const int s = (int)(i / 1792), c = (int)(i % 1792);
        if (s < NB) p.out[O_SP + ((size_t)e * NB + s) * 1792 + c] = bf2f(proj[((size_t)s * TP + TP - 1) * EPROJ + 2048 + c]);
        else p.out[O_SSH + ((size_t)e * NS + (s - NB)) * 1792 + c] = bf2f(proj[((size_t)MP + (s - NB)) * EPROJ + 2048 + c]);
    }
}

constexpr int TC = 32, NCH = (TP + TC - 1) / TC;

template <bool GLA>
__device__ __forceinline__ void glalike_sample(const Ctx& p, int idx  , int i, int h, LAS unsigned char* lds) {
    constexpr int DV = GLA ? 256 : 128, LDP = GLA ? OPROJ : EPROJ, KR = GLA ? 8 : 16, RPT = 128 / KR, VT = DV / 4;
    const int tid = p.tid, m = MP + i;
    GAS unsigned char* ws = p.ws;
    const GAS bf16_t* pr = (const GAS bf16_t*)(ws + WS_PROJ) + (size_t)m * LDP; GAS float* oraw = (GAS float*)(ws + WS_ORAW);
    LAS float* sq = (LAS float*)lds; LAS float* sk = sq + 128; LAS float* sf = sk + 128; LAS float* sv = sf + 128; LAS float* red = sv + 256;
    __syncthreads();
    if (tid < 128) {
        const int ch = h * 128 + tid;
        if (!GLA) {
            const float qa = bf2f(pr[ch]), fa = bf2f(pr[512 + ch]); const float lb = lbval(p, idx, ch);
            const float kk = (1.0f - lb) / (1.0f + __expf(fa));
            sq[tid] = qa * 0.08838834764831845f; sk[tid] = kk; sf[tid] = 1.0f - kk;
        } else {
            float gk = p.in(I_GB)[(size_t)idx * 512 + ch];
#pragma unroll
            for (int r = 0; r < 16; ++r) gk += bf2f(pr[3072 + r]) * p.in(I_GUP)[((size_t)idx * 16 + r) * 512 + ch];
            const float ls = fminf(gk, 0.f) - __logf(1.0f + __expf(-fabsf(gk)));
            sq[tid] = bf2f(pr[ch]) * 0.08838834764831845f; sk[tid] = bf2f(pr[512 + ch]); sf[tid] = __expf(ls * 0.0625f);
        }
    }
    if (tid >= 128 && tid < 128 + DV) {
        const int c = tid - 128;
        if (!GLA) sv[c] = siluf_(bf2f(pr[1024 + h * 128 + c])); else sv[c] = bf2f(pr[1024 + h * 256 + c]);
    }
    __syncthreads();
    const int v4 = (tid % VT) * 4, kr = tid / VT;
    const size_t soff = ((((size_t)idx * NS + i) * 4 + h) * 128) * DV;
    const GAS float* Sin = p.in(GLA ? I_SG : I_SH) + soff; GAS float* Sout = p.out + (GLA ? O_GS : O_HS) + soff;
    const f32x4 vv = *(const LAS f32x4*)(sv + v4); f32x4 o = {0.f, 0.f, 0.f, 0.f};
#pragma unroll 4
    for (int jj = 0; jj < RPT; ++jj) {
        const int k = kr * RPT + jj;
        f32x4 s = *(const GAS f32x4*)(Sin + (size_t)k * DV + v4);
        s = s * sf[k] + vv * sk[k];
        *(GAS f32x4*)(Sout + (size_t)k * DV + v4) = s;
        o = o + s * sq[k];
    }
    *(LAS f32x4*)(red + kr * DV + v4) = o;
    __syncthreads();
    if (tid < DV) { float a = 0.f;
#pragma unroll
        for (int r = 0; r < KR; ++r) a += red[r * DV + tid];
        oraw[(size_t)m * 1024 + h * DV + tid] = a; }
}

__device__ __forceinline__ void rwkv_sample(const Ctx& p, int e, int i, int h, LAS unsigned char* lds) {
    const int tid = p.tid, m = MP + i;
    GAS unsigned char* ws = p.ws;
    const GAS bf16_t* pb = (const GAS bf16_t*)(ws + WS_PROJ) + (size_t)m * EPROJ + 2048; GAS float* oraw = (GAS float*)(ws + WS_ORAW);
    const GAS bf16_t* lraw = (const GAS bf16_t*)(ws + WS_LRAW); GAS float* bsum = (GAS float*)(ws + WS_BSUM);
    LAS float* sr = (LAS float*)lds; LAS float* sw = sr + 64; LAS float* sk = sw + 64; LAS float* sn = sk + 64; LAS float* sa_ = sn + 64; LAS float* sv = sa_ + 64;
    __syncthreads();
    if (tid < 64) {
        const int c = h * 64 + tid;
        const GAS float* prev = p.in(I_SS) + ((size_t)e * NS + i) * 1792; const GAS float* mu = p.in(I_MU) + (size_t)e * 1792;
        const float xr = bf2f(pb[c]), xk = bf2f(pb[512 + c]), xv = bf2f(pb[1024 + c]);
        const float r = xr + (prev[c] - xr) * mu[c], k_ = xk + (prev[512 + c] - xk) * mu[512 + c], v = xv + (prev[1024 + c] - xv) * mu[1024 + c];
        const float a = sigmoidf_(p.in(I_A0)[e * 512 + c] + bf2f(lraw[(size_t)m * 1536 + 512 + c]));
        const float w = __expf(-0.60653066f * sigmoidf_(p.in(I_W0)[e * 512 + c] + bf2f(lraw[(size_t)m * 1536 + c])));
        const float kkw = k_ * p.in(I_KK)[e * 512 + c];
        const float nrm = fmaxf(sqrtf(wave_sum(kkw * kkw)), 1e-12f), kk = kkw / nrm;
        const float kmod = k_ * (1.0f + (a - 1.0f) * p.in(I_KA)[e * 512 + c]);
        const float bs = wave_sum(r * kmod * p.in(I_RK)[e * 512 + c]);
        if (tid == 0) bsum[(size_t)m * 8 + h] = bs;
        sr[tid] = r; sw[tid] = w; sk[tid] = kmod; sn[tid] = -kk; sa_[tid] = kk * a; sv[tid] = v;
    }
    __syncthreads();
    const int row = tid >> 3, l = tid & 7;
    const size_t soff = ((((size_t)e * NS + i) * 8 + h) * 64 + row) * 64 + 8 * l;
    const GAS float* Sin = p.in(I_SR) + soff; GAS float* Sout = p.out + O_RS + soff;
    f32x4 s0 = *(const GAS f32x4*)Sin, s1 = *(const GAS f32x4*)(Sin + 4);
    const f32x4 n0 = *(const LAS f32x4*)(sn + 8 * l), n1 = *(const LAS f32x4*)(sn + 8 * l + 4);
    float sa = (s0.x * n0.x + s0.y * n0.y) + (s0.z * n0.z + s0.w * n0.w) + (s1.x * n1.x + s1.y * n1.y) + (s1.z * n1.z + s1.w * n1.w);
    sa = allred8(sa);
    const f32x4 w0 = *(const LAS f32x4*)(sw + 8 * l), w1 = *(const LAS f32x4*)(sw + 8 * l + 4), a0 = *(const LAS f32x4*)(sa_ + 8 * l), a1 = *(const LAS f32x4*)(sa_ + 8 * l + 4);
    const f32x4 k0 = *(const LAS f32x4*)(sk + 8 * l), k1 = *(const LAS f32x4*)(sk + 8 * l + 4), r0 = *(const LAS f32x4*)(sr + 8 * l), r1 = *(const LAS f32x4*)(sr + 8 * l + 4);
    const float v = sv[row];
    s0 = s0 * w0 + a0 * sa + k0 * v; s1 = s1 * w1 + a1 * sa + k1 * v;
    float y = (s0.x * r0.x + s0.y * r0.y) + (s0.z * r0.z + s0.w * r0.w) + (s1.x * r1.x + s1.y * r1.y) + (s1.z * r1.z + s1.w * r1.w);
    y = allred8(y);
    if (l == 0) oraw[(size_t)m * 1024 + 512 + h * 64 + row] = y;
    *(GAS f32x4*)Sout = s0; *(GAS f32x4*)(Sout + 4) = s1;
}

__device__ __forceinline__ void rwkv_prompt_scan(const Ctx& p, int e, int bh, int hf, LAS unsigned char* lds) {
    const int tid = p.tid, lane = tid & 63, wave = tid >> 6, b = bh >> 3, h = bh & 7;
    GAS unsigned char* ws = p.ws;
    const GAS bf16_t* proj = (const GAS bf16_t*)(ws + WS_PROJ); GAS float* oraw = (GAS float*)(ws + WS_ORAW);
    const GAS bf16_t* lraw = (const GAS bf16_t*)(ws + WS_LRAW); GAS float* bsum = (GAS float*)(ws + WS_BSUM);
    LAS float* st = (LAS float*)lds;
    __syncthreads();
#define RW_LBAR() do { asm volatile("s_waitcnt lgkmcnt(0)" ::: "memory"); __builtin_amdgcn_s_barrier(); asm volatile("" ::: "memory"); } while (0)
    if (wave >= 4) {
        const int ts = tid - 256, s_st = ts >> 3, j8 = (ts & 7) * 8, c0 = h * 64 + j8;
        const GAS float* mu = p.in(I_MU) + (size_t)e * 1792;
        float mu_r[8], mu_k[8], mu_v[8], w0p[8], a0p[8], kkp[8], kap[8], rkp[8];
#pragma unroll
        for (int j = 0; j < 8; ++j) { mu_r[j] = mu[c0 + j]; mu_k[j] = mu[512 + c0 + j]; mu_v[j] = mu[1024 + c0 + j]; w0p[j] = p.in(I_W0)[e * 512 + c0 + j]; a0p[j] = p.in(I_A0)[e * 512 + c0 + j];
            kkp[j] = p.in(I_KK)[e * 512 + c0 + j]; kap[j] = p.in(I_KA)[e * 512 + c0 + j]; rkp[j] = p.in(I_RK)[e * 512 + c0 + j]; }
        for (int c = 0; c < NCH; ++c) {
            {
                const int t = c * TC + s_st; const bool ok = t < TP; const size_t m = (size_t)b * TP + (ok ? t : 0);
                const GAS bf16_t* q = proj + m * EPROJ + 2048 + c0;
                const u32x4 cr = *(const GAS u32x4*)q, ck = *(const GAS u32x4*)(q + 512), cv = *(const GAS u32x4*)(q + 1024);
                u32x4 pr_ = {0u, 0u, 0u, 0u}, pk_ = pr_, pv_ = pr_;
                if (ok && t > 0) { pr_ = *(const GAS u32x4*)(q - EPROJ); pk_ = *(const GAS u32x4*)(q - EPROJ + 512); pv_ = *(const GAS u32x4*)(q - EPROJ + 1024); }
                const u32x4 av = *(const GAS u32x4*)(lraw + m * 1536 + 512 + c0), wv = *(const GAS u32x4*)(lraw + m * 1536 + c0);
                const float xr0[8] = {bflo(cr.x), bfhi(cr.x), bflo(cr.y), bfhi(cr.y), bflo(cr.z), bfhi(cr.z), bflo(cr.w), bfhi(cr.w)};
                const float xk0[8] = {bflo(ck.x), bfhi(ck.x), bflo(ck.y), bfhi(ck.y), bflo(ck.z), bfhi(ck.z), bflo(ck.w), bfhi(ck.w)};
                const float xv0[8] = {bflo(cv.x), bfhi(cv.x), bflo(cv.y), bfhi(cv.y), bflo(cv.z), bfhi(cv.z), bflo(cv.w), bfhi(cv.w)};
                const float qr[8] = {bflo(pr_.x), bfhi(pr_.x), bflo(pr_.y), bfhi(pr_.y), bflo(pr_.z), bfhi(pr_.z), bflo(pr_.w), bfhi(pr_.w)};
                const float qk[8] = {bflo(pk_.x), bfhi(pk_.x), bflo(pk_.y), bfhi(pk_.y), bflo(pk_.z), bfhi(pk_.z), bflo(pk_.w), bfhi(pk_.w)};
                const float qv[8] = {bflo(pv_.x), bfhi(pv_.x), bflo(pv_.y), bfhi(pv_.y), bflo(pv_.z), bfhi(pv_.z), bflo(pv_.w), bfhi(pv_.w)};
                const float ar[8] = {bflo(av.x), bfhi(av.x), bflo(av.y), bfhi(av.y), bflo(av.z), bfhi(av.z), bflo(av.w), bfhi(av.w)};
                const float wr_[8] = {bflo(wv.x), bfhi(wv.x), bflo(wv.y), bfhi(wv.y), bflo(wv.z), bfhi(wv.z), bflo(wv.w), bfhi(wv.w)};
                float xr[8], xk[8], xv[8], a[8], wd[8], kkw[8], kmod[8]; float ss = 0.f, bs = 0.f;
#pragma unroll
                for (int j = 0; j < 8; ++j) {
                    xr[j] = xr0[j] + (qr[j] - xr0[j]) * mu_r[j]; xk[j] = xk0[j] + (qk[j] - xk0[j]) * mu_k[j]; xv[j] = xv0[j] + (qv[j] - xv0[j]) * mu_v[j];
                    a[j] = sigmoidf_(ar[j] + a0p[j]); wd[j] = __expf(-0.60653066f * sigmoidf_(wr_[j] + w0p[j]));
                    kkw[j] = xk[j] * kkp[j]; ss += kkw[j] * kkw[j];
                    kmod[j] = xk[j] * ((a[j] - 1.0f) * kap[j] + 1.0f); bs += xr[j] * kmod[j] * rkp[j];
                }
                ss = allred8(ss); bs = allred8(bs);
                const float inv = rsqrtf(fmaxf(ss, 1e-24f));
                if (ok) {
                    if (hf == 0 && (ts & 7) == 0) bsum[m * 8 + h] = bs;
                    LAS float* sp = st + (c & 1) * (TC * 384) + s_st * 384 + j8;
                    *(LAS f32x4*)(sp) = (f32x4){xr[0], xr[1], xr[2], xr[3]}; *(LAS f32x4*)(sp + 4) = (f32x4){xr[4], xr[5], xr[6], xr[7]};
                    *(LAS f32x4*)(sp + 64) = (f32x4){wd[0], wd[1], wd[2], wd[3]}; *(LAS f32x4*)(sp + 68) = (f32x4){wd[4], wd[5], wd[6], wd[7]};
                    *(LAS f32x4*)(sp + 128) = (f32x4){kmod[0], kmod[1], kmod[2], kmod[3]}; *(LAS f32x4*)(sp + 132) = (f32x4){kmod[4], kmod[5], kmod[6], kmod[7]};
                    *(LAS f32x4*)(sp + 192) = (f32x4){-kkw[0] * inv, -kkw[1] * inv, -kkw[2] * inv, -kkw[3] * inv}; *(LAS f32x4*)(sp + 196) = (f32x4){-kkw[4] * inv, -kkw[5] * inv, -kkw[6] * inv, -kkw[7] * inv};
                    *(LAS f32x4*)(sp + 256) = (f32x4){kkw[0] * inv * a[0], kkw[1] * inv * a[1], kkw[2] * inv * a[2], kkw[3] * inv * a[3]};
                    *(LAS f32x4*)(sp + 260) = (f32x4){kkw[4] * inv * a[4], kkw[5] * inv * a[5], kkw[6] * inv * a[6], kkw[7] * inv * a[7]};
                    *(LAS f32x4*)(sp + 320) = (f32x4){xv[0], xv[1], xv[2], xv[3]}; *(LAS f32x4*)(sp + 324) = (f32x4){xv[4], xv[5], xv[6], xv[7]};
                }
            }
            RW_LBAR();
        }
        RW_LBAR();
    } else {
        __builtin_amdgcn_s_setprio(2);
        const int rowl = wave * 8 + (lane >> 3), row = hf * 32 + rowl, l = lane & 7;
        f32x2_ S[4];
#pragma unroll
        for (int j = 0; j < 4; ++j) S[j] = (f32x2_){0.f, 0.f};
        RW_LBAR();
        for (int c = 0; c < NCH; ++c) {
            const int nsteps = (TP - c * TC) < TC ? (TP - c * TC) : TC;
            GAS float* yp = oraw + ((size_t)b * TP + (size_t)c * TC + l) * 1024 + 512 + h * 64 + row;
            const LAS float* sp = st + (c & 1) * (TC * 384);
#define RW_LD(X, ptr) const f32x4 X##r0 = *(const LAS f32x4*)((ptr) + 8 * l), X##r1 = *(const LAS f32x4*)((ptr) + 8 * l + 4), X##w0 = *(const LAS f32x4*)((ptr) + 64 + 8 * l), X##w1 = *(const LAS f32x4*)((ptr) + 68 + 8 * l), \
                X##k0 = *(const LAS f32x4*)((ptr) + 128 + 8 * l), X##k1 = *(const LAS f32x4*)((ptr) + 132 + 8 * l), X##n0 = *(const LAS f32x4*)((ptr) + 192 + 8 * l), X##n1 = *(const LAS f32x4*)((ptr) + 196 + 8 * l), \
                X##a0 = *(const LAS f32x4*)((ptr) + 256 + 8 * l), X##a1 = *(const LAS f32x4*)((ptr) + 260 + 8 * l); const float X##v = (ptr)[320 + row]
#define RW_LDV(X, ptr) f32x4 X##r0 = *(const LAS f32x4*)((ptr) + 8 * l), X##r1 = *(const LAS f32x4*)((ptr) + 8 * l + 4), X##w0 = *(const LAS f32x4*)((ptr) + 64 + 8 * l), X##w1 = *(const LAS f32x4*)((ptr) + 68 + 8 * l), \
                X##k0 = *(const LAS f32x4*)((ptr) + 128 + 8 * l), X##k1 = *(const LAS f32x4*)((ptr) + 132 + 8 * l), X##n0 = *(const LAS f32x4*)((ptr) + 192 + 8 * l), X##n1 = *(const LAS f32x4*)((ptr) + 196 + 8 * l), \
                X##a0 = *(const LAS f32x4*)((ptr) + 256 + 8 * l), X##a1 = *(const LAS f32x4*)((ptr) + 260 + 8 * l); float X##v = (ptr)[320 + row]
#define RW_LDA(X, ptr) do { X##r0 = *(const LAS f32x4*)((ptr) + 8 * l); X##r1 = *(const LAS f32x4*)((ptr) + 8 * l + 4); X##w0 = *(const LAS f32x4*)((ptr) + 64 + 8 * l); X##w1 = *(const LAS f32x4*)((ptr) + 68 + 8 * l); \
                X##k0 = *(const LAS f32x4*)((ptr) + 128 + 8 * l); X##k1 = *(const LAS f32x4*)((ptr) + 132 + 8 * l); X##n0 = *(const LAS f32x4*)((ptr) + 192 + 8 * l); X##n1 = *(const LAS f32x4*)((ptr) + 196 + 8 * l); \
                X##a0 = *(const LAS f32x4*)((ptr) + 256 + 8 * l); X##a1 = *(const LAS f32x4*)((ptr) + 260 + 8 * l); X##v = (ptr)[320 + row]; } while (0)
#define RW_STEP(X, ssv) do { \
                const f32x2_ nn[4] = {X##n0.xy, X##n0.zw, X##n1.xy, X##n1.zw}, ww[4] = {X##w0.xy, X##w0.zw, X##w1.xy, X##w1.zw}, aa[4] = {X##a0.xy, X##a0.zw, X##a1.xy, X##a1.zw}; \
                const f32x2_ kq[4] = {X##k0.xy, X##k0.zw, X##k1.xy, X##k1.zw}, rr[4] = {X##r0.xy, X##r0.zw, X##r1.xy, X##r1.zw}; \
                const f32x2_ sp2 = (S[0] * nn[0] + S[1] * nn[1]) + (S[2] * nn[2] + S[3] * nn[3]); \
                float sa = sp2.x + sp2.y; sa = allred8(sa); \
                _Pragma("unroll") for (int j = 0; j < 4; ++j) S[j] = S[j] * ww[j] + (aa[j] * sa + kq[j] * X##v); \
                const f32x2_ yp2 = (S[0] * rr[0] + S[1] * rr[1]) + (S[2] * rr[2] + S[3] * rr[3]); \
                float y = yp2.x + yp2.y; y = allred8(y); ycap = (l == (ssv)) ? y : ycap; } while (0)
            RW_LDV(A0_, sp);
            for (int s0 = 0; s0 < nsteps; s0 += 8) {
                float ycap = 0.f;
#define SB_ __builtin_amdgcn_sched_barrier(0);
                { RW_LD(B_, sp + 384); SB_ RW_STEP(A0_, 0); SB_ RW_LD(A_, sp + 768); SB_ RW_STEP(B_, 1); SB_
                  RW_LD(B2_, sp + 1152); SB_ RW_STEP(A_, 2); SB_ RW_LD(A2_, sp + 1536); SB_ RW_STEP(B2_, 3); SB_
                  RW_LD(B3_, sp + 1920); SB_ RW_STEP(A2_, 4); SB_ RW_LD(A3_, sp + 2304); SB_ RW_STEP(B3_, 5); SB_
                  RW_LD(B4_, sp + 2688); SB_ RW_STEP(A3_, 6); SB_ RW_LDA(A0_, sp + 3072); SB_ RW_STEP(B4_, 7); SB_ }
#undef SB_
                sp += 8 * 384;
                yp[(size_t)s0 * 1024] = ycap;
            }
#undef RW_LD
#undef RW_LDV
#undef RW_LDA
#undef RW_STEP
            RW_LBAR();
        }
        __builtin_amdgcn_s_setprio(0);
        GAS float* So = p.out + O_RP + ((((size_t)e * NB + b) * 8 + h) * 64 + row) * 64 + 8 * l;
        *(GAS f32x4*)So = (f32x4){S[0].x, S[0].y, S[1].x, S[1].y}; *(GAS f32x4*)(So + 4) = (f32x4){S[2].x, S[2].y, S[3].x, S[3].y};
    }
}

__device__ __forceinline__ unsigned short f2bf_c(float x) { unsigned u = __float_as_uint(x); u += 0x7fffu + ((u >> 16) & 1u); return (unsigned short)(u >> 16); }
__device__ __forceinline__ unsigned pkc(float lo, float hi) { return (unsigned)f2bf_c(lo) | ((unsigned)f2bf_c(hi) << 16); }
template <bool GLA>
__device__ __forceinline__ void gla_mfma_scan(const Ctx& p, int o, int bh, int part, LAS unsigned char* lds) {
    constexpr int DV = GLA ? 256 : 128, LDP = GLA ? OPROJ : EPROJ, QS = 136  , TS = 40  ;
    constexpr int OFF_QD = 0, OFF_KD = 32 * QS * 2, OFF_KDT = 2 * 32 * QS * 2, OFF_VT = OFF_KDT + 128 * TS * 2, OFF_EL = OFF_VT + 32 * TS * 2, STG = OFF_EL + 512;
    constexpr int OFF_SB = 2 * STG, SBB = 8192;
    constexpr float SC = 0.08838834764831845f;
    const int tid = p.tid, lane = tid & 63, w = tid >> 6, b = bh >> 2, h = bh & 3, colbase = part * 32;
    GAS unsigned char* ws = p.ws;
    const GAS bf16_t* proj = (const GAS bf16_t*)(ws + WS_PROJ); GAS float* oraw = (GAS float*)(ws + WS_ORAW);
    const int kk = lane & 15, tq = lane >> 4, k = 16 * w + kk;
    const int vv = tid & 31, sg = tid >> 5;
    const int r16 = lane & 15, quad = lane >> 4;
    f32x4 S0 = {0.f, 0.f, 0.f, 0.f}, S1 = {0.f, 0.f, 0.f, 0.f};
    u32x4 Aq, Ak, At, Bq, Bk, Bt; unsigned Av0, Av1, Bv0, Bv1; float Ael, Bel;
    const GAS bf16_t* QDg = (const GAS bf16_t*)(ws + WS_MIXB); const GAS bf16_t* KDg = QDg + (size_t)MT * 512; const GAS bf16_t* KDTg = (const GAS bf16_t*)(ws + WS_KDT); const GAS float* ELg = (const GAS float*)(ws + WS_ELG);
    const int tr = tid >> 4, c8 = (tid & 15) * 8, kq = tid >> 2, ps = tid & 3;
#define GM_LOAD(X, cc) do { const size_t r0_ = (size_t)b * TP + (size_t)(cc) * 32;   \
        X##q = *(const GAS u32x4*)(QDg + (r0_ + tr) * 512 + h * 128 + c8); X##k = *(const GAS u32x4*)(KDg + (r0_ + tr) * 512 + h * 128 + c8); \
        X##t = *(const GAS u32x4*)(KDTg + ((((size_t)b * 65 + (cc)) * 512 + h * 128 + kq) * 32 + ps * 8)); \
        const GAS bf16_t* pv_ = proj + (r0_ + 2 * sg) * LDP + 1024 + h * DV + colbase + vv; X##v0 = (unsigned)pv_[0]; X##v1 = (unsigned)pv_[LDP]; \
        X##el = ELg[((size_t)b * 65 + (cc)) * 512 + h * 128 + (tid & 127)]; } while (0)
#define GM_STAGE(X, cc) do { LAS unsigned char* sb_ = lds + ((cc) & 1) * STG; const u32x4 z_ = {0u, 0u, 0u, 0u}; \
        const bool okr_ = (cc) * 32 + tr < TP, okt_ = (cc) * 32 + ps * 8 < TP; \
        *(LAS u32x4*)(sb_ + OFF_QD + (tr * QS + c8) * 2) = okr_ ? X##q : z_; *(LAS u32x4*)(sb_ + OFF_KD + (tr * QS + c8) * 2) = okr_ ? X##k : z_; \
        *(LAS u32x4*)(sb_ + OFF_KDT + (kq * TS + ps * 8) * 2) = okt_ ? X##t : z_; \
        const unsigned va_ = ((cc) * 32 + 2 * sg < TP) ? X##v0 : 0u, vb_ = ((cc) * 32 + 2 * sg + 1 < TP) ? X##v1 : 0u; \
        *(LAS unsigned*)(sb_ + OFF_VT + (vv * TS + 2 * sg) * 2) = GLA ? (va_ | (vb_ << 16)) : pk2(siluf_(bflo(va_)), siluf_(bflo(vb_))); \
        if (tid < 128) *(LAS float*)(sb_ + OFF_EL + tid * 4) = X##el; } while (0)
#define MFMA16(a, b, c) __builtin_amdgcn_mfma_f32_16x16x32_bf16((a), (b), (c), 0, 0, 0)
    auto chunk = [&](const int c) {
        LAS unsigned char* sb = lds + (c & 1) * STG; LAS unsigned char* sbS = lds + OFF_SB + (c & 1) * SBB;
        if (w < 4) {
            const int tt = w >> 1, vt = w & 1;
            f32x4 sc0 = {0.f, 0.f, 0.f, 0.f}, sc1 = {0.f, 0.f, 0.f, 0.f};
#pragma unroll
            for (int ks = 0; ks < 4; ++ks) {
                const bf16x8 bq = *(const LAS bf16x8*)(sb + OFF_QD + ((tt * 16 + r16) * QS + ks * 32 + quad * 8) * 2);
                const bf16x8 a0 = *(const LAS bf16x8*)(sb + OFF_KD + ((r16) * QS + ks * 32 + quad * 8) * 2);
                sc0 = MFMA16(a0, bq, sc0);
                if (tt == 1) { const bf16x8 a1 = *(const LAS bf16x8*)(sb + OFF_KD + ((16 + r16) * QS + ks * 32 + quad * 8) * 2); sc1 = MFMA16(a1, bq, sc1); }
            }
            const int s0 = quad * 4;
            f32x4 dg = tt ? sc1 : sc0;
            dg.x = (s0 + 0 <= r16) ? dg.x : 0.f; dg.y = (s0 + 1 <= r16) ? dg.y : 0.f; dg.z = (s0 + 2 <= r16) ? dg.z : 0.f; dg.w = (s0 + 3 <= r16) ? dg.w : 0.f;
            const f32x4 lo = tt ? sc0 : dg, hi = tt ? dg : (f32x4){0.f, 0.f, 0.f, 0.f};
            const u32x4 au = {pkc(lo.x, lo.y), pkc(lo.z, lo.w), pkc(hi.x, hi.y), pkc(hi.z, hi.w)};
            const u32x2 v0 = *(const LAS u32x2*)(sb + OFF_VT + ((vt * 16 + r16) * TS + quad * 4) * 2), v1 = *(const LAS u32x2*)(sb + OFF_VT + ((vt * 16 + r16) * TS + 16 + quad * 4) * 2);
            f32x4 oacc = MFMA16(__builtin_bit_cast(bf16x8, au), __builtin_bit_cast(bf16x8, ((u32x4){v0.x, v0.y, v1.x, v1.y})), ((f32x4){0.f, 0.f, 0.f, 0.f}));
#pragma unroll
            for (int ks = 0; ks < 4; ++ks) {
                const u32x2 q0 = *(const LAS u32x2*)(sb + OFF_QD + ((tt * 16 + r16) * QS + ks * 32 + quad * 4) * 2), q1 = *(const LAS u32x2*)(sb + OFF_QD + ((tt * 16 + r16) * QS + ks * 32 + 16 + quad * 4) * 2);
                const u32x2 t0 = *(const LAS u32x2*)(sbS + ((vt * 8 + 2 * ks) * 64 + lane) * 8), t1 = *(const LAS u32x2*)(sbS + ((vt * 8 + 2 * ks + 1) * 64 + lane) * 8);
                oacc = MFMA16(__builtin_bit_cast(bf16x8, ((u32x4){q0.x, q0.y, q1.x, q1.y})), __builtin_bit_cast(bf16x8, ((u32x4){t0.x, t0.y, t1.x, t1.y})), oacc);
            }
            const float ov[4] = {oacc.x, oacc.y, oacc.z, oacc.w};
#pragma unroll
            for (int j = 0; j < 4; ++j) { const int tok = c * 32 + tt * 16 + quad * 4 + j; if (tok < TP) oraw[((size_t)b * TP + tok) * 1024 + h * DV + colbase + vt * 16 + r16] = ov[j]; }
        }
        {
            const bf16x8 ak = *(const LAS bf16x8*)(sb + OFF_KDT + ((16 * w + r16) * TS + quad * 8) * 2);
            const bf16x8 b0 = *(const LAS bf16x8*)(sb + OFF_VT + ((r16) * TS + quad * 8) * 2), b1 = *(const LAS bf16x8*)(sb + OFF_VT + ((16 + r16) * TS + quad * 8) * 2);
            S0 = MFMA16(ak, b0, S0); S1 = MFMA16(ak, b1, S1);
            const f32x4 el = *(const LAS f32x4*)(sb + OFF_EL + (16 * w + quad * 4) * 4);
            S0 = S0 * el; S1 = S1 * el;
        }
    };
    auto publish = [&](const int c) {
        LAS unsigned char* sbS = lds + OFF_SB + (c & 1) * SBB;
        *(LAS u32x2*)(sbS + ((0 * 8 + w) * 64 + lane) * 8) = (u32x2){pkc(S0.x, S0.y), pkc(S0.z, S0.w)};
        *(LAS u32x2*)(sbS + ((1 * 8 + w) * 64 + lane) * 8) = (u32x2){pkc(S1.x, S1.y), pkc(S1.z, S1.w)};
    };
    __syncthreads();
    GM_LOAD(A, 0); GM_STAGE(A, 0); GM_LOAD(B, 1);
    for (int c = 0; c < NCH; c += 2) {
        publish(c);
        __syncthreads();
        if (c + 2 < NCH) GM_LOAD(A, c + 2);
        chunk(c);
        if (c + 1 < NCH) {
            GM_STAGE(B, c + 1);
            publish(c + 1);
            __syncthreads();
            if (c + 3 < NCH) GM_LOAD(B, c + 3);
            chunk(c + 1);
            if (c + 2 < NCH) GM_STAGE(A, c + 2);
        }
    }
#undef GM_LOAD
#undef GM_STAGE
#undef MFMA16
    GAS float* So = p.out + (GLA ? O_GP : O_HP) + ((((size_t)o * NB + b) * 4 + h) * 128 + 16 * w + quad * 4) * DV + colbase + r16;
    So[0 * DV] = S0.x; So[1 * DV] = S0.y; So[2 * DV] = S0.z; So[3 * DV] = S0.w;
    So[0 * DV + 16] = S1.x; So[1 * DV + 16] = S1.y; So[2 * DV + 16] = S1.z; So[3 * DV + 16] = S1.w;
}

__device__ __forceinline__ void phase_scan_even(const Ctx& p, int e, LAS unsigned char* lds) {
    const int G = p.G;
    const int sfirst = G > 128 ? 128 : 0, sstride = G - sfirst;
    for (int r = 0; r < (((p.probe >> 11) & 1) ? 2 : 1); ++r)
    for (int task = p.bid - sfirst; task >= 0 && task < 512 + 1024; task += sstride) {
        if (task < 512) glalike_sample<false>(p, e, task >> 2, task & 3, lds);
        else rwkv_sample(p, e, (task - 512) >> 3, (task - 512) & 7, lds);
    }
    for (int task = p.bid; task < 256; task += G) {
        if (task < 128) rwkv_prompt_scan(p, e, task >> 1, task & 1, lds);
        else gla_mfma_scan<false>(p, e, (task - 128) >> 2, (task - 128) & 3, lds);
    }
}
__device__ __forceinline__ void phase_scan_odd(const Ctx& p, int o, LAS unsigned char* lds) {
    const int G = p.G;
    for (int r = 0; r < (((p.probe >> 11) & 1) ? 2 : 1); ++r)
    for (int task = p.bid; task < 512; task += G) glalike_sample<true>(p, o, task >> 2, task & 3, lds);
    for (int task = p.bid; task < 256; task += G) gla_mfma_scan<true>(p, o, task >> 3, task & 7, lds);
}

__device__ __forceinline__ void phase_post_even(const Ctx& p, int e) {
    const int tid = p.tid, lane = tid & 63, wave = tid >> 6;
    GAS unsigned char* ws = p.ws;
    const GAS bf16_t* proj = (const GAS bf16_t*)(ws + WS_PROJ); const GAS float* oraw = (const GAS float*)(ws + WS_ORAW); const GAS bf16_t* lraw = (const GAS bf16_t*)(ws + WS_LRAW);
    const GAS float* bsum = (const GAS float*)(ws + WS_BSUM); GAS bf16_t* mixb = (GAS bf16_t*)(ws + WS_MIXB);
    const int c = lane * 8;
    const GAS float* hn = p.in(I_HNORM) + e * 512 + c; const GAS float* lw = p.in(I_LNW) + e * 512 + c; const GAS float* lbi = p.in(I_LNB) + e * 512 + c;
    const GAS float* mu = p.in(I_MU) + (size_t)e * 1792 + 1024 + c;
    for (int m = p.bid * NWAVES + wave; m < MT; m += p.G * NWAVES) {
        {
            const f32x4 o0 = *(const GAS f32x4*)(oraw + (size_t)m * 1024 + c), o1 = *(const GAS f32x4*)(oraw + (size_t)m * 1024 + c + 4);
            const u32x4 gu = *(const GAS u32x4*)(proj + (size_t)m * EPROJ + 1536 + c);
            float z[8] = {o0.x, o0.y, o0.z, o0.w, o1.x, o1.y, o1.z, o1.w};
            const float ga[8] = {bflo(gu.x), bfhi(gu.x), bflo(gu.y), bfhi(gu.y), bflo(gu.z), bfhi(gu.z), bflo(gu.w), bfhi(gu.w)};
            float ss = 0.f;
#pragma unroll
            for (int j = 0; j < 8; ++j) { z[j] *= sigmoidf_(ga[j]); ss += z[j] * z[j]; }
            ss = wave_sum(ss); const float rs = rsqrtf(ss * (1.0f / 512.0f) + 1e-6f);
            u32x4 w; w.x = pk2(z[0] * rs * hn[0], z[1] * rs * hn[1]); w.y = pk2(z[2] * rs * hn[2], z[3] * rs * hn[3]);
            w.z = pk2(z[4] * rs * hn[4], z[5] * rs * hn[5]); w.w = pk2(z[6] * rs * hn[6], z[7] * rs * hn[7]);
            *(GAS u32x4*)(mixb + (size_t)m * 1024 + c) = w;
        }
        {
            const f32x4 y0 = *(const GAS f32x4*)(oraw + (size_t)m * 1024 + 512 + c), y1 = *(const GAS f32x4*)(oraw + (size_t)m * 1024 + 512 + c + 4);
            float y[8] = {y0.x, y0.y, y0.z, y0.w, y1.x, y1.y, y1.z, y1.w};
            float s1 = 0.f;
#pragma unroll
            for (int j = 0; j < 8; ++j) s1 += y[j];
            s1 = allred8(s1); const float mean = s1 * (1.0f / 64.0f);
            float s2 = 0.f;
#pragma unroll
            for (int j = 0; j < 8; ++j) { y[j] -= mean; s2 += y[j] * y[j]; }
            s2 = allred8(s2); const float rs = rsqrtf(s2 * (1.0f / 64.0f) + 64e-5f);
            const u32x4 cu = *(const GAS u32x4*)(proj + (size_t)m * EPROJ + 2048 + 1024 + c);
            const float cur[8] = {bflo(cu.x), bfhi(cu.x), bflo(cu.y), bfhi(cu.y), bflo(cu.z), bfhi(cu.z), bflo(cu.w), bfhi(cu.w)};
            float prv[8];
            if (m >= MP) { const GAS float* s = p.in(I_SS) + ((size_t)e * NS + (m - MP)) * 1792 + 1024 + c; const f32x4 a = *(const GAS f32x4*)s, b = *(const GAS f32x4*)(s + 4);
                prv[0] = a.x; prv[1] = a.y; prv[2] = a.z; prv[3] = a.w; prv[4] = b.x; prv[5] = b.y; prv[6] = b.z; prv[7] = b.w; }
            else if ((m % TP) == 0) {
#pragma unroll
                for (int j = 0; j < 8; ++j) prv[j] = 0.f; }
            else { const u32x4 pu = *(const GAS u32x4*)(proj + (size_t)(m - 1) * EPROJ + 2048 + 1024 + c);
                prv[0] = bflo(pu.x); prv[1] = bfhi(pu.x); prv[2] = bflo(pu.y); prv[3] = bfhi(pu.y); prv[4] = bflo(pu.z); prv[5] = bfhi(pu.z); prv[6] = bflo(pu.w); prv[7] = bfhi(pu.w); }
            const float bonus = bsum[(size_t)m * 8 + (lane >> 3)];
            const u32x4 gg = *(const GAS u32x4*)(lraw + (size_t)m * 1536 + 1024 + c);
            const float g[8] = {bflo(gg.x), bfhi(gg.x), bflo(gg.y), bfhi(gg.y), bflo(gg.z), bfhi(gg.z), bflo(gg.w), bfhi(gg.w)};
            float ob[8];
#pragma unroll
            for (int j = 0; j < 8; ++j) { const float v = cur[j] + (prv[j] - cur[j]) * mu[j]; ob[j] = (y[j] * rs * lw[j] + lbi[j] + bonus * v) * g[j]; }
            u32x4 w; w.x = pk2(ob[0], ob[1]); w.y = pk2(ob[2], ob[3]); w.z = pk2(ob[4], ob[5]); w.w = pk2(ob[6], ob[7]);
            *(GAS u32x4*)(mixb + (size_t)m * 1024 + 512 + c) = w;
        }
    }
}
__device__ __forceinline__ void phase_post_odd(const Ctx& p, int o) {
    const int tid = p.tid, lane = tid & 63, wave = tid >> 6;
    GAS unsigned char* ws = p.ws;
    const GAS bf16_t* proj = (const GAS bf16_t*)(ws + WS_PROJ); const GAS float* oraw = (const GAS float*)(ws + WS_ORAW); GAS bf16_t* mixb = (GAS bf16_t*)(ws + WS_MIXB);
    const f32x4 gn = *(const GAS f32x4*)(p.in(I_GNORM) + o * 256 + 4 * lane);
    for (int m = p.bid * NWAVES + wave; m < MT; m += p.G * NWAVES) {
#pragma unroll
        for (int h = 0; h < 4; ++h) {
            const int c = h * 256 + 4 * lane;
            const f32x4 v = *(const GAS f32x4*)(oraw + (size_t)m * 1024 + c);
            float ss = (v.x * v.x + v.y * v.y) + (v.z * v.z + v.w * v.w); ss = wave_sum(ss);
            const float rs = rsqrtf(ss * (1.0f / 256.0f) + 1e-6f);
            const u32x2 gu = *(const GAS u32x2*)(proj + (size_t)m * OPROJ + 2048 + c);
            u32x2 w; w.x = pk2(v.x * rs * gn.x * siluf_(bflo(gu.x)), v.y * rs * gn.y * siluf_(bfhi(gu.x)));
            w.y = pk2(v.z * rs * gn.z * siluf_(bflo(gu.y)), v.w * rs * gn.w * siluf_(bfhi(gu.y)));
            *(GAS u32x2*)(mixb + (size_t)m * 1024 + c) = w;
        }
    }
}
__device__ __forceinline__ void phase_fix(const Ctx& p, int arg_, int rep_) {
    int sel = arg_ * 2 + (rep_ ? 1 : 0); asm volatile("" : "+s"(sel));
    const int nk = (sel & 2) ? 4 : 11; const float scale = (sel & 1) ? 0.f : ((sel & 2) ? 1.0f : 0.5f);
    const int tid = p.tid, lane = tid & 63, wave = tid >> 6;
    GAS float* xf = (GAS float*)(p.ws + WS_XF); GAS bf16_t* xb = (GAS bf16_t*)(p.ws + WS_XB); GAS float* ssq = (GAS float*)(p.ws + WS_SSQ);
    const GAS float* part = (const GAS float*)(p.ws + WS_PART);
    for (int r = p.bid * NWAVES + wave; r < 256; r += p.G * NWAVES) {
        const int m = MT - 256 + r; float ss = 0.f;
#pragma unroll
        for (int j = 0; j < 4; ++j) {
            const int c = 4 * lane + 256 * j;
            f32x4 a = {0.f, 0.f, 0.f, 0.f};
            for (int k = 0; k < nk; ++k) a = a + *(const GAS f32x4*)(part + ((size_t)k * 256 + r) * 1024 + c);
            f32x4 x = *(const GAS f32x4*)(xf + (size_t)m * D + c); x = x + a * scale;
            *(GAS f32x4*)(xf + (size_t)m * D + c) = x;
            u32x2 w; w.x = pk2(x.x, x.y); w.y = pk2(x.z, x.w); *(GAS u32x2*)(xb + (size_t)m * D + c) = w;
            ss += (x.x * x.x + x.y * x.y) + (x.z * x.z + x.w * x.w);
        }
        ss = wave_sum(ss);
        if (lane < 16) ssq[(size_t)m * 16 + lane] = lane == 0 ? ss : 0.f;
        if (lane == 0) ((GAS float*)(p.ws + WS_RSTD))[m] = rsqrtf(ss * (1.0f / 1024.0f) + 1e-6f);
    }
    for (int m = p.bid * NTHREADS + tid; m < MT - 256; m += p.G * NTHREADS) ((GAS float*)(p.ws + WS_RSTD))[m] = rstd_of(ssq, m);
}
__device__ __forceinline__ void phase_final(const Ctx& p) {
    const int tid = p.tid, lane = tid & 63, wave = tid >> 6;
    const GAS bf16_t* xb = (const GAS bf16_t*)(p.ws + WS_XB); const GAS float* ssq = (const GAS float*)(p.ws + WS_SSQ);
    for (int m = p.bid * NWAVES + wave; m < MT; m += p.G * NWAVES) {
        GAS float* dst;
        if (m < MP) { const int b = m / TP, t = m % TP; if (t < 16) continue; dst = p.out + O_YP + ((size_t)b * 2048 + (t - 16)) * D; }
        else dst = p.out + O_YS + (size_t)(m - MP) * D;
        const float rs = rstd_of(ssq, m);
#pragma unroll
        for (int j = 0; j < 4; ++j) {
            const int c = 4 * lane + 256 * j; const u32x2 xo = *(const GAS u32x2*)(xb + (size_t)m * D + c); const f32x4 x = {bflo(xo.x), bfhi(xo.x), bflo(xo.y), bfhi(xo.y)}, g = *(const GAS f32x4*)(p.in(I_FNORM) + c);
            *(GAS f32x4*)(dst + c) = x * rs * g;
        }
    }
}

#define XB_TMO      128
#define XB_XCNT(j)  (256  + 64 * (j))
#define XB_XSUB(j)  (1280 + 64 * (j))
#define XB_XGEN(j)  (2304 + 64 * (j))
#define XB_TOP      3328
#define XB_TOPGEN   3392
#define XCD_BAR_WORDS 3456
#define XB_SPIN_CAP (1u << 22)
__device__ __forceinline__ unsigned xb_ld(unsigned* p)              { return __hip_atomic_load(p, __ATOMIC_RELAXED, __HIP_MEMORY_SCOPE_AGENT); }
__device__ __forceinline__ unsigned xb_add(unsigned* p, unsigned v) { return __hip_atomic_fetch_add(p, v, __ATOMIC_RELAXED, __HIP_MEMORY_SCOPE_AGENT); }
__device__ __forceinline__ unsigned xb_xcc_id() { return (unsigned)__builtin_amdgcn_s_getreg((3 << 11) | 20) & 0xFu; }
#define XB_SPIN(cond, bar) do { unsigned _sp = 0; while (cond) { __builtin_amdgcn_s_sleep(1); \
    if ((++_sp & 255u) == 0u) { if (xb_ld(&(bar)[XB_TMO])) break; if (_sp > XB_SPIN_CAP) { atomicAdd(&(bar)[XB_TMO], 1u); break; } } } } while (0)
struct XcdBarrier { unsigned* bar; unsigned x; volatile LAS unsigned* st; };
__device__ __forceinline__ void xcd_barrier_complete(unsigned* bar, unsigned x, unsigned G, unsigned& nloc, unsigned& nx) {
    unsigned sum, cnt, mine, sp = 0u;
    for (;;) {
        sum = 0u; cnt = 0u; mine = 0u;
#pragma unroll
        for (unsigned j = 0; j < 16; ++j) { const unsigned c = xb_ld(&bar[XB_XCNT(j)]); sum += c; cnt += (c > 0u) ? 1u : 0u; mine = (j == x) ? c : mine; }
        if (sum == G) break;
        __builtin_amdgcn_s_sleep(1);
        if ((++sp & 255u) == 0u) { if (xb_ld(&bar[XB_TMO])) break; if (sp > XB_SPIN_CAP) { atomicAdd(&bar[XB_TMO], 1u); break; } }
    }
    nloc = mine > 0u ? mine : 1u; nx = cnt > 0u ? cnt : 1u;
}
__device__ __forceinline__ void xcd_barrier(const XcdBarrier& b, int tid, unsigned G) {
    asm volatile("s_waitcnt vmcnt(0)" ::: "memory");
    __syncthreads();
    if (tid == 0) {
        unsigned* bar = b.bar;
        __builtin_amdgcn_s_waitcnt(0);
        unsigned nloc = b.st[0], nx = b.st[1];
        if (nloc == 0u) { xcd_barrier_complete(bar, b.x, G, nloc, nx); b.st[0] = nloc; b.st[1] = nx; }
        const unsigned old = xb_add(&bar[XB_XSUB(b.x)], 1u);
        const unsigned gen = old / nloc;
        if (old + 1u == (gen + 1u) * nloc) {
            __builtin_amdgcn_fence(__ATOMIC_RELEASE, "agent");
            asm volatile("s_waitcnt vmcnt(0)" ::: "memory");
            const unsigned og = xb_add(&bar[XB_TOP], 1u);
            const unsigned tg = og / nx;
            if (og + 1u == (tg + 1u) * nx) xb_add(&bar[XB_TOPGEN], 1u);
            else XB_SPIN(xb_ld(&bar[XB_TOPGEN]) == tg, bar);
            __builtin_amdgcn_fence(__ATOMIC_ACQUIRE, "agent");
            xb_add(&bar[XB_XGEN(b.x)], 1u);
            asm volatile("s_waitcnt vmcnt(0)" ::: "memory");
        } else {
            XB_SPIN(xb_ld(&bar[XB_XGEN(b.x)]) == gen, bar);
            __builtin_amdgcn_fence(__ATOMIC_ACQUIRE, "agent");
            asm volatile("s_waitcnt vmcnt(0)" ::: "memory");
        }
    }
    __syncthreads();
}

#define TAILCNT(ph, pn) (3520 + (ph) * 4 + (pn))
__device__ __forceinline__ void tail_fixup(const Ctx& p, int ph, int nk, float scale) {
    const int tid = p.tid, lane = tid & 63, wave = tid >> 6, nmain = 64 * 4, ntail = 4 * nk;
    unsigned* bar = (unsigned*)(unsigned char*)(p.ws + WS_BAR);
    GAS float* xf = (GAS float*)(p.ws + WS_XF); GAS bf16_t* xb = (GAS bf16_t*)(p.ws + WS_XB); GAS float* ssq = (GAS float*)(p.ws + WS_SSQ);
    const GAS float* part = (const GAS float*)(p.ws + WS_PART);
    for (int L = p.bid; L < nmain + ntail; L += p.G) {
        if (L < nmain) continue;
        const int j = L - nmain, pn = j % 4, kc = j / 4;
        asm volatile("s_waitcnt vmcnt(0)" ::: "memory");
        __syncthreads();
        if (tid == 0) {
            __builtin_amdgcn_fence(__ATOMIC_RELEASE, "agent");
            asm volatile("s_waitcnt vmcnt(0)" ::: "memory");
            (void)xb_add(&bar[TAILCNT(ph, pn)], 1u);
            XB_SPIN(xb_ld(&bar[TAILCNT(ph, pn)]) < (unsigned)nk, bar);
            __builtin_amdgcn_fence(__ATOMIC_ACQUIRE, "agent");
            asm volatile("s_waitcnt vmcnt(0)" ::: "memory");
        }
        __syncthreads();
        const int r_lo = (kc * 256) / nk, r_hi = ((kc + 1) * 256) / nk, c4 = pn * 256 + 4 * lane;
        for (int r = r_lo + wave; r < r_hi; r += NWAVES) {
            const int m = MT - 256 + r;
            f32x4 sl[11];
#pragma unroll
            for (int k = 0; k < 11; ++k) sl[k] = (k < nk) ? *(const GAS f32x4*)(part + ((size_t)k * 256 + r) * 1024 + c4) : (f32x4){0.f, 0.f, 0.f, 0.f};
            f32x4 a = sl[0];
#pragma unroll
            for (int k = 1; k < 11; ++k) a = a + sl[k];
            const u32x2 xo = *(const GAS u32x2*)(xb + (size_t)m * D + c4); f32x4 x = {bflo(xo.x), bfhi(xo.x), bflo(xo.y), bfhi(xo.y)}; x = x + a * scale;
            u32x2 w; w.x = pk2(x.x, x.y); w.y = pk2(x.z, x.w); *(GAS u32x2*)(xb + (size_t)m * D + c4) = w;
            float ss = (x.x * x.x + x.y * x.y) + (x.z * x.z + x.w * x.w); ss = wave_sum(ss);
            if (lane < 4) ssq[(size_t)m * 16 + pn * 4 + lane] = lane == 0 ? ss : 0.f;
        }
    }
}

__global__ void __launch_bounds__(NTHREADS, 2) mega_fwd(Params pp) {
    extern __shared__ __attribute__((aligned(16))) unsigned char shm[];
    LAS unsigned char* lds = (LAS unsigned char*)shm;
    cg::grid_group grid = cg::this_grid();
    if (threadIdx.x < N_IN) {
        const unsigned long long v = (unsigned long long)pp.in[threadIdx.x];
        LAS unsigned* t = (LAS unsigned*)(lds + TAB_OFF) + 2 * threadIdx.x; t[0] = (unsigned)v; t[1] = (unsigned)(v >> 32);
    }
    #define MK_GBAR() XcdBarrier gbar; gbar.bar = (unsigned*)(pp.ws + WS_BAR); gbar.x = xb_xcc_id(); gbar.st = (volatile LAS unsigned*)(lds + TAB_OFF + 320)
    if (threadIdx.x == 0) { MK_GBAR(); gbar.st[0] = 0u; gbar.st[1] = 0u; (void)xb_add(&gbar.bar[XB_XCNT(gbar.x)], 1u); }
    __syncthreads();
    const int wave_s = __builtin_amdgcn_readfirstlane((int)(threadIdx.x >> 6));
    for (int ph = pp.ph_lo; ph < pp.ph_hi; ++ph) {
        const int kind = PROG[ph][0], arg = PROG[ph][1];
        const int nrep = (((pp.probe_mask >> kind) & 1) || (kind == K_SCAN && (arg & 1) && ((pp.probe_mask >> 12) & 1))) ? 2 : 1;
        for (int rep = 0; rep < nrep; ++rep) {
        int lane_l; asm volatile("v_mbcnt_lo_u32_b32 %0, -1, 0\n\tv_mbcnt_hi_u32_b32 %0, -1, %0" : "=v"(lane_l));
        int tid = wave_s * 64 + lane_l, bid = blockIdx.x; unsigned char* ws_ = pp.ws; float* outp_ = pp.out; LAS unsigned char* ldsl = lds;
        asm volatile("" : "+v"(tid)); asm volatile("" : "+s"(bid)); asm volatile("" : "+s"(ws_)); asm volatile("" : "+s"(outp_)); asm volatile("" : "+s"(ldsl));
        GAS unsigned char* ws = (GAS unsigned char*)ws_; GAS float* outp = (GAS float*)outp_;
        Ctx p; p.lds = ldsl; p.out = outp; p.ws = ws; p.tid = tid; p.bid = bid; p.G = gridDim.x; p.probe = pp.probe_mask;
        if (rep) { MK_GBAR(); xcd_barrier(gbar, tid, (unsigned)gridDim.x); }
        GAS bf16_t* xb = (GAS bf16_t*)(ws + WS_XB); GAS float* xf = (GAS float*)(ws + WS_XF); GAS float* ssq = (GAS float*)(ws + WS_SSQ);
        GAS bf16_t* projb = (GAS bf16_t*)(ws + WS_PROJ);
        if (kind == K_P0) phase_p0(p, ldsl);
        else if (kind == K_GU || kind == K_DN || kind == K_OUT || kind == K_IN || kind == K_LORA) {
            pg8::Gemm g; Epi E; E.ws = ws; E.scale = 1.0f; E.ldo = 0;
            if (kind == K_GU) { g = pg8::Gemm{xb, (const GAS bf16_t*)(ws + WS_WGU) + (size_t)arg * 5632 * 1024, MT, 5632, 1024}; E.mode = 0; }
            else if (kind == K_DN) { g = pg8::Gemm{projb, (const GAS bf16_t*)(ws + WS_WD) + (size_t)arg * 1024 * FF, MT, 1024, FF}; E.mode = 1; E.scale = rep ? 0.f : 0.5f; }
            else if (kind == K_OUT) { g = pg8::Gemm{(const GAS bf16_t*)(ws + WS_MIXB), (const GAS bf16_t*)(ws + WS_WOUT) + (size_t)arg * D * D, MT, 1024, 1024}; E.mode = 1; E.scale = rep ? 0.f : 1.0f; }
            else if (kind == K_IN) { const int odd = arg & 1, idx = arg >> 1;
                g = pg8::Gemm{xb, odd ? (const GAS bf16_t*)(ws + WS_WINO) + (size_t)idx * OPROJ * 1024 : (const GAS bf16_t*)(ws + WS_WINE) + (size_t)idx * EPROJ * 1024, MT, odd ? OPROJ : EPROJ, 1024};
                E.mode = 2; E.ldo = odd ? OPROJ : EPROJ; }
            else { g = pg8::Gemm{(const GAS bf16_t*)(ws + WS_LIN), (const GAS bf16_t*)(ws + WS_WLORA) + (size_t)(arg >> 1) * 1536 * 256, MT, 1536, 256}; E.mode = 3; E.ldo = 1536; }
            pg8::StaticOrder S; S.init(g.M, g.N, g.K, p.G, bid, E.mode == 1);
            pg8::gemm_phase(ldsl, g, S, E, tid);
            if (E.mode == 1) tail_fixup(p, ph, g.K / 256, E.scale);
        } else if (kind == K_LIN) { phase_fprep(p, arg & 1, arg >> 1); if (!(arg & 1)) phase_lin(p, arg >> 1); }
        else if (kind == K_SCAN) { if (arg & 1) phase_scan_odd(p, arg >> 1, ldsl); else phase_scan_even(p, arg >> 1, ldsl); }
        else if (kind == K_FIX) phase_fix(p, arg, rep);
        else if (kind == K_POST) { if (arg & 1) phase_post_odd(p, arg >> 1); else phase_post_even(p, arg >> 1); }
        else phase_final(p);
        }
        if (ph + 1 < pp.ph_hi) { if (pp.ph_lo < 0) grid.sync();   else { MK_GBAR(); int lane_b; asm volatile("v_mbcnt_lo_u32_b32 %0, -1, 0\n\tv_mbcnt_hi_u32_b32 %0, -1, %0" : "=v"(lane_b)); xcd_barrier(gbar, wave_s * 64 + lane_b, (unsigned)gridDim.x); } }
    }
}

extern "C" void kernel_launch(void* const* d_in, const int* in_sizes, int n_in, void* d_out, int out_size, void* d_ws, size_t ws_size, hipStream_t stream) {
    static int grid_blocks = 0;
    if (grid_blocks == 0) {
        if (n_in != N_IN || (size_t)out_size != O_END || ws_size < WS_END) {
            fprintf(stderr, "kernel_launch: unexpected shapes: n_in %d out %d ws %zu (need %zu)\n", n_in, out_size, ws_size, (size_t)WS_END);
            grid_blocks = -1; return;
        }
        int dev = 0, cus = 0, per_cu = 0;
        hipGetDevice(&dev);
        hipDeviceGetAttribute(&cus, hipDeviceAttributeMultiprocessorCount, dev);
        if (hipFuncSetAttribute((const void*)mega_fwd, hipFuncAttributeMaxDynamicSharedMemorySize, LDS_BYTES) != hipSuccess) fprintf(stderr, "kernel_launch: hipFuncSetAttribute failed\n");
        hipOccupancyMaxActiveBlocksPerMultiprocessor(&per_cu, (const void*)mega_fwd, NTHREADS, LDS_BYTES);
        (void)hipGetLastError();
        if (per_cu < 1) fprintf(stderr, "kernel_launch: occupancy query reports %d blocks per CU\n", per_cu);
        grid_blocks = cus > 0 ? cus : 256;
    }
    if (grid_blocks < 0) return;
    if (hipMemsetAsync((char*)d_ws + WS_BAR, 0, 16384, stream) != hipSuccess) { fprintf(stderr, "kernel_launch: memset failed\n"); return; }
    Params p{};
    for (int i = 0; i < N_IN; ++i) p.in[i] = (const float*)d_in[i];
    p.out = (float*)d_out; p.ws = (unsigned char*)d_ws; p.ph_lo = 0; p.ph_hi = NPHASES; p.probe_mask = PROBE_MASK;
    void* args[] = {&p};
    hipError_t e = hipLaunchCooperativeKernel((const void*)mega_fwd, dim3(grid_blocks), dim3(NTHREADS), args, LDS_BYTES, stream);
    if (e != hipSuccess) fprintf(stderr, "cooperative launch failed: %s (grid %d)\n", hipGetErrorString(e), grid_blocks);
}
```
